# Optimizing an MI355X kernel written in HIP

```python
import math
import jax, jax.numpy as jnp
from jax import lax
import numpy as np

D_MODEL = 2048
BATCH = 8
SEQ = 2048
DEPTH = 4
DEC_BATCH = 4
DEC_SEQ = 4096
PAST_LEN = 128

GRID_W = 64
D_FF = 5632
NA_HEADS = 8
NA_HEAD_DIM = 64
NA_WIN_H = 8
NA_WIN_W = 16
NA_WIDTH = NA_HEADS * NA_HEAD_DIM
HG_HEADS = 4
HG_DK = 128
HG_DV = 128
HG_WIDTH = HG_HEADS * HG_DV
HG_CHUNK = 16
S5_GROUPS = 64
S5_GROUP_CH = 16
S5_STATE = 64
S5_WIDTH = S5_GROUPS * S5_GROUP_CH
MIX_WIDTH = NA_WIDTH + HG_WIDTH + S5_WIDTH
IN_SPLITS = [NA_WIDTH, NA_WIDTH, NA_WIDTH,
             HG_HEADS * HG_DK, HG_HEADS * HG_DK, HG_HEADS * HG_DK, HG_WIDTH, HG_WIDTH,
             S5_WIDTH]
IN_COLS = sum(IN_SPLITS)
EPS = 1e-6

kernel_name = "hybrid_bidir_encoder_na_hgrn2_s5"


def rms_norm(x, gain):
    xf = x.astype(jnp.float32)
    y = xf * lax.rsqrt(jnp.mean(xf * xf, axis=-1, keepdims=True) + EPS)
    return (y * gain.astype(jnp.float32)).astype(x.dtype)


def swiglu(h, w_gate, w_up, w_down):
    return (jax.nn.silu(h @ w_gate) * (h @ w_up)) @ w_down


def neighborhood_attention(q, k, v, rel_bias):
    bsz, t = q.shape[0], q.shape[1]
    rows = t // GRID_W
    kh = min(NA_WIN_H, rows)
    kw = NA_WIN_W
    grid = lambda a: a.reshape(bsz, rows, GRID_W, NA_HEADS, NA_HEAD_DIM)
    qg, kg, vg = grid(q), grid(k), grid(v)
    col = jnp.arange(GRID_W)
    col_start = jnp.clip(col - kw // 2, 0, GRID_W - kw)
    col_idx = col_start[:, None] + jnp.arange(kw)[None, :]
    col_bias = rel_bias[:, :, col_idx - col[:, None] + (NA_WIN_W - 1)]
    scale = NA_HEAD_DIM ** -0.5

    def one_row(r):
        rs = jnp.clip(r - kh // 2, 0, rows - kh)
        k_win = lax.dynamic_slice_in_dim(kg, rs, kh, axis=1)[:, :, col_idx]
        v_win = lax.dynamic_slice_in_dim(vg, rs, kh, axis=1)[:, :, col_idx]
        q_r = lax.dynamic_index_in_dim(qg, r, axis=1, keepdims=False)
        s = jnp.einsum('bwhd,bawkhd->bhwak', q_r, k_win).astype(jnp.float32) * scale
        dr = rs + jnp.arange(kh) - r
        bias = jnp.transpose(col_bias[:, dr + (NA_WIN_H - 1)], (0, 2, 1, 3))
        s = s + bias.astype(jnp.float32)[None]
        p = jax.nn.softmax(s.reshape(bsz, NA_HEADS, GRID_W, kh * kw), axis=-1)
        p = p.reshape(bsz, NA_HEADS, GRID_W, kh, kw).astype(v.dtype)
        return jnp.einsum('bhwak,bawkhd->bwhd', p, v_win)

    out = lax.map(one_row, jnp.arange(rows))
    return jnp.transpose(out, (1, 0, 2, 3, 4)).reshape(bsz, t, NA_WIDTH)


def hgrn2_gates(z, lb):
    bsz, t = z.shape[0], z.shape[1]
    zf = z.astype(jnp.float32).reshape(bsz, t, HG_HEADS, HG_DK)
    lb = lb.astype(jnp.float32).reshape(HG_HEADS, HG_DK)
    log_f = jnp.logaddexp(jnp.log(lb), jnp.log1p(-lb) + jax.nn.log_sigmoid(zf))
    k = (1.0 - lb) * jax.nn.sigmoid(-zf)
    return log_f, k


def hgrn2_chunk_scan(q, log_f, k, v):
    bsz, t = q.shape[0], q.shape[1]
    n = t // HG_CHUNK

    def chunks(a):
        return jnp.transpose(a.reshape(bsz, n, HG_CHUNK, HG_HEADS, a.shape[-1]), (0, 3, 1, 2, 4))

    q, log_f, k, v = chunks(q), chunks(log_f), chunks(k), chunks(v)
    b = jnp.cumsum(log_f, axis=3)
    lower = jnp.tril(jnp.ones((HG_CHUNK, HG_CHUNK), dtype=bool))
    diff = b[:, :, :, :, None, :] - b[:, :, :, None, :, :]
    decay = jnp.exp(jnp.where(lower[:, :, None], diff, -jnp.inf))
    scores = jnp.einsum('bhntd,bhntsd,bhnsd->bhnts', q, decay, k)
    o_intra = jnp.einsum('bhnts,bhnsv->bhntv', scores, v)
    b_last = b[:, :, :, -1:, :]
    q_dec = q * jnp.exp(b)
    kv = jnp.einsum('bhnsd,bhnsv->bhndv', k * jnp.exp(b_last - b), v)
    chunk_decay = jnp.exp(b_last[:, :, :, 0, :])

    def step(state, inp):
        qd, dec, kvc = inp
        o = jnp.einsum('bhtd,bhdv->bhtv', qd, state)
        return dec[..., None] * state + kvc, o

    s0 = jnp.zeros((bsz, HG_HEADS, HG_DK, v.shape[-1]), jnp.float32)
    _, o_inter = lax.scan(step, s0, (jnp.moveaxis(q_dec, 2, 0), jnp.moveaxis(chunk_decay, 2, 0),
                                     jnp.moveaxis(kv, 2, 0)))
    o = o_intra + jnp.moveaxis(o_inter, 0, 2)
    return jnp.transpose(o, (0, 2, 3, 1, 4)).reshape(bsz, t, HG_HEADS, v.shape[-1])


def _complex_affine_combine(e1, e2):
    a1r, a1i, b1r, b1i = e1
    a2r, a2i, b2r, b2i = e2
    ar = a1r * a2r - a1i * a2i
    ai = a1r * a2i + a1i * a2r
    br = a2r * b1r - a2i * b1i + b2r
    bi = a2r * b1i + a2i * b1r + b2i
    return ar, ai, br, bi


def s5_direction(u_t, a_re, a_im, log_dt, b_re, b_im, c_re, c_im, reverse):
    t = u_t.shape[0]
    dt = jnp.exp(log_dt)[:, None]
    mag = jnp.exp(dt * a_re)
    ang = dt * a_im
    ab_re = mag * jnp.cos(ang)
    ab_im = mag * jnp.sin(ang)
    den = a_re * a_re + a_im * a_im
    nr = ab_re - 1.0
    f_re = (nr * a_re + ab_im * a_im) / den
    f_im = (ab_im * a_re - nr * a_im) / den
    bb_re = f_re[..., None] * b_re - f_im[..., None] * b_im
    bb_im = f_re[..., None] * b_im + f_im[..., None] * b_re
    bu_re = jnp.einsum('tbgc,gpc->tbgp', u_t, bb_re)
    bu_im = jnp.einsum('tbgc,gpc->tbgp', u_t, bb_im)
    shape = (t, 1) + ab_re.shape
    a_r = jnp.broadcast_to(ab_re, shape)
    a_i = jnp.broadcast_to(ab_im, shape)
    _, _, x_re, x_im = lax.associative_scan(_complex_affine_combine, (a_r, a_i, bu_re, bu_im),
                                            reverse=reverse, axis=0)
    return jnp.einsum('tbgp,gcp->btgc', x_re, c_re) - jnp.einsum('tbgp,gcp->btgc', x_im, c_im)


def encoder_layer(x, p, l, lb_l):
    f32 = jnp.float32
    bsz, t = x.shape[0], x.shape[1]
    h = rms_norm(x, p['ffn1_norm'][l])
    x = x + 0.5 * swiglu(h, p['ffn1_w_gate'][l], p['ffn1_w_up'][l], p['ffn1_w_down'][l])
    h = rms_norm(x, p['mix_norm'][l])
    z = h @ p['w_in'][l]
    offs = [int(o) for o in np.cumsum(IN_SPLITS)[:-1]]
    zq, zk, zv, hq, hf_f, hf_b, hi, hg, su = jnp.split(z, offs, axis=-1)
    qa = rms_norm(zq.reshape(bsz, t, NA_HEADS, NA_HEAD_DIM), p['q_norm'][l])
    ka = rms_norm(zk.reshape(bsz, t, NA_HEADS, NA_HEAD_DIM), p['k_norm'][l])
    va = zv.reshape(bsz, t, NA_HEADS, NA_HEAD_DIM)
    a_out = rms_norm(neighborhood_attention(qa, ka, va, p['rel_bias'][l]), p['attn_out_norm'][l]).astype(x.dtype)
    q_h = jax.nn.silu(hq.astype(f32)).reshape(bsz, t, HG_HEADS, HG_DK)
    v_h = hi.astype(f32).reshape(bsz, t, HG_HEADS, HG_DV)
    logf_f, k_f = hgrn2_gates(hf_f, lb_l[0])
    logf_b, k_b = hgrn2_gates(hf_b, lb_l[1])
    flip = lambda a: jnp.flip(a, axis=1)
    o_h = hgrn2_chunk_scan(q_h, logf_f, k_f, v_h) + flip(
        hgrn2_chunk_scan(flip(q_h), flip(logf_b), flip(k_b), flip(v_h)))
    o_h = rms_norm(o_h, p['hg_out_norm'][l].reshape(HG_HEADS, HG_DV)).reshape(bsz, t, HG_WIDTH)
    b_out = (o_h * jax.nn.silu(hg.astype(f32))).astype(x.dtype)
    u = su.astype(f32).reshape(bsz, t, S5_GROUPS, S5_GROUP_CH)
    u_t = jnp.transpose(u, (1, 0, 2, 3))
    dirs = []
    for d in range(2):
        dirs.append(s5_direction(u_t, p['s5_a_re'][l, d].astype(f32), p['s5_a_im'][l, d].astype(f32),
                                 p['s5_log_dt'][l, d].astype(f32), p['s5_b_re'][l, d].astype(f32),
                                 p['s5_b_im'][l, d].astype(f32), p['s5_c_re'][l, d].astype(f32),
                                 p['s5_c_im'][l, d].astype(f32), reverse=(d == 1)))
    y = dirs[0] + dirs[1] + u * p['s5_d'][l].astype(f32).reshape(S5_GROUPS, S5_GROUP_CH)
    y = jax.nn.gelu(y.reshape(bsz, t, S5_WIDTH))
    y = y * jax.nn.sigmoid(y @ p['s5_w_glu'][l].astype(f32) + p['s5_b_glu'][l].astype(f32))
    c_out = rms_norm(y, p['s5_out_norm'][l]).astype(x.dtype)
    mix = jnp.concatenate([a_out, b_out, c_out], axis=-1) @ p['w_out'][l]
    x = x + mix
    h = rms_norm(x, p['ffn2_norm'][l])
    x = x + 0.5 * swiglu(h, p['ffn2_w_gate'][l], p['ffn2_w_up'][l], p['ffn2_w_down'][l])
    return rms_norm(x, p['final_norm'][l])


def encoder_trunk(x, p, lb):
    for l in range(DEPTH):
        x = encoder_layer(x, p, l, lb[l])
    return x


def setup_inputs(seed: int = 0) -> dict:
    key = jax.random.key(seed)
    ks = jax.random.split(key, 32)
    f32 = jnp.float32
    L, D, F = DEPTH, D_MODEL, D_FF
    G, P, Gc = S5_GROUPS, S5_STATE, S5_GROUP_CH

    def nrm(k, shape, scale):
        return jax.random.normal(k, shape, f32) * scale

    def gain(k, shape):
        return 1.0 + 0.02 * jax.random.normal(k, shape, f32)

    n_idx = jnp.arange(P, dtype=f32)
    return {
        'x_prompt': nrm(ks[0], (BATCH, SEQ, D), 1.0),
        'x_sample': nrm(ks[1], (DEC_BATCH, DEC_SEQ, D), 1.0),
        'ffn1_norm': gain(ks[2], (L, D)),
        'ffn1_w_gate': nrm(ks[3], (L, D, F), D ** -0.5),
        'ffn1_w_up': nrm(ks[4], (L, D, F), D ** -0.5),
        'ffn1_w_down': nrm(ks[5], (L, F, D), F ** -0.5),
        'mix_norm': gain(ks[6], (L, D)),
        'w_in': nrm(ks[7], (L, D, IN_COLS), D ** -0.5),
        'q_norm': gain(ks[8], (L, NA_HEAD_DIM)),
        'k_norm': gain(ks[9], (L, NA_HEAD_DIM)),
        'rel_bias': nrm(ks[10], (L, NA_HEADS, 2 * NA_WIN_H - 1, 2 * NA_WIN_W - 1), 0.02),
        'attn_out_norm': gain(ks[11], (L, NA_WIDTH)),
        'hg_lb_logits': nrm(ks[12], (L, 2, HG_HEADS * HG_DK), 1.0),
        'hg_out_norm': gain(ks[13], (L, HG_WIDTH)),
        's5_a_re': -0.5 * jnp.exp(nrm(ks[14], (L, 2, G, P), 0.05)),
        's5_a_im': jnp.pi * n_idx + nrm(ks[15], (L, 2, G, P), 0.01),
        's5_log_dt': jax.random.uniform(ks[16], (L, 2, G), f32, math.log(1e-3), math.log(1e-1)),
        's5_b_re': nrm(ks[17], (L, 2, G, P, Gc), (2 * Gc) ** -0.5),
        's5_b_im': nrm(ks[18], (L, 2, G, P, Gc), (2 * Gc) ** -0.5),
        's5_c_re': nrm(ks[19], (L, 2, G, Gc, P), (2 * P) ** -0.5),
        's5_c_im': nrm(ks[20], (L, 2, G, Gc, P), (2 * P) ** -0.5),
        's5_d': nrm(ks[21], (L, S5_WIDTH), 1.0),
        's5_w_glu': nrm(ks[22], (L, S5_WIDTH, S5_WIDTH), S5_WIDTH ** -0.5),
        's5_b_glu': nrm(ks[23], (L, S5_WIDTH), 0.01),
        's5_out_norm': gain(ks[24], (L, S5_WIDTH)),
        'w_out': nrm(ks[25], (L, MIX_WIDTH, D), MIX_WIDTH ** -0.5),
        'ffn2_norm': gain(ks[26], (L, D)),
        'ffn2_w_gate': nrm(ks[27], (L, D, F), D ** -0.5),
        'ffn2_w_up': nrm(ks[28], (L, D, F), D ** -0.5),
        'ffn2_w_down': nrm(ks[29], (L, F, D), F ** -0.5),
        'final_norm': gain(ks[30], (L, D)),
    }


def reference(x_prompt, x_sample, ffn1_norm, ffn1_w_gate, ffn1_w_up, ffn1_w_down, mix_norm, w_in,
              q_norm, k_norm, rel_bias, attn_out_norm, hg_lb_logits, hg_out_norm,
              s5_a_re, s5_a_im, s5_log_dt, s5_b_re, s5_b_im, s5_c_re, s5_c_im, s5_d, s5_w_glu, s5_b_glu,
              s5_out_norm, w_out, ffn2_norm, ffn2_w_gate, ffn2_w_up, ffn2_w_down, final_norm):
    p = dict(ffn1_norm=ffn1_norm, ffn1_w_gate=ffn1_w_gate, ffn1_w_up=ffn1_w_up, ffn1_w_down=ffn1_w_down,
             mix_norm=mix_norm, w_in=w_in, q_norm=q_norm, k_norm=k_norm, rel_bias=rel_bias,
             attn_out_norm=attn_out_norm, hg_out_norm=hg_out_norm,
             s5_a_re=s5_a_re, s5_a_im=s5_a_im, s5_log_dt=s5_log_dt, s5_b_re=s5_b_re, s5_b_im=s5_b_im,
             s5_c_re=s5_c_re, s5_c_im=s5_c_im, s5_d=s5_d, s5_w_glu=s5_w_glu, s5_b_glu=s5_b_glu,
             s5_out_norm=s5_out_norm, w_out=w_out, ffn2_norm=ffn2_norm, ffn2_w_gate=ffn2_w_gate,
             ffn2_w_up=ffn2_w_up, ffn2_w_down=ffn2_w_down, final_norm=final_norm)
    lb = jnp.cumsum(jax.nn.softmax(hg_lb_logits.astype(jnp.float32), axis=0), axis=0)
    lb = lb - lb[0:1]
    y_prompt = encoder_trunk(x_prompt, p, lb)
    y_sample = encoder_trunk(x_sample, p, lb)
    return (y_prompt, y_sample)
```

```cpp
#include <hip/hip_runtime.h>
#include <cstdio>
#include <cstdint>
namespace pg8 {
#define PG8_LAS __attribute__((address_space(3)))
typedef unsigned short bf16_t;
typedef short bf16x8 __attribute__((ext_vector_type(8)));
typedef float f32x4 __attribute__((ext_vector_type(4)));
typedef unsigned u32x4 __attribute__((ext_vector_type(4)));
constexpr int BM = 256, BK = 64, HALF = 128, HTB = HALF * BK * 2  , STAGE_BYTES = 8 * HTB, NXCD = 8, WGM = 8;

__host__ __device__ __forceinline__ int lds_byte(int r, int c) { const int st = (r >> 4) * 2 + (c >> 5), rr = r & 15, cc = c & 31, ob = rr * 64 + cc * 2; return st * 1024 + (ob ^ (((ob >> 9) & 1) << 5)); }
__host__ __device__ __forceinline__ void stage_rc(int b, int& R, int& C) { const int st = b / 1024, sb = b % 1024, swz = sb ^ (((sb >> 9) & 1) << 5); R = (st >> 1) * 16 + swz / 64; C = (st & 1) * 32 + (swz % 64) / 2; }
__host__ __device__ __forceinline__ int perm32(int rho) { const int n = rho >> 4, i = rho & 15; return 8 * (i >> 2) + 4 * n + (i & 3); }

struct Unit { int pm, pn; };
struct Gemm { const bf16_t* A; const bf16_t* Bt; int M, N, K, lda, ldb; };

struct StaticOrder {
    int nM, nN, nwg, G, c;
    __host__ __device__ void init(int M, int N, int G_, int c_) { nM = M / BM; nN = N / BM; nwg = nM * nN; G = G_; c = c_; }
    __host__ __device__ bool next(int i, Unit& u) const {
        const long L = (long)i * G + c; if (L >= nwg) return false;
        int wgid = (int)L; { const int q = nwg / NXCD, r = nwg % NXCD, xcd = wgid % NXCD, off = wgid / NXCD; wgid = (xcd < r ? xcd * (q + 1) : r * (q + 1) + (xcd - r) * q) + off; }
        const int nig = WGM * nN, gid = wgid / nig, fm = gid * WGM, gsz = (nM - fm) < WGM ? (nM - fm) : WGM;
        u.pm = fm + ((wgid % nig) % gsz); u.pn = (wgid % nig) / gsz; return true;
    }
    __device__ __forceinline__ void a_ready(const Unit&) const {}
    __device__ __forceinline__ void done(const Unit&) const {}
};

template <class Epi, class Sched, bool ALIGN_EPI = false, bool SP2 = false>
__device__ __forceinline__ void gemm_phase(PG8_LAS unsigned char* lds, const Gemm g, const Sched& S, const Epi& E) {
    int tid_ = threadIdx.x; asm volatile("" : "+v"(tid_));
    const int tid = tid_, wid = __builtin_amdgcn_readfirstlane(tid >> 6), lane = tid & 63, wr = wid >> 2, wc = wid & 3, fr = lane & 15, fq = lane >> 4;
    const int K = g.K, nt = K / BK;
    unsigned voffA[2], voffB[2];
#pragma unroll
    for (int i = 0; i < 2; ++i) { int R, C; stage_rc(tid * 16 + i * 8192, R, C); const int Rb = Epi::PERM ? ((R & ~31) + perm32(R & 31)) : R;
        voffA[i] = (unsigned)(R * g.lda + C) * 2u; voffB[i] = (unsigned)(Rb * g.ldb + C) * 2u; }
    const size_t kstep = (size_t)(BK * 2);
    const size_t hstepA = (size_t)HALF * g.lda * 2, hstepB = (size_t)HALF * g.ldb * 2;
    const size_t tstepA = 2 * hstepA, tstepB = 2 * hstepB;
    const unsigned ldsw = (unsigned)wid * 1024u;
    const int aoff = lds_byte(wr * 64 + fr, fq * 8), boff = lds_byte(wc * 32 + fr, fq * 8);
#define PG8_SA(b, h) (((b) * 2 + (h)) * HTB)
#define PG8_SB(b, h) ((4 + (b) * 2 + (h)) * HTB)
#define PG8_STAGE(bufoff, gbase, voff) do { _Pragma("unroll") for (int _i = 0; _i < 2; ++_i) \
        __builtin_amdgcn_global_load_lds((const unsigned*)((const char*)(gbase) + (voff)[_i]), (PG8_LAS unsigned*)(lds + (bufoff) + ldsw + _i * 8192), 16, 0, 0); } while (0)
#define PG8_LDA(dst, b, h) do { _Pragma("unroll") for (int m = 0; m < 4; ++m) _Pragma("unroll") for (int k = 0; k < 2; ++k) dst[m][k] = *(const PG8_LAS bf16x8*)(lds + PG8_SA(b, h) + aoff + m * 2048 + k * 1024); } while (0)
#define PG8_LDB(dst, b, h) do { _Pragma("unroll") for (int n = 0; n < 2; ++n) _Pragma("unroll") for (int k = 0; k < 2; ++k) dst[n][k] = *(const PG8_LAS bf16x8*)(lds + PG8_SB(b, h) + boff + n * 2048 + k * 1024); } while (0)
#define PG8_MMA(ai, bj, At, Bt) do { __builtin_amdgcn_s_setprio(1); _Pragma("unroll") for (int m = 0; m < 4; ++m) _Pragma("unroll") for (int n = 0; n < 2; ++n) _Pragma("unroll") for (int k = 0; k < 2; ++k) \
        acc[ai][bj][m][n] = __builtin_amdgcn_mfma_f32_16x16x32_bf16(Bt[n][k], At[m][k], acc[ai][bj][m][n], 0, 0, 0); __builtin_amdgcn_s_setprio(0); } while (0)
#define PG8_WAIT_V(n) asm volatile("s_waitcnt vmcnt(" #n ")" ::: "memory")
#define PG8_WAIT_L(n) asm volatile("s_waitcnt lgkmcnt(" #n ")" ::: "memory")
#define PG8_BAR __builtin_amdgcn_s_barrier()
#define PG8_SCHED __builtin_amdgcn_sched_barrier(0)
    Unit cur, nxt; int ui = 0;
    if (!S.next(0, cur)) return;
    f32x4 acc[2][2][4][2];
#pragma unroll
    for (int a = 0; a < 2; ++a)
#pragma unroll
        for (int b = 0; b < 2; ++b)
#pragma unroll
            for (int m = 0; m < 4; ++m)
#pragma unroll
                for (int n = 0; n < 2; ++n) acc[a][b][m][n] = (f32x4){0.f, 0.f, 0.f, 0.f};
    bf16x8 At[4][2], B0[2][2], B1[2][2];
    const char* cA = (const char*)g.A + (size_t)cur.pm * tstepA; const char* cB = (const char*)g.Bt + (size_t)cur.pn * tstepB;
    S.a_ready(cur);
    if constexpr (SP2) {
        PG8_STAGE(PG8_SB(0, 0), cB, voffB); PG8_STAGE(PG8_SB(0, 1), cB + hstepB, voffB); PG8_STAGE(PG8_SA(0, 0), cA, voffA); PG8_STAGE(PG8_SA(0, 1), cA + hstepA, voffA);
        if (wr == 1) PG8_BAR;
        PG8_WAIT_V(2); PG8_BAR;
        PG8_STAGE(PG8_SB(1, 0), cB + kstep, voffB); PG8_STAGE(PG8_SA(1, 0), cA + kstep, voffA); PG8_STAGE(PG8_SB(1, 1), cB + hstepB + kstep, voffB);
        PG8_WAIT_V(6); PG8_BAR;
    } else {
        PG8_STAGE(PG8_SB(0, 0), cB, voffB); PG8_STAGE(PG8_SA(0, 0), cA, voffA); PG8_STAGE(PG8_SB(0, 1), cB + hstepB, voffB); PG8_STAGE(PG8_SA(0, 1), cA + hstepA, voffA);
        if (wr == 1) PG8_BAR;
        PG8_WAIT_V(4); PG8_BAR;
        PG8_STAGE(PG8_SB(1, 0), cB + kstep, voffB); PG8_STAGE(PG8_SA(1, 0), cA + kstep, voffA); PG8_STAGE(PG8_SB(1, 1), cB + hstepB + kstep, voffB);
        PG8_WAIT_V(6); PG8_BAR;
    }
    for (;;) {
        const bool has_next = S.next(ui + 1, nxt);
        const char* nA = has_next ? (const char*)g.A + (size_t)nxt.pm * tstepA : cA; const char* nB = has_next ? (const char*)g.Bt + (size_t)nxt.pn * tstepB : cB;
        for (int t = 0; t < nt; t += 2) {
            const bool last = (t == nt - 2);
            const char* a1 = cA + (size_t)(t + 1) * kstep;
            const char* a2 = last ? nA : cA + (size_t)(t + 2) * kstep; const char* b2 = last ? nB : cB + (size_t)(t + 2) * kstep;
            const char* a3 = a2 + kstep; const char* b3 = b2 + kstep;
            if (last && has_next) S.a_ready(nxt);
            if constexpr (SP2) {
            PG8_LDB(B0, 0, 0); PG8_LDB(B1, 0, 1); PG8_SCHED; PG8_LDA(At, 0, 0); PG8_STAGE(PG8_SA(1, 1), a1 + hstepA, voffA);
            PG8_WAIT_V(8); PG8_WAIT_L(0); PG8_BAR; PG8_MMA(0, 0, At, B0); PG8_MMA(0, 1, At, B1); PG8_BAR; PG8_SCHED;
            PG8_LDA(At, 0, 1); PG8_STAGE(PG8_SB(0, 0), b2, voffB); PG8_STAGE(PG8_SB(0, 1), b2 + hstepB, voffB); PG8_STAGE(PG8_SA(0, 0), a2, voffA);
            PG8_WAIT_V(8); PG8_WAIT_L(0); PG8_BAR; PG8_MMA(1, 0, At, B0); PG8_MMA(1, 1, At, B1); PG8_BAR; PG8_SCHED;
            PG8_LDB(B0, 1, 0); PG8_LDB(B1, 1, 1); PG8_SCHED; PG8_LDA(At, 1, 0); PG8_STAGE(PG8_SA(0, 1), a2 + hstepA, voffA);
            PG8_WAIT_V(8); PG8_WAIT_L(0); PG8_BAR; PG8_MMA(0, 0, At, B0); PG8_MMA(0, 1, At, B1); PG8_BAR; PG8_SCHED;
            PG8_LDA(At, 1, 1); PG8_STAGE(PG8_SB(1, 0), b3, voffB); PG8_STAGE(PG8_SB(1, 1), b3 + hstepB, voffB); PG8_STAGE(PG8_SA(1, 0), a3, voffA);
            PG8_WAIT_V(8); PG8_WAIT_L(0); PG8_BAR; PG8_MMA(1, 0, At, B0); PG8_MMA(1, 1, At, B1); PG8_BAR; PG8_SCHED;
            } else {
            PG8_LDB(B0, 0, 0); PG8_SCHED; PG8_LDA(At, 0, 0); PG8_STAGE(PG8_SA(1, 1), a1 + hstepA, voffA);
            PG8_WAIT_L(8); PG8_BAR; PG8_WAIT_L(0); PG8_MMA(0, 0, At, B0); PG8_BAR; PG8_SCHED;
            PG8_LDB(B1, 0, 1); PG8_STAGE(PG8_SB(0, 0), b2, voffB);
            PG8_BAR; PG8_WAIT_L(0); PG8_MMA(0, 1, At, B1); PG8_BAR;
            PG8_LDA(At, 0, 1); PG8_STAGE(PG8_SA(0, 0), a2, voffA);
            PG8_BAR; PG8_WAIT_L(0); PG8_MMA(1, 0, At, B0); PG8_BAR; PG8_SCHED;
            PG8_STAGE(PG8_SB(0, 1), b2 + hstepB, voffB);
            PG8_WAIT_V(6); PG8_BAR; PG8_MMA(1, 1, At, B1); PG8_BAR;
            PG8_LDB(B0, 1, 0); PG8_SCHED; PG8_LDA(At, 1, 0); PG8_STAGE(PG8_SA(0, 1), a2 + hstepA, voffA);
            PG8_WAIT_L(8); PG8_BAR; PG8_WAIT_L(0); PG8_MMA(0, 0, At, B0); PG8_BAR; PG8_SCHED;
            PG8_LDB(B1, 1, 1); PG8_STAGE(PG8_SB(1, 0), b3, voffB);
            PG8_BAR; PG8_WAIT_L(0); PG8_MMA(0, 1, At, B1); PG8_BAR;
            PG8_LDA(At, 1, 1); PG8_STAGE(PG8_SA(1, 0), a3, voffA);
            PG8_BAR; PG8_WAIT_L(0); PG8_MMA(1, 0, At, B0); PG8_BAR; PG8_SCHED;
            PG8_STAGE(PG8_SB(1, 1), b3 + hstepB, voffB);
            PG8_WAIT_V(6); PG8_BAR; PG8_MMA(1, 1, At, B1); PG8_BAR;
            }
        }
        if constexpr (ALIGN_EPI) { if (wr == 0) PG8_BAR; }
        if constexpr (!Epi::AFTER_DRAIN) { E(acc, cur, wr, wc, fr, fq); S.done(cur); }
        if (!has_next) break;
#pragma unroll
        for (int a = 0; a < 2; ++a)
#pragma unroll
            for (int b = 0; b < 2; ++b)
#pragma unroll
                for (int m = 0; m < 4; ++m)
#pragma unroll
                    for (int n = 0; n < 2; ++n) acc[a][b][m][n] = (f32x4){0.f, 0.f, 0.f, 0.f};
        cur = nxt; cA = nA; cB = nB; ++ui;
        if constexpr (ALIGN_EPI) { if (wr == 1) PG8_BAR; }
    }
    PG8_WAIT_V(0);
    if constexpr (!ALIGN_EPI) { if (wr == 0) PG8_BAR; }
    PG8_BAR;
    if constexpr (Epi::AFTER_DRAIN) { E.fused(acc, cur, wr, wc, fr, fq, lds, wid, lane); S.done(cur); }
#undef PG8_SA
#undef PG8_SB
#undef PG8_STAGE
#undef PG8_LDA
#undef PG8_LDB
#undef PG8_MMA
#undef PG8_WAIT_V
#undef PG8_WAIT_L
#undef PG8_BAR
#undef PG8_SCHED
}
}

constexpr int NWAVES = 8;
#ifndef MK_PER_PHASE
#define MK_PER_PHASE 1
#endif
constexpr int DM = 2048, FF = 5632, NL = 4, MTOK = 32768, MPROMPT = 16384, TP = 2048, TS = 4096;
constexpr int INC = 5120, NAW = 512, HGW = 512, S5W = 1024;
constexpr float EPS = 1e-6f;
constexpr int PH_PER_LAYER = 13, N_PHASES = NL * PH_PER_LAYER;

constexpr size_t MiB = 1u << 20;
constexpr size_t WS_CTL = 0, CTL_ZERO_BYTES = 1 * MiB;
constexpr size_t WS_TAB = 1 * MiB;
constexpr size_t WS_WGU1 = 2 * MiB, WS_WD1 = 46 * MiB, WS_WIN = 68 * MiB, WS_WGLU = 88 * MiB, WS_WOUT = 90 * MiB, WS_WGU2 = 98 * MiB, WS_WD2 = 142 * MiB;
constexpr size_t WS_XB = 164 * MiB;
constexpr size_t WS_H = 292 * MiB;
constexpr size_t WS_Q = 292 * MiB, WS_K = 324 * MiB, WS_V = 356 * MiB, WS_QH = 388 * MiB, WS_VH = 420 * MiB, WS_GH = 452 * MiB, WS_LFF = 484 * MiB, WS_LFB = 548 * MiB;
constexpr size_t WS_UX = 644 * MiB;
constexpr size_t WS_CAT = 772 * MiB;
constexpr size_t WS_YPRE = 900 * MiB, WS_Y2 = 964 * MiB;
constexpr size_t WS_O = 1028 * MiB;
constexpr size_t WS_OF = 1060 * MiB, WS_OB = 1124 * MiB;
constexpr size_t WS_YF = 1188 * MiB;
constexpr size_t WS_END = 1316 * MiB;
constexpr int CW_TMO = 0, CW_CODE = 1, CW_BAR = 4096;

constexpr int RING_OFF = 0, RING_BYTES = 131072;
constexpr int LDSCTL_OFF = RING_BYTES, MISC_OFF = LDSCTL_OFF + 320;
constexpr int LDS_BYTES = 147456;

#define GAS __attribute__((address_space(1)))
#define LAS __attribute__((address_space(3)))
typedef unsigned short bf16;
typedef unsigned v4u __attribute__((ext_vector_type(4)));
typedef unsigned v2u __attribute__((ext_vector_type(2)));
typedef float f32x4 __attribute__((ext_vector_type(4)));
typedef short bf16x8 __attribute__((ext_vector_type(8)));
typedef GAS unsigned gu32;
#define RLX_AGENT __ATOMIC_RELAXED, __HIP_MEMORY_SCOPE_AGENT
#define LDS_WAIT() asm volatile("s_waitcnt lgkmcnt(0)" ::: "memory")
#define VM_WAIT() asm volatile("s_waitcnt vmcnt(0)" ::: "memory")
__device__ __forceinline__ unsigned f2bf(float f) { unsigned u = __builtin_bit_cast(unsigned, f); return (u + 0x7fffu + ((u >> 16) & 1u)) >> 16; }
__device__ __forceinline__ unsigned pk2(float lo, float hi) { return f2bf(lo) | (f2bf(hi) << 16); }
__device__ __forceinline__ float bflo(unsigned w) { return __builtin_bit_cast(float, w << 16); }
__device__ __forceinline__ float bfhi(unsigned w) { return __builtin_bit_cast(float, w & 0xffff0000u); }
__device__ __forceinline__ float bf2f(bf16 b) { return __builtin_bit_cast(float, ((unsigned)b) << 16); }
__device__ __forceinline__ float fast_rcp(float x) { return __builtin_amdgcn_rcpf(x); }
__device__ __forceinline__ float sigmoidf_(float x) { return fast_rcp(1.0f + __expf(-x)); }
__device__ __forceinline__ float siluf_(float x) { return x * sigmoidf_(x); }
__device__ __forceinline__ float gelu_tanh(float x) {
    const float t = 1.5957691216057308f * (x + 0.044715f * x * x * x);
    return x * sigmoidf_(t);
}
__device__ __forceinline__ float wave_sum(float v) {
#pragma unroll
    for (int o = 1; o < 64; o <<= 1) v += __shfl_xor(v, o);
    return v;
}
__device__ __forceinline__ float wave_max(float v) {
#pragma unroll
    for (int o = 1; o < 64; o <<= 1) v = fmaxf(v, __shfl_xor(v, o));
    return v;
}
#define XB_TMO      128
#define XB_XCNT(j)  (256  + 64 * (j))
#define XB_XSUB(j)  (1280 + 64 * (j))
#define XB_XGEN(j)  (2304 + 64 * (j))
#define XB_TOP      3328
#define XB_TOPGEN   3392
#define XCD_BAR_WORDS 3456
#define XB_SPIN_CAP (1u << 18)

__device__ __forceinline__ unsigned xb_ld(unsigned* p)              { return __hip_atomic_load(p, __ATOMIC_RELAXED, __HIP_MEMORY_SCOPE_AGENT); }
__device__ __forceinline__ unsigned xb_add(unsigned* p, unsigned v) { return __hip_atomic_fetch_add(p, v, __ATOMIC_RELAXED, __HIP_MEMORY_SCOPE_AGENT); }
__device__ __forceinline__ unsigned xb_xcc_id() { return (unsigned)__builtin_amdgcn_s_getreg((3 << 11) | 20) & 0xFu; }
#define XB_SPIN(cond, bar) do { unsigned _sp = 0; while (cond) { __builtin_amdgcn_s_sleep(1); \
    if ((++_sp & 255u) == 0u) { if (xb_ld(&(bar)[XB_TMO])) break; if (_sp > XB_SPIN_CAP) { atomicAdd(&(bar)[XB_TMO], 1u); break; } } } } while (0)

struct XcdBarrier {
    unsigned* bar; unsigned x;
    volatile LAS unsigned* st;
};

__device__ __forceinline__ XcdBarrier xcd_barrier_post(unsigned* bar, volatile LAS unsigned* st) {
    XcdBarrier b; b.bar = bar; b.x = xb_xcc_id(); b.st = st;
    if (threadIdx.x == 0) (void)xb_add(&bar[XB_XCNT(b.x)], 1u);
    return b;
}
__device__ __forceinline__ void xcd_barrier_complete(unsigned* bar, unsigned x, unsigned& nloc, unsigned& nx) {
    const unsigned G = gridDim.x * gridDim.y * gridDim.z;
    unsigned sum, cnt, mine, sp = 0u;
    for (;;) {
        sum = 0u; cnt = 0u; mine = 0u;
#pragma unroll
        for (unsigned j = 0; j < 16; ++j) { const unsigned c = xb_ld(&bar[XB_XCNT(j)]); sum += c; cnt += (c > 0u) ? 1u : 0u; mine = (j == x) ? c : mine; }
        if (sum == G) break;
        __builtin_amdgcn_s_sleep(1);
        if ((++sp & 255u) == 0u) { if (xb_ld(&bar[XB_TMO])) break; if (sp > XB_SPIN_CAP) { atomicAdd(&bar[XB_TMO], 1u); break; } }
    }
    nloc = mine > 0u ? mine : 1u; nx = cnt > 0u ? cnt : 1u;
}

__device__ __forceinline__ void xcd_barrier(const XcdBarrier& b) {
    asm volatile("s_waitcnt vmcnt(0)" ::: "memory");
    __syncthreads();
    if (threadIdx.x == 0) {
        unsigned* bar = b.bar;
        __builtin_amdgcn_s_waitcnt(0);
        unsigned nloc = b.st[0], nx = b.st[1];
        if (nloc == 0u) { xcd_barrier_complete(bar, b.x, nloc, nx); b.st[0] = nloc; b.st[1] = nx; }
        const unsigned old = xb_add(&bar[XB_XSUB(b.x)], 1u);
        const unsigned gen = old / nloc;
        if (old + 1u == (gen + 1u) * nloc) {
            __builtin_amdgcn_fence(__ATOMIC_RELEASE, "agent");
            asm volatile("s_waitcnt vmcnt(0)" ::: "memory");
            const unsigned og = xb_add(&bar[XB_TOP], 1u);
            const unsigned tg = og / nx;
            if (og + 1u == (tg + 1u) * nx) xb_add(&bar[XB_TOPGEN], 1u);
            else XB_SPIN(xb_ld(&bar[XB_TOPGEN]) == tg, bar);
            __builtin_amdgcn_fence(__ATOMIC_ACQUIRE, "agent");
            xb_add(&bar[XB_XGEN(b.x)], 1u);
            asm volatile("s_waitcnt vmcnt(0)" ::: "memory");
        } else {
            XB_SPIN(xb_ld(&bar[XB_XGEN(b.x)]) == gen, bar);
            __builtin_amdgcn_fence(__ATOMIC_ACQUIRE, "agent");
            asm volatile("s_waitcnt vmcnt(0)" ::: "memory");
        }
    }
    __syncthreads();
}

using pg8::Unit;
struct EpiSwiGLU {
    static constexpr bool PERM = true, AFTER_DRAIN = false;
    bf16* H;
    __device__ __forceinline__ void operator()(const f32x4 (&acc)[2][2][4][2], const Unit& u, int wr, int wc, int fr, int fq) const {
        const int row0 = u.pm * 256 + wr * 64 + fr, col0 = u.pn * 128 + wc * 32 + 8 * fq;
#pragma unroll
        for (int ai = 0; ai < 2; ++ai)
#pragma unroll
            for (int m = 0; m < 4; ++m) {
                bf16* rowp = H + (size_t)(row0 + ai * 128 + m * 16) * FF + col0;
                float h[8];
#pragma unroll
                for (int n = 0; n < 2; ++n)
#pragma unroll
                    for (int i = 0; i < 4; ++i) { const float g = acc[ai][0][m][n][i], uu = acc[ai][1][m][n][i]; h[4 * n + i] = siluf_(g) * uu; }
                v4u w; w.x = pk2(h[0], h[1]); w.y = pk2(h[2], h[3]); w.z = pk2(h[4], h[5]); w.w = pk2(h[6], h[7]);
                *(v4u*)rowp = w;
            }
    }
};
struct EpiResid {
    static constexpr bool PERM = false, AFTER_DRAIN = false;
    float* X; float scale;
    __device__ __forceinline__ void operator()(const f32x4 (&acc)[2][2][4][2], const Unit& u, int wr, int wc, int fr, int fq) const {
        const int row0 = u.pm * 256 + wr * 64 + fr, col0 = u.pn * 256 + wc * 32 + 4 * fq;
#pragma unroll
        for (int ai = 0; ai < 2; ++ai)
#pragma unroll
            for (int m = 0; m < 4; ++m) {
                float* rowp = X + (size_t)(row0 + ai * 128 + m * 16) * DM + col0;
#pragma unroll
                for (int bj = 0; bj < 2; ++bj)
#pragma unroll
                    for (int n = 0; n < 2; ++n) { f32x4* p = (f32x4*)(rowp + bj * 128 + n * 16); *p = *p + acc[ai][bj][m][n] * scale; }
            }
    }
};
struct EpiWin {
    static constexpr bool PERM = true, AFTER_DRAIN = false;
    bf16 *Q, *K, *V, *QH, *VH, *GH; float *LFF, *LFB; bf16* UX; const float *qn, *kn, *lb;
    __device__ __forceinline__ void operator()(const f32x4 (&acc)[2][2][4][2], const Unit& u, int wr, int wc, int fr, int fq) const {
        const int row0 = u.pm * 256 + wr * 64 + fr, pn = u.pn, seg = pn >> 1;
        const int cbase = (pn & 1) * 256 + 64 * wc + 8 * fq;
        if (seg <= 1) {
            const float* gn = seg == 0 ? qn : kn; bf16* dst = seg == 0 ? Q : K;
            float gv[2][8];
#pragma unroll
            for (int bj = 0; bj < 2; ++bj) { const f32x4 a = *(const f32x4*)(gn + 32 * bj + 8 * fq), b = *(const f32x4*)(gn + 32 * bj + 8 * fq + 4);
                gv[bj][0] = a[0]; gv[bj][1] = a[1]; gv[bj][2] = a[2]; gv[bj][3] = a[3]; gv[bj][4] = b[0]; gv[bj][5] = b[1]; gv[bj][6] = b[2]; gv[bj][7] = b[3]; }
#pragma unroll
            for (int ai = 0; ai < 2; ++ai)
#pragma unroll
                for (int m = 0; m < 4; ++m) {
                    float ss = 0.f;
#pragma unroll
                    for (int bj = 0; bj < 2; ++bj)
#pragma unroll
                        for (int n = 0; n < 2; ++n) { const f32x4 x = acc[ai][bj][m][n]; ss += (x[0] * x[0] + x[1] * x[1]) + (x[2] * x[2] + x[3] * x[3]); }
                    ss += __shfl_xor(ss, 16); ss += __shfl_xor(ss, 32);
                    const float rstd = 1.0f / sqrtf(ss * (1.0f / 64.0f) + EPS);
                    bf16* rowp = dst + (size_t)(row0 + ai * 128 + m * 16) * 512 + cbase;
#pragma unroll
                    for (int bj = 0; bj < 2; ++bj) { const f32x4 x0 = acc[ai][bj][m][0] * rstd, x1 = acc[ai][bj][m][1] * rstd; v4u w;
                        w.x = pk2(x0[0] * gv[bj][0], x0[1] * gv[bj][1]); w.y = pk2(x0[2] * gv[bj][2], x0[3] * gv[bj][3]); w.z = pk2(x1[0] * gv[bj][4], x1[1] * gv[bj][5]); w.w = pk2(x1[2] * gv[bj][6], x1[3] * gv[bj][7]);
                        *(v4u*)(rowp + 32 * bj) = w; }
                }
        } else if (seg == 2 || seg == 3 || seg == 6 || seg == 7) {
            bf16* dst = seg == 2 ? V : (seg == 3 ? QH : (seg == 6 ? VH : GH)); const bool act = (seg == 3 || seg == 7);
#pragma unroll
            for (int ai = 0; ai < 2; ++ai)
#pragma unroll
                for (int m = 0; m < 4; ++m) {
                    bf16* rowp = dst + (size_t)(row0 + ai * 128 + m * 16) * 512 + cbase;
#pragma unroll
                    for (int bj = 0; bj < 2; ++bj) { f32x4 x0 = acc[ai][bj][m][0], x1 = acc[ai][bj][m][1];
                        if (act) {
#pragma unroll
                            for (int i = 0; i < 4; ++i) { x0[i] = siluf_(x0[i]); x1[i] = siluf_(x1[i]); } }
                        v4u w; w.x = pk2(x0[0], x0[1]); w.y = pk2(x0[2], x0[3]); w.z = pk2(x1[0], x1[1]); w.w = pk2(x1[2], x1[3]);
                        *(v4u*)(rowp + 32 * bj) = w; }
                }
        } else if (seg == 4 || seg == 5) {
            float* dst = seg == 4 ? LFF : LFB; const float* lbp = lb + (seg - 4) * 512 + cbase;
            f32x4 lbv[2][2];
#pragma unroll
            for (int bj = 0; bj < 2; ++bj) { lbv[bj][0] = *(const f32x4*)(lbp + 32 * bj); lbv[bj][1] = *(const f32x4*)(lbp + 32 * bj + 4); }
#pragma unroll
            for (int ai = 0; ai < 2; ++ai)
#pragma unroll
                for (int m = 0; m < 4; ++m) {
                    float* rowp = dst + (size_t)(row0 + ai * 128 + m * 16) * 512 + cbase;
#pragma unroll
                    for (int bj = 0; bj < 2; ++bj)
#pragma unroll
                        for (int n = 0; n < 2; ++n) { f32x4 o;
#pragma unroll
                            for (int i = 0; i < 4; ++i) { const float l = lbv[bj][n][i]; o[i] = __logf(l + (1.0f - l) * sigmoidf_(acc[ai][bj][m][n][i])); }
                            *(f32x4*)(rowp + 32 * bj + 4 * n) = o; }
                }
        } else {
#pragma unroll
            for (int ai = 0; ai < 2; ++ai)
#pragma unroll
                for (int m = 0; m < 4; ++m) {
                    const int row = row0 + ai * 128 + m * 16;
#pragma unroll
                    for (int bj = 0; bj < 2; ++bj) { const int g = (pn - 16) * 16 + 4 * wc + 2 * bj + (fq >> 1);
                        bf16* p = UX + ((size_t)g * 2048 + (row >> 4)) * 512 + (row & 15) * 16 + 8 * (fq & 1);
                        const f32x4 x0 = acc[ai][bj][m][0], x1 = acc[ai][bj][m][1];
                        v4u w; w.x = pk2(x0[0], x0[1]); w.y = pk2(x0[2], x0[3]); w.z = pk2(x1[0], x1[1]); w.w = pk2(x1[2], x1[3]);
                        *(v4u*)p = w; }
                }
        }
    }
};
struct EpiGLU {
    static constexpr bool PERM = true, AFTER_DRAIN = false;
    const bf16* YPRE; const float* bias; bf16* Y2;
    __device__ __forceinline__ void operator()(const f32x4 (&acc)[2][2][4][2], const Unit& u, int wr, int wc, int fr, int fq) const {
        const int row0 = u.pm * 256 + wr * 64 + fr, col0 = u.pn * 256 + wc * 32 + 8 * fq;
        f32x4 bv[2][2];
#pragma unroll
        for (int bj = 0; bj < 2; ++bj) { bv[bj][0] = *(const f32x4*)(bias + col0 + bj * 128); bv[bj][1] = *(const f32x4*)(bias + col0 + bj * 128 + 4); }
#pragma unroll
        for (int ai = 0; ai < 2; ++ai)
#pragma unroll
            for (int m = 0; m < 4; ++m) {
                const size_t off = (size_t)(row0 + ai * 128 + m * 16) * S5W + col0;
#pragma unroll
                for (int bj = 0; bj < 2; ++bj) { const v4u yp = *(const v4u*)(YPRE + off + bj * 128);
                    const f32x4 z0 = acc[ai][bj][m][0] + bv[bj][0], z1 = acc[ai][bj][m][1] + bv[bj][1];
                    v4u w; w.x = pk2(bflo(yp.x) * sigmoidf_(z0[0]), bfhi(yp.x) * sigmoidf_(z0[1])); w.y = pk2(bflo(yp.y) * sigmoidf_(z0[2]), bfhi(yp.y) * sigmoidf_(z0[3]));
                    w.z = pk2(bflo(yp.z) * sigmoidf_(z1[0]), bfhi(yp.z) * sigmoidf_(z1[1])); w.w = pk2(bflo(yp.w) * sigmoidf_(z1[2]), bfhi(yp.w) * sigmoidf_(z1[3]));
                    *(v4u*)(Y2 + off + bj * 128) = w; }
            }
    }
};

struct Frame {
    LAS unsigned char* lds;
    volatile LAS unsigned* MISC;
    gu32* ctl;
    int tid, lane, wave, G, gw, NGW, bid;
    unsigned char* ws;
};
struct Args { const float* in[31]; float* out; unsigned char* ws; int ph_lo, ph_hi, li, pad; };
#define WSP(T, off) ((T*)(F.ws + (off)))
#define FA Frame& F, const Args& A

__device__ __forceinline__ void conv_item(const float* W, int Nsrc, int K, int src_col0, bf16* WT, int dst_row0, int k0, LAS float* scr, int lane) {
#pragma unroll 8
    for (int i = 0; i < 32; ++i) { const int kk = 2 * i + (lane >> 5); scr[kk * 33 + (lane & 31)] = W[(size_t)(k0 + kk) * Nsrc + src_col0 + (lane & 31)]; }
    LDS_WAIT(); asm volatile("" ::: "memory");
    const int c = lane & 7;
#pragma unroll
    for (int j = 0; j < 4; ++j) { const int n = (lane >> 3) + 8 * j; const LAS float* s = scr + (8 * c) * 33 + n;
        v4u o; o.x = pk2(s[0 * 33], s[1 * 33]); o.y = pk2(s[2 * 33], s[3 * 33]); o.z = pk2(s[4 * 33], s[5 * 33]); o.w = pk2(s[6 * 33], s[7 * 33]);
        *(GAS v4u*)(WT + (size_t)(dst_row0 + n) * K + k0 + 8 * c) = o; }
    LDS_WAIT(); asm volatile("" ::: "memory");
}
__device__ __forceinline__ void conv_layer(FA, int l) {
    LAS float* scr = (LAS float*)(F.lds + RING_OFF + F.wave * 16384);
    constexpr int I_GU = 32 * 352, I_D = 88 * 64, I_IN = 32 * 160, I_GLU = 16 * 32, I_OUT = 32 * 64;
    constexpr int NITEMS = 2 * I_GU + 2 * I_D + I_IN + I_GLU + I_OUT;
    const size_t wff = (size_t)DM * FF;
    for (int it = F.gw; it < NITEMS; it += F.NGW) {
        int r = it;
        if (r < 2 * I_GU) { const int second = r >= I_GU; if (second) r -= I_GU;
            const int kb = r / 352, nbd = r % 352, tile = nbd >> 3, pb = nbd & 7, bj = pb >> 2, sub = pb & 3;
            const float* W = A.in[second ? (bj ? 28 : 27) : (bj ? 4 : 3)] + (size_t)l * wff;
            conv_item(W, FF, DM, 128 * tile + 32 * sub, WSP(bf16, second ? WS_WGU2 : WS_WGU1), 32 * nbd, 64 * kb, scr, F.lane); continue; }
        r -= 2 * I_GU;
        if (r < 2 * I_D) { const int second = r >= I_D; if (second) r -= I_D;
            const int kb = r / 64, nbd = r % 64;
            conv_item(A.in[second ? 29 : 5] + (size_t)l * wff, DM, FF, 32 * nbd, WSP(bf16, second ? WS_WD2 : WS_WD1), 32 * nbd, 64 * kb, scr, F.lane); continue; }
        r -= 2 * I_D;
        if (r < I_IN) { const int kb = r / 160, nbd = r % 160, tile = nbd >> 3, pb = nbd & 7, bj = pb >> 2, wc = pb & 3;
            conv_item(A.in[7] + (size_t)l * DM * INC, INC, DM, 256 * tile + 32 * (2 * wc + bj), WSP(bf16, WS_WIN), 32 * nbd, 64 * kb, scr, F.lane); continue; }
        r -= I_IN;
        if (r < I_GLU) { const int kb = r / 32, nbd = r % 32;
            conv_item(A.in[22] + (size_t)l * S5W * S5W, S5W, S5W, 32 * nbd, WSP(bf16, WS_WGLU), 32 * nbd, 64 * kb, scr, F.lane); continue; }
        r -= I_GLU;
        { const int kb = r / 64, nbd = r % 64;
            conv_item(A.in[25] + (size_t)l * DM * DM, DM, DM, 32 * nbd, WSP(bf16, WS_WOUT), 32 * nbd, 64 * kb, scr, F.lane); }
    }
}
__device__ __forceinline__ void lb_table(FA) {
    float* LB = WSP(float, WS_TAB); const float* lg = A.in[12];
    for (int i = blockIdx.x * 512 + F.tid; i < 1024; i += F.G * 512) {
        float v[NL], mx = -1e30f;
#pragma unroll
        for (int l = 0; l < NL; ++l) { v[l] = lg[l * 1024 + i]; mx = fmaxf(mx, v[l]); }
        float s = 0.f;
#pragma unroll
        for (int l = 0; l < NL; ++l) { v[l] = expf(v[l] - mx); s += v[l]; }
        float c = 0.f;
#pragma unroll
        for (int l = 0; l < NL; ++l) { if (l > 0) c += v[l] / s; LB[l * 1024 + i] = c; }
    }
}
__device__ __forceinline__ const float* in_row(FA, int r) { return r < MPROMPT ? A.in[0] + (size_t)r * DM : A.in[1] + (size_t)(r - MPROMPT) * DM; }
template <bool FROM_INPUT>
__device__ __forceinline__ void norm_phase(FA, const float* gain) {
    bf16* XB = WSP(bf16, WS_XB);
    for (int r = F.gw; r < MTOK; r += F.NGW) {
        const float* src = FROM_INPUT ? in_row(F, A, r) : A.out + (size_t)r * DM;
        const f32x4* xr = (const f32x4*)src + F.lane; f32x4 v[8]; float s = 0.f;
#pragma unroll
        for (int j = 0; j < 8; ++j) { v[j] = xr[64 * j]; s += (v[j][0] * v[j][0] + v[j][1] * v[j][1]) + (v[j][2] * v[j][2] + v[j][3] * v[j][3]); }
        const float rstd = 1.0f / sqrtf(wave_sum(s) * (1.0f / DM) + EPS);
        if (FROM_INPUT) { f32x4* xo = (f32x4*)(A.out + (size_t)r * DM) + F.lane;
#pragma unroll
            for (int j = 0; j < 8; ++j) xo[64 * j] = v[j]; }
        v2u* o = (v2u*)(XB + (size_t)r * DM) + F.lane; const f32x4* gp = (const f32x4*)gain + F.lane;
#pragma unroll
        for (int j = 0; j < 8; ++j) { const f32x4 g = gp[64 * j]; v2u w; w.x = pk2(v[j][0] * rstd * g[0], v[j][1] * rstd * g[1]); w.y = pk2(v[j][2] * rstd * g[2], v[j][3] * rstd * g[3]); o[64 * j] = w; }
    }
}
__device__ __forceinline__ void final_norm_phase(FA, const float* gfin, const float* gnext) {
    bf16* XB = WSP(bf16, WS_XB);
    for (int r = F.gw; r < MTOK; r += F.NGW) {
        f32x4* xr = (f32x4*)(A.out + (size_t)r * DM) + F.lane; f32x4 v[8]; float s = 0.f;
#pragma unroll
        for (int j = 0; j < 8; ++j) { v[j] = xr[64 * j]; s += (v[j][0] * v[j][0] + v[j][1] * v[j][1]) + (v[j][2] * v[j][2] + v[j][3] * v[j][3]); }
        const float rstd = 1.0f / sqrtf(wave_sum(s) * (1.0f / DM) + EPS);
        const f32x4* gp = (const f32x4*)gfin + F.lane; float s2 = 0.f;
#pragma unroll
        for (int j = 0; j < 8; ++j) { v[j] = v[j] * rstd * gp[64 * j]; xr[64 * j] = v[j]; s2 += (v[j][0] * v[j][0] + v[j][1] * v[j][1]) + (v[j][2] * v[j][2] + v[j][3] * v[j][3]); }
        if (gnext) {
            const float rstd2 = 1.0f / sqrtf(wave_sum(s2) * (1.0f / DM) + EPS);
            v2u* o = (v2u*)(XB + (size_t)r * DM) + F.lane; const f32x4* gq = (const f32x4*)gnext + F.lane;
#pragma unroll
            for (int j = 0; j < 8; ++j) { const f32x4 g = gq[64 * j]; v2u w; w.x = pk2(v[j][0] * rstd2 * g[0], v[j][1] * rstd2 * g[1]); w.y = pk2(v[j][2] * rstd2 * g[2], v[j][3] * rstd2 * g[3]); o[64 * j] = w; }
        }
    }
}
__device__ __forceinline__ void seq_of_row(int r, int& base, int& t, int& rows) {
    if (r < MPROMPT) { base = r & ~(TP - 1); t = r & (TP - 1); rows = TP / 64; } else { const int q = r - MPROMPT; base = MPROMPT + (q & ~(TS - 1)); t = q & (TS - 1); rows = TS / 64; }
}
__device__ __forceinline__ void seq_of_index(int s, int& base, int& T) { if (s < 8) { base = s * TP; T = TP; } else { base = MPROMPT + (s - 8) * TS; T = TS; } }

__device__ __forceinline__ void naive_na(FA, const float* relb, int w0, int nw) {
    const bf16* Q = WSP(bf16, WS_Q); const bf16* K = WSP(bf16, WS_K); const bf16* V = WSP(bf16, WS_V); bf16* O = WSP(bf16, WS_O);
    const int lane = F.lane;
    for (int task = w0; task < MTOK * 8; task += nw) {
        const int r = task >> 3, h = task & 7; int base, t, rows; seq_of_row(r, base, t, rows);
        const int gr = t >> 6, gc = t & 63, rs = min(max(gr - 4, 0), rows - 8), cs = min(max(gc - 8, 0), 48);
        float sc[2];
#pragma unroll
        for (int kk = 0; kk < 2; ++kk) { const int j = lane + 64 * kk, a = j >> 4, kc = j & 15, tok = base + (rs + a) * 64 + cs + kc;
            const v4u* qp = (const v4u*)(Q + (size_t)r * 512 + h * 64); const v4u* kp = (const v4u*)(K + (size_t)tok * 512 + h * 64); float d = 0.f;
#pragma unroll
            for (int i = 0; i < 8; ++i) { const v4u a4 = qp[i], b4 = kp[i];
                d += bflo(a4.x) * bflo(b4.x) + bfhi(a4.x) * bfhi(b4.x) + bflo(a4.y) * bflo(b4.y) + bfhi(a4.y) * bfhi(b4.y) + bflo(a4.z) * bflo(b4.z) + bfhi(a4.z) * bfhi(b4.z) + bflo(a4.w) * bflo(b4.w) + bfhi(a4.w) * bfhi(b4.w); }
            const int dr = rs + a - gr, dc = cs + kc - gc;
            sc[kk] = d * 0.125f + relb[(h * 15 + dr + 7) * 31 + dc + 15]; }
        const float mx = wave_max(fmaxf(sc[0], sc[1]));
        const float e0 = __expf(sc[0] - mx), e1 = __expf(sc[1] - mx), inv = 1.0f / wave_sum(e0 + e1);
        const float p0 = e0 * inv, p1 = e1 * inv; float o = 0.f;
        for (int j = 0; j < 128; ++j) { const float pj = __shfl(j < 64 ? p0 : p1, j & 63); const int tok = base + (rs + (j >> 4)) * 64 + cs + (j & 15);
            o += pj * bf2f(V[(size_t)tok * 512 + h * 64 + lane]); }
        O[(size_t)r * 512 + h * 64 + lane] = (bf16)f2bf(o);
    }
}
__device__ __forceinline__ void naive_hgrn(FA, int w0, int nw) {
    const bf16* QH = WSP(bf16, WS_QH); const bf16* VH = WSP(bf16, WS_VH);
    for (int task = w0; task < 12 * 4 * 2 * 2; task += nw) {
        const int vh = task & 1, dir = (task >> 1) & 1, head = (task >> 2) & 3, s = task >> 4; int base, T; seq_of_index(s, base, T);
        const float* LF = dir ? WSP(float, WS_LFB) : WSP(float, WS_LFF); float* OUT = dir ? WSP(float, WS_OB) : WSP(float, WS_OF);
        const int col = head * 128 + vh * 64 + F.lane;
        float S[128];
#pragma unroll
        for (int d = 0; d < 128; ++d) S[d] = 0.f;
        for (int step = 0; step < T; ++step) {
            const int row = base + (dir ? T - 1 - step : step);
            const f32x4* lf = (const f32x4*)(LF + (size_t)row * 512 + head * 128); const v4u* qp = (const v4u*)(QH + (size_t)row * 512 + head * 128);
            const float vv = bf2f(VH[(size_t)row * 512 + col]); float o = 0.f;
#pragma unroll
            for (int d8 = 0; d8 < 16; ++d8) { const f32x4 l0 = lf[2 * d8], l1 = lf[2 * d8 + 1]; const v4u q4 = qp[d8];
                const float q[8] = {bflo(q4.x), bfhi(q4.x), bflo(q4.y), bfhi(q4.y), bflo(q4.z), bfhi(q4.z), bflo(q4.w), bfhi(q4.w)};
#pragma unroll
                for (int i = 0; i < 8; ++i) { const float f = __expf(i < 4 ? l0[i] : l1[i - 4]); const int d = 8 * d8 + i; S[d] = f * S[d] + (1.0f - f) * vv; o += q[i] * S[d]; } }
            OUT[(size_t)row * 512 + col] = o;
        }
    }
}
__device__ __forceinline__ void naive_s5(FA, int l, int w0, int nw) {
    const bf16* UX = WSP(bf16, WS_UX); float* YF = WSP(float, WS_YF); bf16* YPRE = WSP(bf16, WS_YPRE);
    const int lane = F.lane;
    for (int task = w0; task < 12 * 64; task += nw) {
        const int g = task & 63, s = task >> 6; int base, T; seq_of_index(s, base, T);
        const float dsk = A.in[21][l * 1024 + g * 16 + (lane & 15)];
        for (int dir = 0; dir < 2; ++dir) {
            const int pi = ((l * 2 + dir) * 64 + g) * 64 + lane;
            const float are = A.in[14][pi], aim = A.in[15][pi], dt = expf(A.in[16][(l * 2 + dir) * 64 + g]);
            const float mag = expf(dt * are), ang = dt * aim, abr = mag * cosf(ang), abi = mag * sinf(ang);
            const float den = are * are + aim * aim, nr = abr - 1.0f, fre = (nr * are + abi * aim) / den, fim = (abi * are - nr * aim) / den;
            float bbr[16], bbi[16], cr[16], ci[16];
#pragma unroll
            for (int c = 0; c < 16; ++c) { const float br = A.in[17][(size_t)pi * 16 + c], bi = A.in[18][(size_t)pi * 16 + c];
                bbr[c] = fre * br - fim * bi; bbi[c] = fre * bi + fim * br;
                const size_t ciix = ((size_t)((l * 2 + dir) * 64 + g) * 16 + c) * 64 + lane; cr[c] = A.in[19][ciix]; ci[c] = A.in[20][ciix]; }
            float xr = 0.f, xi = 0.f;
            for (int step = 0; step < T; ++step) {
                const int row = base + (dir ? T - 1 - step : step);
                const bf16* up = UX + ((size_t)g * 2048 + (row >> 4)) * 512 + (row & 15) * 16;
                const v4u u0 = *(const v4u*)up, u1 = *(const v4u*)(up + 8);
                const float uu[16] = {bflo(u0.x), bfhi(u0.x), bflo(u0.y), bfhi(u0.y), bflo(u0.z), bfhi(u0.z), bflo(u0.w), bfhi(u0.w), bflo(u1.x), bfhi(u1.x), bflo(u1.y), bfhi(u1.y), bflo(u1.z), bfhi(u1.z), bflo(u1.w), bfhi(u1.w)};
                float bur = 0.f, bui = 0.f;
#pragma unroll
                for (int c = 0; c < 16; ++c) { bur += bbr[c] * uu[c]; bui += bbi[c] * uu[c]; }
                const float nxr = abr * xr - abi * xi + bur, nxi = abr * xi + abi * xr + bui; xr = nxr; xi = nxi;
                float my = 0.f;
#pragma unroll
                for (int c = 0; c < 16; ++c) { const float v = wave_sum(cr[c] * xr - ci[c] * xi); my = (lane == c) ? v : my; }
                if (lane < 16) { const size_t o = (size_t)row * 1024 + g * 16 + lane;
                    if (dir == 0) YF[o] = my; else { const float tot = YF[o] + my + dsk * bf2f(up[lane]); YPRE[o] = (bf16)f2bf(gelu_tanh(tot)); } }
            }
        }
    }
}
__device__ __forceinline__ void post_phase(FA, int l) {
    const bf16* O = WSP(bf16, WS_O); const float* OF = WSP(float, WS_OF); const float* OB = WSP(float, WS_OB); const bf16* GH = WSP(bf16, WS_GH); const bf16* Y2 = WSP(bf16, WS_Y2); bf16* CAT = WSP(bf16, WS_CAT);
    const float* ga = A.in[11] + l * 512; const float* gb = A.in[13] + l * 512; const float* gc = A.in[24] + l * 1024; const int lane = F.lane;
    for (int r = F.gw; r < MTOK; r += F.NGW) {
        {
            const v4u w = *(const v4u*)(O + (size_t)r * 512 + 8 * lane); float x[8] = {bflo(w.x), bfhi(w.x), bflo(w.y), bfhi(w.y), bflo(w.z), bfhi(w.z), bflo(w.w), bfhi(w.w)}; float s = 0.f;
#pragma unroll
            for (int i = 0; i < 8; ++i) s += x[i] * x[i];
            const float rstd = 1.0f / sqrtf(wave_sum(s) * (1.0f / 512.0f) + EPS); const f32x4 g0 = *(const f32x4*)(ga + 8 * lane), g1 = *(const f32x4*)(ga + 8 * lane + 4);
            v4u o; o.x = pk2(x[0] * rstd * g0[0], x[1] * rstd * g0[1]); o.y = pk2(x[2] * rstd * g0[2], x[3] * rstd * g0[3]); o.z = pk2(x[4] * rstd * g1[0], x[5] * rstd * g1[1]); o.w = pk2(x[6] * rstd * g1[2], x[7] * rstd * g1[3]);
            *(v4u*)(CAT + (size_t)r * DM + 8 * lane) = o; }
        {
            const f32x4 a0 = *(const f32x4*)(OF + (size_t)r * 512 + 8 * lane), a1 = *(const f32x4*)(OF + (size_t)r * 512 + 8 * lane + 4), b0 = *(const f32x4*)(OB + (size_t)r * 512 + 8 * lane), b1 = *(const f32x4*)(OB + (size_t)r * 512 + 8 * lane + 4);
            const f32x4 x0 = a0 + b0, x1 = a1 + b1; float s = (x0[0] * x0[0] + x0[1] * x0[1]) + (x0[2] * x0[2] + x0[3] * x0[3]) + (x1[0] * x1[0] + x1[1] * x1[1]) + (x1[2] * x1[2] + x1[3] * x1[3]);
            s += __shfl_xor(s, 1); s += __shfl_xor(s, 2); s += __shfl_xor(s, 4); s += __shfl_xor(s, 8);
            const float rstd = 1.0f / sqrtf(s * (1.0f / 128.0f) + EPS); const f32x4 g0 = *(const f32x4*)(gb + 8 * lane), g1 = *(const f32x4*)(gb + 8 * lane + 4);
            const v4u gh = *(const v4u*)(GH + (size_t)r * 512 + 8 * lane);
            v4u o; o.x = pk2(x0[0] * rstd * g0[0] * bflo(gh.x), x0[1] * rstd * g0[1] * bfhi(gh.x)); o.y = pk2(x0[2] * rstd * g0[2] * bflo(gh.y), x0[3] * rstd * g0[3] * bfhi(gh.y));
            o.z = pk2(x1[0] * rstd * g1[0] * bflo(gh.z), x1[1] * rstd * g1[1] * bfhi(gh.z)); o.w = pk2(x1[2] * rstd * g1[2] * bflo(gh.w), x1[3] * rstd * g1[3] * bfhi(gh.w));
            *(v4u*)(CAT + (size_t)r * DM + 512 + 8 * lane) = o; }
        {
            float s = 0.f; v4u w[2];
#pragma unroll
            for (int hh = 0; hh < 2; ++hh) { w[hh] = *(const v4u*)(Y2 + (size_t)r * 1024 + 512 * hh + 8 * lane);
                s += bflo(w[hh].x) * bflo(w[hh].x) + bfhi(w[hh].x) * bfhi(w[hh].x) + bflo(w[hh].y) * bflo(w[hh].y) + bfhi(w[hh].y) * bfhi(w[hh].y) + bflo(w[hh].z) * bflo(w[hh].z) + bfhi(w[hh].z) * bfhi(w[hh].z) + bflo(w[hh].w) * bflo(w[hh].w) + bfhi(w[hh].w) * bfhi(w[hh].w); }
            const float rstd = 1.0f / sqrtf(wave_sum(s) * (1.0f / 1024.0f) + EPS);
#pragma unroll
            for (int hh = 0; hh < 2; ++hh) { const f32x4 g0 = *(const f32x4*)(gc + 512 * hh + 8 * lane), g1 = *(const f32x4*)(gc + 512 * hh + 8 * lane + 4);
                v4u o; o.x = pk2(bflo(w[hh].x) * rstd * g0[0], bfhi(w[hh].x) * rstd * g0[1]); o.y = pk2(bflo(w[hh].y) * rstd * g0[2], bfhi(w[hh].y) * rstd * g0[3]);
                o.z = pk2(bflo(w[hh].z) * rstd * g1[0], bfhi(w[hh].z) * rstd * g1[1]); o.w = pk2(bflo(w[hh].w) * rstd * g1[2], bfhi(w[hh].w) * rstd * g1[3]);
                *(v4u*)(CAT + (size_t)r * DM + 1024 + 512 * hh + 8 * lane) = o; } }
    }
}

__global__ void __launch_bounds__(NWAVES * 64, 2) enc_fwd(const Args A) {
    extern __shared__ __attribute__((aligned(16))) unsigned char lds[];
    Frame F;
    F.lds = (LAS unsigned char*)lds; F.MISC = (volatile LAS unsigned*)(F.lds + MISC_OFF);
    F.tid = threadIdx.x; F.lane = F.tid & 63; F.wave = __builtin_amdgcn_readfirstlane(F.tid >> 6);
    F.G = gridDim.x; F.gw = blockIdx.x * NWAVES + F.wave; F.NGW = F.G * NWAVES; F.bid = blockIdx.x; F.ws = A.ws;
    F.ctl = (gu32*)(A.ws + WS_CTL);
    for (int u = F.tid; u < (LDS_BYTES - LDSCTL_OFF) / 4; u += NWAVES * 64) ((LAS unsigned*)(F.lds + LDSCTL_OFF))[u] = 0u;
    __syncthreads();
    XcdBarrier bar; bar.bar = (unsigned*)(F.ctl + CW_BAR); bar.x = 0; bar.st = nullptr;
    if (!MK_PER_PHASE) bar = xcd_barrier_post((unsigned*)(F.ctl + CW_BAR), F.MISC + 8);
#define GRID_BAR() do { if (MK_PER_PHASE) { if (F.tid == 0) __hip_atomic_store(F.ctl + CW_TMO, 0xBADBA0u, RLX_AGENT); } else { xcd_barrier(bar); } } while (0)
    const int lo = A.ph_lo, hi = A.ph_hi;
#ifndef ONLY
#define ONLY -1
#endif
#define IN(k) ((ONLY < 0 || ((k) - p0) == ONLY) && lo <= (k) && (k) < hi)
#define SEAM(k) do { if (IN(k) && IN((k) + 1)) GRID_BAR(); } while (0)
    const int G = F.G;
#define PHASE_BEGIN() do { int t_ = threadIdx.x; asm volatile("" : "+v"(t_)); F.tid = t_; F.lane = t_ & 63; F.wave = __builtin_amdgcn_readfirstlane(t_ >> 6); \
        int b_ = blockIdx.x; asm volatile("" : "+v"(b_)); b_ = __builtin_amdgcn_readfirstlane(b_); F.bid = b_; F.gw = b_ * NWAVES + F.wave; \
        unsigned z_ = 0u; asm volatile("" : "+v"(z_)); z_ = (unsigned)__builtin_amdgcn_readfirstlane((int)z_); F.ws = A.ws + z_; } while (0)
    for (int l = 0; l < NL; ++l) {
        const int p0 = l * PH_PER_LAYER;
        if (IN(p0 + 0)) { PHASE_BEGIN();
            conv_layer(F, A, l);
            if (l == 0) { lb_table(F, A); norm_phase<true>(F, A, A.in[2]); }
        }
        SEAM(p0 + 0);
        if (IN(p0 + 1)) { PHASE_BEGIN(); pg8::Gemm g{WSP(bf16, WS_XB), WSP(bf16, WS_WGU1), MTOK, 2 * FF, DM, DM, DM}; pg8::StaticOrder S; S.init(MTOK, 2 * FF, G, F.bid);
            EpiSwiGLU E{WSP(bf16, WS_H)}; pg8::gemm_phase<EpiSwiGLU, pg8::StaticOrder, true, true>(F.lds + RING_OFF, g, S, E); }
        SEAM(p0 + 1);
        if (IN(p0 + 2)) { PHASE_BEGIN(); pg8::Gemm g{WSP(bf16, WS_H), WSP(bf16, WS_WD1), MTOK, DM, FF, FF, FF}; pg8::StaticOrder S; S.init(MTOK, DM, G, F.bid);
            EpiResid E{A.out, 0.5f}; pg8::gemm_phase<EpiResid, pg8::StaticOrder, true, true>(F.lds + RING_OFF, g, S, E); }
        SEAM(p0 + 2);
        if (IN(p0 + 3)) { PHASE_BEGIN(); norm_phase<false>(F, A, A.in[6] + l * DM); }
        SEAM(p0 + 3);
        if (IN(p0 + 4)) { PHASE_BEGIN(); pg8::Gemm g{WSP(bf16, WS_XB), WSP(bf16, WS_WIN), MTOK, INC, DM, DM, DM}; pg8::StaticOrder S; S.init(MTOK, INC, G, F.bid);
            EpiWin E{WSP(bf16, WS_Q), WSP(bf16, WS_K), WSP(bf16, WS_V), WSP(bf16, WS_QH), WSP(bf16, WS_VH), WSP(bf16, WS_GH), WSP(float, WS_LFF), WSP(float, WS_LFB), WSP(bf16, WS_UX),
                     A.in[8] + l * 64, A.in[9] + l * 64, WSP(float, WS_TAB) + l * 1024};
            pg8::gemm_phase<EpiWin, pg8::StaticOrder, true, true>(F.lds + RING_OFF, g, S, E); }
        SEAM(p0 + 4);
        if (IN(p0 + 5)) { PHASE_BEGIN();
#ifndef SKIP_S5
            if (F.gw < 768) naive_s5(F, A, l, F.gw, 768);
#endif
#ifndef SKIP_HG
            if (F.gw >= 768 && F.gw < 960) naive_hgrn(F, A, F.gw - 768, 192);
#endif
#ifndef SKIP_NA
            if (F.gw >= 960) naive_na(F, A, A.in[10] + l * (8 * 15 * 31), F.gw - 960, F.NGW - 960);
#endif
        }
        SEAM(p0 + 5);
        if (IN(p0 + 6)) { PHASE_BEGIN(); pg8::Gemm g{WSP(bf16, WS_YPRE), WSP(bf16, WS_WGLU), MTOK, S5W, S5W, S5W, S5W}; pg8::StaticOrder S; S.init(MTOK, S5W, G, F.bid);
            EpiGLU E{WSP(bf16, WS_YPRE), A.in[23] + l * S5W, WSP(bf16, WS_Y2)}; pg8::gemm_phase<EpiGLU, pg8::StaticOrder, true, true>(F.lds + RING_OFF, g, S, E); }
        SEAM(p0 + 6);
        if (IN(p0 + 7)) { PHASE_BEGIN(); post_phase(F, A, l); }
        SEAM(p0 + 7);
        if (IN(p0 + 8)) { PHASE_BEGIN(); pg8::Gemm g{WSP(bf16, WS_CAT), WSP(bf16, WS_WOUT), MTOK, DM, DM, DM, DM}; pg8::StaticOrder S; S.init(MTOK, DM, G, F.bid);
            EpiResid E{A.out, 1.0f}; pg8::gemm_phase<EpiResid, pg8::StaticOrder, true, true>(F.lds + RING_OFF, g, S, E); }
        SEAM(p0 + 8);
        if (IN(p0 + 9)) { PHASE_BEGIN(); norm_phase<false>(F, A, A.in[26] + l * DM); }
        SEAM(p0 + 9);
        if (IN(p0 + 10)) { PHASE_BEGIN(); pg8::Gemm g{WSP(bf16, WS_XB), WSP(bf16, WS_WGU2), MTOK, 2 * FF, DM, DM, DM}; pg8::StaticOrder S; S.init(MTOK, 2 * FF, G, F.bid);
            EpiSwiGLU E{WSP(bf16, WS_H)}; pg8::gemm_phase<EpiSwiGLU, pg8::StaticOrder, true, true>(F.lds + RING_OFF, g, S, E); }
        SEAM(p0 + 10);
        if (IN(p0 + 11)) { PHASE_BEGIN(); pg8::Gemm g{WSP(bf16, WS_H), WSP(bf16, WS_WD2), MTOK, DM, FF, FF, FF}; pg8::StaticOrder S; S.init(MTOK, DM, G, F.bid);
            EpiResid E{A.out, 0.5f}; pg8::gemm_phase<EpiResid, pg8::StaticOrder, true, true>(F.lds + RING_OFF, g, S, E); }
        SEAM(p0 + 11);
        if (IN(p0 + 12)) { PHASE_BEGIN(); final_norm_phase(F, A, A.in[30] + l * DM, l + 1 < NL ? A.in[2] + (l + 1) * DM : nullptr); }
        SEAM(p0 + 12);
    }
#undef IN
#undef SEAM
}

extern "C" void kernel_launch(void* const* d_in, const int* in_sizes, int n_in, void* d_out, int out_size, void* d_ws, size_t ws_size, hipStream_t stream) {
    static int grid = 0;
    if (grid == 0) {
        if (n_in != 31 || out_size != MTOK * DM || ws_size < WS_END) { fprintf(stderr, "kernel_launch: unexpected shapes: n_in %d out %d ws %zu (need %zu); nothing launched\n", n_in, out_size, ws_size, (size_t)WS_END); grid = -1; return; }
        int dev = 0, cus = 0, per_cu = 0;
        if (hipGetDevice(&dev) != hipSuccess || hipDeviceGetAttribute(&cus, hipDeviceAttributeMultiprocessorCount, dev) != hipSuccess) { grid = -1; return; }
        if (hipFuncSetAttribute((const void*)enc_fwd, hipFuncAttributeMaxDynamicSharedMemorySize, LDS_BYTES) != hipSuccess) { fprintf(stderr, "kernel_launch: hipFuncSetAttribute failed\n"); grid = -1; return; }
        if (hipOccupancyMaxActiveBlocksPerMultiprocessor(&per_cu, (const void*)enc_fwd, NWAVES * 64, LDS_BYTES) != hipSuccess || per_cu < 1)
            fprintf(stderr, "kernel_launch: note: occupancy query reports %d workgroups per CU\n", per_cu);
        (void)hipGetLastError();
        grid = cus;
    }
    if (grid < 0) return;
    if (hipMemsetAsync((char*)d_ws + WS_CTL, 0, CTL_ZERO_BYTES, stream) != hipSuccess) { fprintf(stderr, "kernel_launch: memset failed\n"); return; }
    Args a{};
    for (int i = 0; i < 31; ++i) a.in[i] = (const float*)d_in[i];
    a.out = (float*)d_out; a.ws = (unsigned char*)d_ws; a.li = 0; a.pad = 0;
#if MK_PER_PHASE
    for (int p = 0; p < N_PHASES; ++p) { a.ph_lo = p; a.ph_hi = p + 1; hipLaunchKernelGGL(enc_fwd, dim3(grid), dim3(NWAVES * 64), LDS_BYTES, stream, a); }
#else
    a.ph_lo = 0; a.ph_hi = N_PHASES; hipLaunchKernelGGL(enc_fwd, dim3(grid), dim3(NWAVES * 64), LDS_BYTES, stream, a);
#endif
    const hipError_t le = hipPeekAtLastError();
    if (le != hipSuccess) fprintf(stderr, "kernel_launch: launch failed: %s\n", hipGetErrorName(le));
}
```

```cpp
#include <hip/hip_runtime.h>
#include <cstdio>
#include <cstdint>
namespace pg8 {
#define PG8_LAS __attribute__((address_space(3)))
typedef unsigned short bf16_t;
typedef short bf16x8 __attribute__((ext_vector_type(8)));
typedef float f32x4 __attribute__((ext_vector_type(4)));
typedef unsigned u32x4 __attribute__((ext_vector_type(4)));
constexpr int BM = 256, BK = 64, HALF = 128, HTB = HALF * BK * 2  , STAGE_BYTES = 8 * HTB, NXCD = 8, WGM = 8;

__host__ __device__ __forceinline__ int lds_byte(int r, int c) { const int st = (r >> 4) * 2 + (c >> 5), rr = r & 15, cc = c & 31, ob = rr * 64 + cc * 2; return st * 1024 + (ob ^ (((ob >> 9) & 1) << 5)); }
__host__ __device__ __forceinline__ void stage_rc(int b, int& R, int& C) { const int st = b / 1024, sb = b % 1024, swz = sb ^ (((sb >> 9) & 1) << 5); R = (st >> 1) * 16 + swz / 64; C = (st & 1) * 32 + (swz % 64) / 2; }
__host__ __device__ __forceinline__ int perm32(int rho) { const int n = rho >> 4, i = rho & 15; return 8 * (i >> 2) + 4 * n + (i & 3); }

struct Unit { int pm, pn; };
struct Gemm { const bf16_t* A; const bf16_t* Bt; int M, N, K, lda, ldb; };

struct StaticOrder {
    int nM, nN, nwg, G, c, wgm;
    __host__ __device__ void init(int M, int N, int G_, int c_, int wgm_ = WGM) { nM = M / BM; nN = N / BM; nwg = nM * nN; G = G_; c = c_; wgm = wgm_; }
    __host__ __device__ bool next(int i, Unit& u) const {
        const long L = (long)i * G + c; if (L >= nwg) return false;
        int wgid = (int)L; { const int q = nwg / NXCD, r = nwg % NXCD, xcd = wgid % NXCD, off = wgid / NXCD; wgid = (xcd < r ? xcd * (q + 1) : r * (q + 1) + (xcd - r) * q) + off; }
        const int nig = wgm * nN, gid = wgid / nig, fm = gid * wgm, gsz = (nM - fm) < wgm ? (nM - fm) : wgm;
        u.pm = fm + ((wgid % nig) % gsz); u.pn = (wgid % nig) / gsz; return true;
    }
    __device__ __forceinline__ void a_ready(const Unit&) const {}
    __device__ __forceinline__ void done(const Unit&) const {}
};

template <class Epi, class Sched, bool ALIGN_EPI = false, bool SP2 = false>
__device__ __forceinline__ void gemm_phase(PG8_LAS unsigned char* lds, const Gemm g, const Sched& S, const Epi& E, int tid_in) {
    int tid_ = tid_in; asm volatile("" : "+v"(tid_));
    const int tid = tid_, wid = __builtin_amdgcn_readfirstlane(tid >> 6), lane = tid & 63, wr = wid >> 2, wc = wid & 3, fr = lane & 15, fq = lane >> 4;
    const int K = g.K, nt = K / BK;
    unsigned voffA[2], voffB[2];
#pragma unroll
    for (int i = 0; i < 2; ++i) { int R, C; stage_rc(tid * 16 + i * 8192, R, C); const int Rb = Epi::PERM ? ((R & ~31) + perm32(R & 31)) : R;
        voffA[i] = (unsigned)(R * g.lda + C) * 2u; voffB[i] = (unsigned)(Rb * g.ldb + C) * 2u; }
    const size_t kstep = (size_t)(BK * 2);
    const size_t hstepA = (size_t)HALF * g.lda * 2, hstepB = (size_t)HALF * g.ldb * 2;
    const size_t tstepA = 2 * hstepA, tstepB = 2 * hstepB;
    const unsigned ldsw = (unsigned)wid * 1024u;
    const int aoff = lds_byte(wr * 64 + fr, fq * 8), boff = lds_byte(wc * 32 + fr, fq * 8);
#define PG8_SA(b, h) (((b) * 2 + (h)) * HTB)
#define PG8_SB(b, h) ((4 + (b) * 2 + (h)) * HTB)
#define PG8_STAGE(bufoff, gbase, voff) do { _Pragma("unroll") for (int _i = 0; _i < 2; ++_i) \
        __builtin_amdgcn_global_load_lds((const unsigned*)((const char*)(gbase) + (voff)[_i]), (PG8_LAS unsigned*)(lds + (bufoff) + ldsw + _i * 8192), 16, 0, 0); } while (0)
#define PG8_LDA(dst, b, h) do { _Pragma("unroll") for (int m = 0; m < 4; ++m) _Pragma("unroll") for (int k = 0; k < 2; ++k) dst[m][k] = *(const PG8_LAS bf16x8*)(lds + PG8_SA(b, h) + aoff + m * 2048 + k * 1024); } while (0)
#define PG8_LDB(dst, b, h) do { _Pragma("unroll") for (int n = 0; n < 2; ++n) _Pragma("unroll") for (int k = 0; k < 2; ++k) dst[n][k] = *(const PG8_LAS bf16x8*)(lds + PG8_SB(b, h) + boff + n * 2048 + k * 1024); } while (0)
#define PG8_MMA(ai, bj, At, Bt) do { __builtin_amdgcn_s_setprio(1); _Pragma("unroll") for (int m = 0; m < 4; ++m) _Pragma("unroll") for (int n = 0; n < 2; ++n) _Pragma("unroll") for (int k = 0; k < 2; ++k) \
        acc[ai][bj][m][n] = __builtin_amdgcn_mfma_f32_16x16x32_bf16(Bt[n][k], At[m][k], acc[ai][bj][m][n], 0, 0, 0); __builtin_amdgcn_s_setprio(0); } while (0)
#define PG8_WAIT_V(n) asm volatile("s_waitcnt vmcnt(" #n ")" ::: "memory")
#define PG8_WAIT_L(n) asm volatile("s_waitcnt lgkmcnt(" #n ")" ::: "memory")
#define PG8_BAR __builtin_amdgcn_s_barrier()
#define PG8_SCHED __builtin_amdgcn_sched_barrier(0)
    Unit cur, nxt; int ui = 0;
    if (!S.next(0, cur)) return;
    f32x4 acc[2][2][4][2];
#pragma unroll
    for (int a = 0; a < 2; ++a)
#pragma unroll
        for (int b = 0; b < 2; ++b)
#pragma unroll
            for (int m = 0; m < 4; ++m)
#pragma unroll
                for (int n = 0; n < 2; ++n) acc[a][b][m][n] = (f32x4){0.f, 0.f, 0.f, 0.f};
    bf16x8 At[4][2], B0[2][2], B1[2][2];
    const char* cA = (const char*)g.A + (size_t)cur.pm * tstepA; const char* cB = (const char*)g.Bt + (size_t)cur.pn * tstepB;
    S.a_ready(cur);
    E.first(cur, lds, tid);
    if constexpr (SP2) {
        PG8_STAGE(PG8_SB(0, 0), cB, voffB); PG8_STAGE(PG8_SB(0, 1), cB + hstepB, voffB); PG8_STAGE(PG8_SA(0, 0), cA, voffA); PG8_STAGE(PG8_SA(0, 1), cA + hstepA, voffA);
        if (wr == 1) PG8_BAR;
        PG8_WAIT_V(2); PG8_BAR;
        PG8_STAGE(PG8_SB(1, 0), cB + kstep, voffB); PG8_STAGE(PG8_SA(1, 0), cA + kstep, voffA); PG8_STAGE(PG8_SB(1, 1), cB + hstepB + kstep, voffB);
        PG8_WAIT_V(6); PG8_BAR;
    } else {
        PG8_STAGE(PG8_SB(0, 0), cB, voffB); PG8_STAGE(PG8_SA(0, 0), cA, voffA); PG8_STAGE(PG8_SB(0, 1), cB + hstepB, voffB); PG8_STAGE(PG8_SA(0, 1), cA + hstepA, voffA);
        if (wr == 1) PG8_BAR;
        PG8_WAIT_V(4); PG8_BAR;
        PG8_STAGE(PG8_SB(1, 0), cB + kstep, voffB); PG8_STAGE(PG8_SA(1, 0), cA + kstep, voffA); PG8_STAGE(PG8_SB(1, 1), cB + hstepB + kstep, voffB);
        PG8_WAIT_V(6); PG8_BAR;
    }
    for (;;) {
        const bool has_next = S.next(ui + 1, nxt);
        const char* nA = has_next ? (const char*)g.A + (size_t)nxt.pm * tstepA : cA; const char* nB = has_next ? (const char*)g.Bt + (size_t)nxt.pn * tstepB : cB;
        for (int t = 0; t < nt; t += 2) {
            const bool last = (t == nt - 2);
            const char* a1 = cA + (size_t)(t + 1) * kstep;
            const char* a2 = last ? nA : cA + (size_t)(t + 2) * kstep; const char* b2 = last ? nB : cB + (size_t)(t + 2) * kstep;
            const char* a3 = a2 + kstep; const char* b3 = b2 + kstep;
            if (last && has_next) S.a_ready(nxt);
            if constexpr (SP2) {
            PG8_LDB(B0, 0, 0); PG8_LDB(B1, 0, 1); PG8_SCHED; PG8_LDA(At, 0, 0); PG8_STAGE(PG8_SA(1, 1), a1 + hstepA, voffA);
            PG8_WAIT_V(8); PG8_WAIT_L(0); PG8_BAR; PG8_MMA(0, 0, At, B0); PG8_MMA(0, 1, At, B1); PG8_BAR; PG8_SCHED;
            PG8_LDA(At, 0, 1); PG8_STAGE(PG8_SB(0, 0), b2, voffB); PG8_STAGE(PG8_SB(0, 1), b2 + hstepB, voffB); PG8_STAGE(PG8_SA(0, 0), a2, voffA);
            PG8_WAIT_V(8); PG8_WAIT_L(0); PG8_BAR; PG8_MMA(1, 0, At, B0); PG8_MMA(1, 1, At, B1); PG8_BAR; PG8_SCHED;
            PG8_LDB(B0, 1, 0); PG8_LDB(B1, 1, 1); PG8_SCHED; PG8_LDA(At, 1, 0); PG8_STAGE(PG8_SA(0, 1), a2 + hstepA, voffA);
            PG8_WAIT_V(8); PG8_WAIT_L(0); PG8_BAR; PG8_MMA(0, 0, At, B0); PG8_MMA(0, 1, At, B1); PG8_BAR; PG8_SCHED;
            PG8_LDA(At, 1, 1); PG8_STAGE(PG8_SB(1, 0), b3, voffB); PG8_STAGE(PG8_SB(1, 1), b3 + hstepB, voffB); PG8_STAGE(PG8_SA(1, 0), a3, voffA);
            PG8_WAIT_V(8); PG8_WAIT_L(0); PG8_BAR; PG8_MMA(1, 0, At, B0); PG8_MMA(1, 1, At, B1); PG8_BAR; PG8_SCHED;
            } else {
            PG8_LDB(B0, 0, 0); PG8_SCHED; PG8_LDA(At, 0, 0); PG8_STAGE(PG8_SA(1, 1), a1 + hstepA, voffA);
            PG8_WAIT_L(8); PG8_BAR; PG8_WAIT_L(0); PG8_MMA(0, 0, At, B0); PG8_BAR; PG8_SCHED;
            PG8_LDB(B1, 0, 1); PG8_STAGE(PG8_SB(0, 0), b2, voffB);
            PG8_BAR; PG8_WAIT_L(0); PG8_MMA(0, 1, At, B1); PG8_BAR;
            PG8_LDA(At, 0, 1); PG8_STAGE(PG8_SA(0, 0), a2, voffA);
            PG8_BAR; PG8_WAIT_L(0); PG8_MMA(1, 0, At, B0); PG8_BAR; PG8_SCHED;
            PG8_STAGE(PG8_SB(0, 1), b2 + hstepB, voffB);
            PG8_WAIT_V(6); PG8_BAR; PG8_MMA(1, 1, At, B1); PG8_BAR;
            PG8_LDB(B0, 1, 0); PG8_SCHED; PG8_LDA(At, 1, 0); PG8_STAGE(PG8_SA(0, 1), a2 + hstepA, voffA);
            PG8_WAIT_L(8); PG8_BAR; PG8_WAIT_L(0); PG8_MMA(0, 0, At, B0); PG8_BAR; PG8_SCHED;
            PG8_LDB(B1, 1, 1); PG8_STAGE(PG8_SB(1, 0), b3, voffB);
            PG8_BAR; PG8_WAIT_L(0); PG8_MMA(0, 1, At, B1); PG8_BAR;
            PG8_LDA(At, 1, 1); PG8_STAGE(PG8_SA(1, 0), a3, voffA);
            PG8_BAR; PG8_WAIT_L(0); PG8_MMA(1, 0, At, B0); PG8_BAR; PG8_SCHED;
            PG8_STAGE(PG8_SB(1, 1), b3 + hstepB, voffB);
            PG8_WAIT_V(6); PG8_BAR; PG8_MMA(1, 1, At, B1); PG8_BAR;
            }
        }
        if constexpr (ALIGN_EPI) { if (wr == 0) PG8_BAR; }
        if constexpr (!Epi::AFTER_DRAIN) { E(acc, cur, wr, wc, fr, fq, ui, has_next, nxt, lds, tid); S.done(cur); }
        if (!has_next) break;
#pragma unroll
        for (int a = 0; a < 2; ++a)
#pragma unroll
            for (int b = 0; b < 2; ++b)
#pragma unroll
                for (int m = 0; m < 4; ++m)
#pragma unroll
                    for (int n = 0; n < 2; ++n) acc[a][b][m][n] = (f32x4){0.f, 0.f, 0.f, 0.f};
        cur = nxt; cA = nA; cB = nB; ++ui;
        if constexpr (ALIGN_EPI) { if (wr == 1) PG8_BAR; }
    }
    PG8_WAIT_V(0);
    if constexpr (!ALIGN_EPI) { if (wr == 0) PG8_BAR; }
    PG8_BAR;
    if constexpr (Epi::AFTER_DRAIN) { E.fused(acc, cur, wr, wc, fr, fq, lds, wid, lane); S.done(cur); }
#undef PG8_SA
#undef PG8_SB
#undef PG8_STAGE
#undef PG8_LDA
#undef PG8_LDB
#undef PG8_MMA
#undef PG8_WAIT_V
#undef PG8_WAIT_L
#undef PG8_BAR
#undef PG8_SCHED
}
}

constexpr int NWAVES = 8;
#ifndef WGM_UP
#define WGM_UP 8
#endif
#ifndef WGM_DN
#define WGM_DN 4
#endif
#ifndef WGM_IN
#define WGM_IN 4
#endif
#ifndef MK_PER_PHASE
#define MK_PER_PHASE 0
#endif
constexpr int DM = 2048, FF = 5632, NL = 4, MTOK = 32768, MPROMPT = 16384, TP = 2048, TS = 4096;
constexpr int INC = 5120, NAW = 512, HGW = 512, S5W = 1024;
constexpr float EPS = 1e-6f;
constexpr int PH_PER_LAYER = 15, N_PHASES = NL * PH_PER_LAYER;

constexpr size_t MiB = 1u << 20;
constexpr size_t WS_CTL = 1475 * MiB, CTL_ZERO_BYTES = 1 * MiB;
constexpr size_t WS_TAB = 1 * MiB;
constexpr size_t WS_WGU1 = 2 * MiB, WS_WD1 = 46 * MiB, WS_WIN = 68 * MiB, WS_WGLU = 88 * MiB, WS_WOUT = 90 * MiB, WS_WGU2 = 98 * MiB, WS_WD2 = 142 * MiB;
constexpr size_t WS_XB = 164 * MiB;
constexpr size_t WS_H = 292 * MiB;
constexpr size_t WS_Q = 292 * MiB, WS_K = 324 * MiB, WS_V = 356 * MiB, WS_QH = 388 * MiB, WS_VH = 420 * MiB, WS_GH = 452 * MiB, WS_LFF = 484 * MiB, WS_LFB = 548 * MiB;
constexpr size_t WS_UX = 644 * MiB;
constexpr size_t WS_CAT = 772 * MiB;
constexpr size_t WS_YPRE = 900 * MiB, WS_Y2 = 964 * MiB;
constexpr size_t WS_O = 1028 * MiB;
constexpr size_t WS_OF = 1060 * MiB, WS_OB = 1124 * MiB;
constexpr size_t WS_YF = 1188 * MiB;
constexpr size_t WS_S5E = 1316 * MiB, WS_S5Y = 1324 * MiB;
constexpr size_t WS_E = WS_YF;
constexpr size_t WS_LT = WS_OF;
constexpr size_t WS_SIN = 1340 * MiB;
constexpr size_t WS_HD = 1468 * MiB;
constexpr size_t WS_SS = 1470 * MiB, SS_BYTES = 5 * MiB;
constexpr size_t WS_END = 1476 * MiB;
constexpr int CW_TMO = 0, CW_CODE = 1, CW_BAR = 4096;

constexpr int RING_OFF = 0, RING_BYTES = 131072;
constexpr int LDSCTL_OFF = RING_BYTES, MISC_OFF = LDSCTL_OFF + 320;
constexpr int LDS_BYTES = 147456;

#define GAS __attribute__((address_space(1)))
#define LAS __attribute__((address_space(3)))
typedef unsigned short bf16;
typedef unsigned v4u __attribute__((ext_vector_type(4)));
typedef unsigned v2u __attribute__((ext_vector_type(2)));
typedef float f32x4 __attribute__((ext_vector_type(4)));
typedef short bf16x8 __attribute__((ext_vector_type(8)));
typedef GAS unsigned gu32;
#define RLX_AGENT __ATOMIC_RELAXED, __HIP_MEMORY_SCOPE_AGENT
#define LDS_WAIT() asm volatile("s_waitcnt lgkmcnt(0)" ::: "memory")
#define VM_WAIT() asm volatile("s_waitcnt vmcnt(0)" ::: "memory")
__device__ __forceinline__ unsigned f2bf(float f) { unsigned u = __builtin_bit_cast(unsigned, f); return (u + 0x7fffu + ((u >> 16) & 1u)) >> 16; }
typedef float f32x2_t __attribute__((ext_vector_type(2)));
typedef __bf16 bf16x2_t __attribute__((ext_vector_type(2)));
__device__ __forceinline__ unsigned pk2(float lo, float hi) { const f32x2_t v = {lo, hi}; const bf16x2_t b = __builtin_convertvector(v, bf16x2_t); return __builtin_bit_cast(unsigned, b); }
__device__ __forceinline__ float bflo(unsigned w) { return __builtin_bit_cast(float, w << 16); }
__device__ __forceinline__ float bfhi(unsigned w) { return __builtin_bit_cast(float, w & 0xffff0000u); }
__device__ __forceinline__ float bf2f(bf16 b) { return __builtin_bit_cast(float, ((unsigned)b) << 16); }
__device__ __forceinline__ float fast_rcp(float x) { return __builtin_amdgcn_rcpf(x); }
__device__ __forceinline__ float fast_rsq(float x) { return __builtin_amdgcn_rsqf(x); }
__device__ __forceinline__ void fast_sincos(float x, float& s, float& c) { float r = x * 0.15915494309189535f; r = r - floorf(r); s = __builtin_amdgcn_sinf(r); c = __builtin_amdgcn_cosf(r); }
__device__ __forceinline__ float sigmoidf_(float x) { return fast_rcp(1.0f + __expf(-x)); }
__device__ __forceinline__ float siluf_(float x) { return x * sigmoidf_(x); }
__device__ __forceinline__ float gelu_tanh(float x) {
    const float t = 1.5957691216057308f * (x + 0.044715f * x * x * x);
    return x * sigmoidf_(t);
}
template <int MASK> __device__ __forceinline__ float xshfl(float v, int lane) {
    if (MASK < 32) return __builtin_bit_cast(float, __builtin_amdgcn_ds_swizzle(__builtin_bit_cast(int, v), (MASK << 10) | 0x1f));
    else return __builtin_bit_cast(float, __builtin_amdgcn_ds_bpermute((lane ^ 32) << 2, __builtin_bit_cast(int, v)));
}
__device__ __forceinline__ float lane_bcast(float v, int src) { return __builtin_bit_cast(float, __builtin_amdgcn_ds_bpermute(src << 2, __builtin_bit_cast(int, v))); }
__device__ __forceinline__ float wave_sum(float v, int lane) {
    v += xshfl<1>(v, lane); v += xshfl<2>(v, lane); v += xshfl<4>(v, lane); v += xshfl<8>(v, lane); v += xshfl<16>(v, lane); v += xshfl<32>(v, lane); return v;
}
__device__ __forceinline__ float wave_max(float v, int lane) {
    v = fmaxf(v, xshfl<1>(v, lane)); v = fmaxf(v, xshfl<2>(v, lane)); v = fmaxf(v, xshfl<4>(v, lane)); v = fmaxf(v, xshfl<8>(v, lane)); v = fmaxf(v, xshfl<16>(v, lane)); v = fmaxf(v, xshfl<32>(v, lane)); return v;
}
typedef unsigned long long u64;
__device__ __forceinline__ u64 ss_fix(float s) { return (u64)(s * 1048576.0f + 0.5f); }
__device__ __forceinline__ float ss_val(u64 v) { return (float)v * (1.0f / 1048576.0f); }
constexpr int ROWSC_OFF = RING_BYTES + 1024;
constexpr int NA_BIAS_OFF = RING_BYTES + 4096;
struct RowScale {
    const u64* ssa; const u64* ssb; bool useb;
    __device__ __forceinline__ float conv(u64 a, u64 b2) const { const float rs = fast_rsq(ss_val(a) * (1.0f / DM) + EPS); const float r2 = fast_rsq(rs * rs * ss_val(b2) * (1.0f / DM) + EPS); return useb ? rs * r2 : rs; }
    __device__ __forceinline__ void issue(int pm, int tid, u64& a, u64& b2) const { a = ssa[pm * 256 + (tid & 255)]; b2 = ssb[pm * 256 + (tid & 255)]; }
    __device__ __forceinline__ void commit(LAS unsigned char* lds, int slot, int tid, u64 a, u64 b2) const { ((LAS float*)(lds + ROWSC_OFF))[slot * 256 + (tid & 255)] = conv(a, b2); }
    __device__ __forceinline__ float get(LAS unsigned char* lds, int slot, int idx) const { return ((LAS float*)(lds + ROWSC_OFF))[slot * 256 + idx]; }
};
#define XB_TMO      128
#define XB_XCNT(j)  (256  + 64 * (j))
#define XB_XSUB(j)  (1280 + 64 * (j))
#define XB_XGEN(j)  (2304 + 64 * (j))
#define XB_TOP      3328
#define XB_TOPGEN   3392
#define XCD_BAR_WORDS 3456
#define XB_SPIN_CAP (1u << 18)

__device__ __forceinline__ unsigned xb_ld(unsigned* p)              { return __hip_atomic_load(p, __ATOMIC_RELAXED, __HIP_MEMORY_SCOPE_AGENT); }
__device__ __forceinline__ unsigned xb_add(unsigned* p, unsigned v) { return __hip_atomic_fetch_add(p, v, __ATOMIC_RELAXED, __HIP_MEMORY_SCOPE_AGENT); }
__device__ __forceinline__ unsigned xb_xcc_id() { return (unsigned)__builtin_amdgcn_s_getreg((3 << 11) | 20) & 0xFu; }
#define XB_SPIN(cond, bar) do { unsigned _sp = 0; while (cond) { __builtin_amdgcn_s_sleep(1); \
    if ((++_sp & 255u) == 0u) { if (xb_ld(&(bar)[XB_TMO])) break; if (_sp > XB_SPIN_CAP) { atomicAdd(&(bar)[XB_TMO], 1u); break; } } } } while (0)

struct XcdBarrier {
    unsigned* bar; unsigned x;
    volatile LAS unsigned* st;
    bool t0;
};

__device__ __forceinline__ XcdBarrier xcd_barrier_post(unsigned* bar, volatile LAS unsigned* st) {
    XcdBarrier b; b.bar = bar; b.x = xb_xcc_id(); b.st = st; b.t0 = (threadIdx.x == 0);
    if (threadIdx.x == 0) (void)xb_add(&bar[XB_XCNT(b.x)], 1u);
    return b;
}
__device__ __forceinline__ void xcd_barrier_complete(unsigned* bar, unsigned x, unsigned& nloc, unsigned& nx) {
    const unsigned G = gridDim.x * gridDim.y * gridDim.z;
    unsigned sum, cnt, mine, sp = 0u;
    for (;;) {
        sum = 0u; cnt = 0u; mine = 0u;
#pragma unroll
        for (unsigned j = 0; j < 16; ++j) { const unsigned c = xb_ld(&bar[XB_XCNT(j)]); sum += c; cnt += (c > 0u) ? 1u : 0u; mine = (j == x) ? c : mine; }
        if (sum == G) break;
        __builtin_amdgcn_s_sleep(1);
        if ((++sp & 255u) == 0u) { if (xb_ld(&bar[XB_TMO])) break; if (sp > XB_SPIN_CAP) { atomicAdd(&bar[XB_TMO], 1u); break; } }
    }
    nloc = mine > 0u ? mine : 1u; nx = cnt > 0u ? cnt : 1u;
}

__device__ __forceinline__ void xcd_barrier(const XcdBarrier& b) {
    asm volatile("s_waitcnt vmcnt(0)" ::: "memory");
    __syncthreads();
    if (b.t0) {
        unsigned* bar = b.bar;
        __builtin_amdgcn_s_waitcnt(0);
        unsigned nloc = b.st[0], nx = b.st[1];
        if (nloc == 0u) { xcd_barrier_complete(bar, b.x, nloc, nx); b.st[0] = nloc; b.st[1] = nx; }
        const unsigned old = xb_add(&bar[XB_XSUB(b.x)], 1u);
        const unsigned gen = old / nloc;
        if (old + 1u == (gen + 1u) * nloc) {
            __builtin_amdgcn_fence(__ATOMIC_RELEASE, "agent");
            asm volatile("s_waitcnt vmcnt(0)" ::: "memory");
            const unsigned og = xb_add(&bar[XB_TOP], 1u);
            const unsigned tg = og / nx;
            if (og + 1u == (tg + 1u) * nx) xb_add(&bar[XB_TOPGEN], 1u);
            else XB_SPIN(xb_ld(&bar[XB_TOPGEN]) == tg, bar);
            __builtin_amdgcn_fence(__ATOMIC_ACQUIRE, "agent");
            xb_add(&bar[XB_XGEN(b.x)], 1u);
            asm volatile("s_waitcnt vmcnt(0)" ::: "memory");
        } else {
            XB_SPIN(xb_ld(&bar[XB_XGEN(b.x)]) == gen, bar);
            __builtin_amdgcn_fence(__ATOMIC_ACQUIRE, "agent");
            asm volatile("s_waitcnt vmcnt(0)" ::: "memory");
        }
    }
    __syncthreads();
}

using pg8::Unit;
struct EpiSwiGLU {
    static constexpr bool PERM = true, AFTER_DRAIN = false;
    __device__ __forceinline__ void first(const Unit& u, LAS unsigned char* lds, int tid) const { u64 a, b2; rsc.issue(u.pm, tid, a, b2); rsc.commit(lds, 0, tid, a, b2); }
    bf16* H; RowScale rsc;
    __device__ __forceinline__ void operator()(const f32x4 (&acc)[2][2][4][2], const Unit& u, int wr, int wc, int fr, int fq, int ui, bool has_next, const Unit& nxt, LAS unsigned char* lds, int tid) const {
        const int row0 = u.pm * 256 + wr * 64 + fr, col0 = u.pn * 128 + wc * 32 + 8 * fq;
        u64 na, nb; rsc.issue(has_next ? nxt.pm : u.pm, tid, na, nb);
#pragma unroll
        for (int ai = 0; ai < 2; ++ai)
#pragma unroll
            for (int m = 0; m < 4; ++m) {
                const int row = row0 + ai * 128 + m * 16;
                const float rs = rsc.get(lds, ui & 1, ai * 128 + wr * 64 + m * 16 + fr);
                bf16* rowp = H + (size_t)row * FF + col0;
                float h[8];
#pragma unroll
                for (int n = 0; n < 2; ++n)
#pragma unroll
                    for (int i = 0; i < 4; ++i) { const float g = acc[ai][0][m][n][i] * rs, uu = acc[ai][1][m][n][i] * rs; h[4 * n + i] = siluf_(g) * uu; }
                v4u w; w.x = pk2(h[0], h[1]); w.y = pk2(h[2], h[3]); w.z = pk2(h[4], h[5]); w.w = pk2(h[6], h[7]);
                *(v4u*)rowp = w;
            }
        rsc.commit(lds, (ui + 1) & 1, tid, na, nb);
    }
};
struct EpiResid {
    static constexpr bool PERM = true, AFTER_DRAIN = false;
    __device__ __forceinline__ void first(const Unit&, LAS unsigned char*, int) const {}
    bf16* XB; float scale; const u64* pre_ss; bool has_pre; const float* pre_g; u64* ssa; u64* ssb; const float* gb;
    __device__ __forceinline__ void operator()(const f32x4 (&acc)[2][2][4][2], const Unit& u, int wr, int wc, int fr, int fq, int ui, bool has_next, const Unit& nxt, LAS unsigned char* lds, int tid) const {
        const int row0 = u.pm * 256 + wr * 64 + fr, col0 = u.pn * 256 + wc * 32 + 8 * fq;
        f32x4 pg[2][2], g2[2][2];
#pragma unroll
        for (int bj = 0; bj < 2; ++bj)
#pragma unroll
            for (int n = 0; n < 2; ++n) { pg[bj][n] = has_pre ? *(const f32x4*)(pre_g + col0 + bj * 128 + n * 4) : (f32x4){1.f, 1.f, 1.f, 1.f};
                if (ssb) { const f32x4 t = *(const f32x4*)(gb + col0 + bj * 128 + n * 4); g2[bj][n] = t * t; } else g2[bj][n] = (f32x4){0.f, 0.f, 0.f, 0.f}; }
#pragma unroll
        for (int ai = 0; ai < 2; ++ai) {
            v4u xw[4][2]; u64 ps[4];
#pragma unroll
            for (int m = 0; m < 4; ++m) { const int row = row0 + ai * 128 + m * 16; ps[m] = pre_ss[row];
#pragma unroll
                for (int bj = 0; bj < 2; ++bj) xw[m][bj] = *(const v4u*)(XB + (size_t)row * DM + col0 + bj * 128); }
#pragma unroll
            for (int m = 0; m < 4; ++m) {
                const int row = row0 + ai * 128 + m * 16;
                const float r1 = has_pre ? fast_rsq(ss_val(ps[m]) * (1.0f / DM) + EPS) : 1.0f;
                float sa = 0.f, sb = 0.f;
#pragma unroll
                for (int bj = 0; bj < 2; ++bj) { const v4u w0 = xw[m][bj]; f32x4 xn[2];
                    const f32x4 xo[2] = {(f32x4){bflo(w0.x), bfhi(w0.x), bflo(w0.y), bfhi(w0.y)}, (f32x4){bflo(w0.z), bfhi(w0.z), bflo(w0.w), bfhi(w0.w)}};
#pragma unroll
                    for (int n = 0; n < 2; ++n) { xn[n] = xo[n] * (pg[bj][n] * r1) + acc[ai][bj][m][n] * scale;
                        const f32x4 sq = xn[n] * xn[n]; sa += (sq[0] + sq[1]) + (sq[2] + sq[3]);
                        if (ssb) { const f32x4 sg = sq * g2[bj][n]; sb += (sg[0] + sg[1]) + (sg[2] + sg[3]); } }
                    v4u w; w.x = pk2(xn[0][0], xn[0][1]); w.y = pk2(xn[0][2], xn[0][3]); w.z = pk2(xn[1][0], xn[1][1]); w.w = pk2(xn[1][2], xn[1][3]);
                    *(v4u*)(XB + (size_t)row * DM + col0 + bj * 128) = w; }
                sa += xshfl<16>(sa, 16 * fq + fr); sa += xshfl<32>(sa, 16 * fq + fr);
                if (ssb) { sb += xshfl<16>(sb, 16 * fq + fr); sb += xshfl<32>(sb, 16 * fq + fr); }
                if (fq == 0) { atomicAdd(ssa + row, ss_fix(sa)); if (ssb) atomicAdd(ssb + row, ss_fix(sb)); }
            }
        }
    }
};
struct EpiWin {
    static constexpr bool PERM = true, AFTER_DRAIN = false;
    __device__ __forceinline__ void first(const Unit& u, LAS unsigned char* lds, int tid) const { u64 a, b2; rsc.issue(u.pm, tid, a, b2); rsc.commit(lds, 0, tid, a, b2); }
    bf16 *Q, *K, *V, *QH, *VH, *GH, *LFF, *LFB; bf16* UX; const float *qn, *kn, *lb; RowScale rsc;
    __device__ __forceinline__ void operator()(const f32x4 (&acc_)[2][2][4][2], const Unit& u, int wr, int wc, int fr, int fq, int ui, bool has_next, const Unit& nxt, LAS unsigned char* lds, int tid) const {
        const int row0 = u.pm * 256 + wr * 64 + fr, pn = u.pn, seg = pn >> 1;
        u64 na, nb; rsc.issue(has_next ? nxt.pm : u.pm, tid, na, nb);
        f32x4 acc[2][2][4][2];
#pragma unroll
        for (int ai = 0; ai < 2; ++ai)
#pragma unroll
            for (int m = 0; m < 4; ++m) { const float rs = rsc.get(lds, ui & 1, ai * 128 + wr * 64 + m * 16 + fr);
#pragma unroll
                for (int bj = 0; bj < 2; ++bj)
#pragma unroll
                    for (int n = 0; n < 2; ++n) acc[ai][bj][m][n] = acc_[ai][bj][m][n] * rs; }
        const int cbase = (pn & 1) * 256 + 64 * wc + 8 * fq;
        if (seg <= 1) {
            const float* gn = seg == 0 ? qn : kn; bf16* dst = seg == 0 ? Q : K;
            float gv[2][8];
#pragma unroll
            for (int bj = 0; bj < 2; ++bj) { const f32x4 a = *(const f32x4*)(gn + 32 * bj + 8 * fq), b = *(const f32x4*)(gn + 32 * bj + 8 * fq + 4);
                gv[bj][0] = a[0]; gv[bj][1] = a[1]; gv[bj][2] = a[2]; gv[bj][3] = a[3]; gv[bj][4] = b[0]; gv[bj][5] = b[1]; gv[bj][6] = b[2]; gv[bj][7] = b[3]; }
#pragma unroll
            for (int ai = 0; ai < 2; ++ai)
#pragma unroll
                for (int m = 0; m < 4; ++m) {
                    float ss = 0.f;
#pragma unroll
                    for (int bj = 0; bj < 2; ++bj)
#pragma unroll
                        for (int n = 0; n < 2; ++n) { const f32x4 x = acc[ai][bj][m][n]; ss += (x[0] * x[0] + x[1] * x[1]) + (x[2] * x[2] + x[3] * x[3]); }
                    ss += xshfl<16>(ss, 16 * fq + fr); ss += xshfl<32>(ss, 16 * fq + fr);
                    const float rstd = fast_rsq(ss * (1.0f / 64.0f) + EPS);
                    bf16* rowp = dst + (size_t)(row0 + ai * 128 + m * 16) * 512 + cbase;
#pragma unroll
                    for (int bj = 0; bj < 2; ++bj) { const f32x4 x0 = acc[ai][bj][m][0] * rstd, x1 = acc[ai][bj][m][1] * rstd; v4u w;
                        w.x = pk2(x0[0] * gv[bj][0], x0[1] * gv[bj][1]); w.y = pk2(x0[2] * gv[bj][2], x0[3] * gv[bj][3]); w.z = pk2(x1[0] * gv[bj][4], x1[1] * gv[bj][5]); w.w = pk2(x1[2] * gv[bj][6], x1[3] * gv[bj][7]);
                        *(v4u*)(rowp + 32 * bj) = w; }
                }
        } else if (seg == 2 || seg == 3 || seg == 6 || seg == 7) {
            bf16* dst = seg == 2 ? V : (seg == 3 ? QH : (seg == 6 ? VH : GH)); const bool act = (seg == 3 || seg == 7);
#pragma unroll
            for (int ai = 0; ai < 2; ++ai)
#pragma unroll
                for (int m = 0; m < 4; ++m) {
                    bf16* rowp = dst + (size_t)(row0 + ai * 128 + m * 16) * 512 + cbase;
#pragma unroll
                    for (int bj = 0; bj < 2; ++bj) { f32x4 x0 = acc[ai][bj][m][0], x1 = acc[ai][bj][m][1];
                        if (act) {
#pragma unroll
                            for (int i = 0; i < 4; ++i) { x0[i] = siluf_(x0[i]); x1[i] = siluf_(x1[i]); } }
                        v4u w; w.x = pk2(x0[0], x0[1]); w.y = pk2(x0[2], x0[3]); w.z = pk2(x1[0], x1[1]); w.w = pk2(x1[2], x1[3]);
                        *(v4u*)(rowp + 32 * bj) = w; }
                }
        } else if (seg == 4 || seg == 5) {
            bf16* dst = seg == 4 ? LFF : LFB; const float* lbp = lb + (seg - 4) * 512 + cbase;
            f32x4 lbv[2][2];
#pragma unroll
            for (int bj = 0; bj < 2; ++bj) { lbv[bj][0] = *(const f32x4*)(lbp + 32 * bj); lbv[bj][1] = *(const f32x4*)(lbp + 32 * bj + 4); }
#pragma unroll
            for (int ai = 0; ai < 2; ++ai)
#pragma unroll
                for (int m = 0; m < 4; ++m) {
                    bf16* rowp = dst + (size_t)(row0 + ai * 128 + m * 16) * 512 + cbase;
#pragma unroll
                    for (int bj = 0; bj < 2; ++bj) { float o[8];
#pragma unroll
                        for (int n = 0; n < 2; ++n)
#pragma unroll
                            for (int i = 0; i < 4; ++i) { const float l = lbv[bj][n][i]; o[4 * n + i] = 0.69314718056f * __builtin_amdgcn_logf(l + (1.0f - l) * sigmoidf_(acc[ai][bj][m][n][i])); }
                        v4u w; w.x = pk2(o[0], o[1]); w.y = pk2(o[2], o[3]); w.z = pk2(o[4], o[5]); w.w = pk2(o[6], o[7]);
                        *(v4u*)(rowp + 32 * bj) = w; }
                }
        } else {
#pragma unroll
            for (int ai = 0; ai < 2; ++ai)
#pragma unroll
                for (int m = 0; m < 4; ++m) {
                    const int row = row0 + ai * 128 + m * 16;
#pragma unroll
                    for (int bj = 0; bj < 2; ++bj) { const int g = (pn - 16) * 16 + 4 * wc + 2 * bj + (fq >> 1);
                        bf16* p = UX + ((size_t)g * 2048 + (row >> 4)) * 512 + (row & 15) * 16 + 8 * (fq & 1);
                        const f32x4 x0 = acc[ai][bj][m][0], x1 = acc[ai][bj][m][1];
                        v4u w; w.x = pk2(x0[0], x0[1]); w.y = pk2(x0[2], x0[3]); w.z = pk2(x1[0], x1[1]); w.w = pk2(x1[2], x1[3]);
                        *(v4u*)p = w; }
                }
        }
        rsc.commit(lds, (ui + 1) & 1, tid, na, nb);
    }
};
struct EpiGLU {
    static constexpr bool PERM = true, AFTER_DRAIN = false;
    __device__ __forceinline__ void first(const Unit&, LAS unsigned char*, int) const {}
    const bf16* YPRE; const float* bias; bf16* Y2;
    __device__ __forceinline__ void operator()(const f32x4 (&acc)[2][2][4][2], const Unit& u, int wr, int wc, int fr, int fq, int ui, bool has_next, const Unit& nxt, LAS unsigned char* lds, int tid) const {
        const int row0 = u.pm * 256 + wr * 64 + fr, col0 = u.pn * 256 + wc * 32 + 8 * fq;
        f32x4 bv[2][2];
#pragma unroll
        for (int bj = 0; bj < 2; ++bj) { bv[bj][0] = *(const f32x4*)(bias + col0 + bj * 128); bv[bj][1] = *(const f32x4*)(bias + col0 + bj * 128 + 4); }
#pragma unroll
        for (int ai = 0; ai < 2; ++ai) {
            v4u ypv[4][2];
#pragma unroll
            for (int m = 0; m < 4; ++m)
#pragma unroll
                for (int bj = 0; bj < 2; ++bj) ypv[m][bj] = *(const v4u*)(YPRE + (size_t)(row0 + ai * 128 + m * 16) * S5W + col0 + bj * 128);
#pragma unroll
            for (int m = 0; m < 4; ++m) {
                const size_t off = (size_t)(row0 + ai * 128 + m * 16) * S5W + col0;
#pragma unroll
                for (int bj = 0; bj < 2; ++bj) { const v4u yp = ypv[m][bj];
                    const f32x4 z0 = acc[ai][bj][m][0] + bv[bj][0], z1 = acc[ai][bj][m][1] + bv[bj][1];
                    v4u w; w.x = pk2(bflo(yp.x) * sigmoidf_(z0[0]), bfhi(yp.x) * sigmoidf_(z0[1])); w.y = pk2(bflo(yp.y) * sigmoidf_(z0[2]), bfhi(yp.y) * sigmoidf_(z0[3]));
                    w.z = pk2(bflo(yp.z) * sigmoidf_(z1[0]), bfhi(yp.z) * sigmoidf_(z1[1])); w.w = pk2(bflo(yp.w) * sigmoidf_(z1[2]), bfhi(yp.w) * sigmoidf_(z1[3]));
                    *(v4u*)(Y2 + off + bj * 128) = w; }
            }
        }
    }
};

struct S5Order {
    int G, c;
    __device__ __forceinline__ bool next(int i, Unit& u) const {
        int g, rt;
        if (G == 256) { if (i >= 2) return false; const int x = c & 7, s = c >> 3; g = 32 * i + x * 4 + (s >> 3); rt = s & 7; }
        else { const int id = i * G + c; if (id >= 512) return false; g = id >> 3; rt = id & 7; }
        u.pm = g * 8 + rt; u.pn = g; return true;
    }
    __device__ __forceinline__ void a_ready(const Unit&) const {}
    __device__ __forceinline__ void done(const Unit&) const {}
};
struct EpiS5E {
    static constexpr bool PERM = false, AFTER_DRAIN = false;
    __device__ __forceinline__ void first(const Unit&, LAS unsigned char*, int) const {}
    bf16* E;
    __device__ __forceinline__ void operator()(const f32x4 (&acc)[2][2][4][2], const Unit& u, int wr, int wc, int fr, int fq, int ui, bool has_next, const Unit& nxt, LAS unsigned char* lds, int tid) const {
        const int row0 = u.pm * 256 + wr * 64 + fr, col0 = wc * 32 + 4 * fq;
#pragma unroll
        for (int ai = 0; ai < 2; ++ai)
#pragma unroll
            for (int m = 0; m < 4; ++m) { bf16* rowp = E + (size_t)(row0 + ai * 128 + m * 16) * 256 + col0;
#pragma unroll
                for (int bj = 0; bj < 2; ++bj)
#pragma unroll
                    for (int n = 0; n < 2; ++n) { const f32x4 x = acc[ai][bj][m][n]; v2u w; w.x = pk2(x[0], x[1]); w.y = pk2(x[2], x[3]); *(v2u*)(rowp + bj * 128 + n * 16) = w; } }
    }
};
struct EpiS5Y {
    static constexpr bool PERM = true, AFTER_DRAIN = false;
    __device__ __forceinline__ void first(const Unit&, LAS unsigned char*, int) const {}
    bf16* YPRE;
    __device__ __forceinline__ void operator()(const f32x4 (&acc)[2][2][4][2], const Unit& u, int wr, int wc, int fr, int fq, int ui, bool has_next, const Unit& nxt, LAS unsigned char* lds, int tid) const {
        const int g = u.pn, chunk0 = (u.pm & 7) * 256 + wr * 64 + fr;
#pragma unroll
        for (int ai = 0; ai < 2; ++ai)
#pragma unroll
            for (int m = 0; m < 4; ++m) { const int chunk = chunk0 + ai * 128 + m * 16;
#pragma unroll
                for (int bj = 0; bj < 2; ++bj) { const int tok = chunk * 16 + 8 * bj + 2 * wc + (fq >> 1);
                    const f32x4 x0 = acc[ai][bj][m][0], x1 = acc[ai][bj][m][1];
                    v4u w; w.x = pk2(gelu_tanh(x0[0]), gelu_tanh(x0[1])); w.y = pk2(gelu_tanh(x0[2]), gelu_tanh(x0[3])); w.z = pk2(gelu_tanh(x1[0]), gelu_tanh(x1[1])); w.w = pk2(gelu_tanh(x1[2]), gelu_tanh(x1[3]));
                    *(v4u*)(YPRE + (size_t)tok * S5W + g * 16 + 8 * (fq & 1)) = w; } }
    }
};

struct Frame {
    LAS unsigned char* lds;
    volatile LAS unsigned* MISC;
    int tid, lane, wave, G, gw, NGW, bid, zi;
    unsigned char* ws; float* X;
};
struct Args { const float* in[33]; int ph_lo, ph_hi, li, pad; };
#define WSP(T, off) ((T*)(F.ws + (off)))
__device__ __forceinline__ int fresh_lane() { unsigned z = 0u; asm volatile("" : "+v"(z)); return (int)__builtin_amdgcn_mbcnt_hi(~0u, __builtin_amdgcn_mbcnt_lo(~0u, z)); }
template <class T> __device__ __forceinline__ T* opaque_ptr(T* p) {
    unsigned long long w = (unsigned long long)p; unsigned lo = (unsigned)w, hi = (unsigned)(w >> 32);
    asm volatile("" : "+v"(lo), "+v"(hi));
    lo = (unsigned)__builtin_amdgcn_readfirstlane((int)lo); hi = (unsigned)__builtin_amdgcn_readfirstlane((int)hi);
    return (T*)(((unsigned long long)hi << 32) | lo);
}
#define FA Frame& F, const Args& A
#define AIN(k) (A.in[(k) + F.zi])

__device__ __forceinline__ void conv_item(const float* W, int Nsrc, int K, int src_col0, bf16* WT, int dst_row0, int k0, LAS float* scr, int lane, const float* ga = nullptr, const float* gb = nullptr) {
    float wv[32];
#pragma unroll
    for (int i = 0; i < 32; ++i) { const int kk = 2 * i + (lane >> 5); wv[i] = __builtin_nontemporal_load(W + (size_t)(k0 + kk) * Nsrc + src_col0 + (lane & 31)); }
    const int c = lane & 7;
    f32x4 g0 = (f32x4){1.f, 1.f, 1.f, 1.f}, g1 = g0;
    if (ga) { g0 = *(const f32x4*)(ga + k0 + 8 * c); g1 = *(const f32x4*)(ga + k0 + 8 * c + 4); if (gb) { g0 = g0 * *(const f32x4*)(gb + k0 + 8 * c); g1 = g1 * *(const f32x4*)(gb + k0 + 8 * c + 4); } }
#pragma unroll
    for (int i = 0; i < 32; ++i) { const int kk = 2 * i + (lane >> 5); scr[kk * 33 + (lane & 31)] = wv[i]; }
    LDS_WAIT(); asm volatile("" ::: "memory");
#pragma unroll
    for (int j = 0; j < 4; ++j) { const int n = (lane >> 3) + 8 * j; const LAS float* s = scr + (8 * c) * 33 + n;
        v4u o; o.x = pk2(s[0 * 33] * g0[0], s[1 * 33] * g0[1]); o.y = pk2(s[2 * 33] * g0[2], s[3 * 33] * g0[3]); o.z = pk2(s[4 * 33] * g1[0], s[5 * 33] * g1[1]); o.w = pk2(s[6 * 33] * g1[2], s[7 * 33] * g1[3]);
        *(GAS v4u*)(WT + (size_t)(dst_row0 + n) * K + k0 + 8 * c) = o; }
    LDS_WAIT(); asm volatile("" ::: "memory");
}
__device__ __forceinline__ void conv_layer(FA, int l) {
    LAS float* scr = (LAS float*)(F.lds + RING_OFF + F.wave * 16384);
    constexpr int I_GU = 32 * 352, I_D = 88 * 64, I_IN = 32 * 160, I_GLU = 16 * 32, I_OUT = 32 * 64;
    constexpr int NITEMS = 2 * I_GU + 2 * I_D + I_IN + I_GLU + I_OUT;
    const size_t wff = (size_t)DM * FF;
    for (int it = F.gw; it < NITEMS; it += F.NGW) {
        int r = it;
        if (r < 2 * I_GU) { const int second = r >= I_GU; if (second) r -= I_GU;
            const int kb = r / 352, nbd = r % 352, tile = nbd >> 3, pb = nbd & 7, bj = pb >> 2, sub = pb & 3;
            const float* W = AIN(second ? (bj ? 28 : 27) : (bj ? 4 : 3)) + (size_t)l * wff;
            conv_item(W, FF, DM, 128 * tile + 32 * sub, WSP(bf16, second ? WS_WGU2 : WS_WGU1), 32 * nbd, 64 * kb, scr, F.lane, AIN(second ? 26 : 2) + l * DM, (!second && l > 0) ? AIN(30) + (l - 1) * DM : nullptr); continue; }
        r -= 2 * I_GU;
        if (r < 2 * I_D) { const int second = r >= I_D; if (second) r -= I_D;
            const int kb = r / 64, nbd = r % 64;
            conv_item(AIN(second ? 29 : 5) + (size_t)l * wff, DM, FF, 32 * nbd, WSP(bf16, second ? WS_WD2 : WS_WD1), 32 * nbd, 64 * kb, scr, F.lane); continue; }
        r -= 2 * I_D;
        if (r < I_IN) { const int kb = r / 160, nbd = r % 160, tile = nbd >> 3, pb = nbd & 7, bj = pb >> 2, wc = pb & 3;
            conv_item(AIN(7) + (size_t)l * DM * INC, INC, DM, 256 * tile + 32 * (2 * wc + bj), WSP(bf16, WS_WIN), 32 * nbd, 64 * kb, scr, F.lane, AIN(6) + l * DM); continue; }
        r -= I_IN;
        if (r < I_GLU) { const int kb = r / 32, nbd = r % 32;
            conv_item(AIN(22) + (size_t)l * S5W * S5W, S5W, S5W, 32 * nbd, WSP(bf16, WS_WGLU), 32 * nbd, 64 * kb, scr, F.lane); continue; }
        r -= I_GLU;
        { const int kb = r / 64, nbd = r % 64;
            conv_item(AIN(25) + (size_t)l * DM * DM, DM, DM, 32 * nbd, WSP(bf16, WS_WOUT), 32 * nbd, 64 * kb, scr, F.lane); }
    }
}
__device__ __forceinline__ void lb_table(FA) {
    float* LB = WSP(float, WS_TAB); const float* lg = AIN(12);
    for (int i = blockIdx.x * 512 + F.tid; i < 1024; i += F.G * 512) {
        float v[NL], mx = -1e30f;
#pragma unroll
        for (int l = 0; l < NL; ++l) { v[l] = lg[l * 1024 + i]; mx = fmaxf(mx, v[l]); }
        float s = 0.f;
#pragma unroll
        for (int l = 0; l < NL; ++l) { v[l] = expf(v[l] - mx); s += v[l]; }
        float c = 0.f;
#pragma unroll
        for (int l = 0; l < NL; ++l) { if (l > 0) c += v[l] / s; LB[l * 1024 + i] = c; }
    }
}
__device__ __forceinline__ const float* in_row(FA, int r) { return r < MPROMPT ? AIN(0) + (size_t)r * DM : AIN(1) + (size_t)(r - MPROMPT) * DM; }
__device__ __forceinline__ void prep_phase(FA) {
    bf16* XB = WSP(bf16, WS_XB); u64* SS0 = WSP(u64, WS_SS);
    for (int r = F.gw; r < MTOK; r += F.NGW) {
        const f32x4* xr = (const f32x4*)in_row(F, A, r) + F.lane; f32x4 v[8]; float s = 0.f;
#pragma unroll
        for (int j = 0; j < 8; ++j) { v[j] = __builtin_nontemporal_load(xr + 64 * j); s += (v[j][0] * v[j][0] + v[j][1] * v[j][1]) + (v[j][2] * v[j][2] + v[j][3] * v[j][3]); }
        s = wave_sum(s, F.lane); if (F.lane == 0) SS0[r] = ss_fix(s);
        v2u* o = (v2u*)(XB + (size_t)r * DM) + F.lane;
#pragma unroll
        for (int j = 0; j < 8; ++j) { v2u w; w.x = pk2(v[j][0], v[j][1]); w.y = pk2(v[j][2], v[j][3]); o[64 * j] = w; }
    }
}
__device__ __forceinline__ void out_norm_phase(FA, const u64* ss, const float* g) {
    const bf16* XB = WSP(bf16, WS_XB);
    for (int r = F.gw; r < MTOK; r += F.NGW) {
        f32x4* xr = (f32x4*)(F.X + (size_t)r * DM) + F.lane; const f32x4* gp = (const f32x4*)g + F.lane; const v2u* xb = (const v2u*)(XB + (size_t)r * DM) + F.lane;
        const float rstd = fast_rsq(ss_val(ss[r]) * (1.0f / DM) + EPS);
        v2u w[8];
#pragma unroll
        for (int j = 0; j < 8; ++j) w[j] = xb[64 * j];
#pragma unroll
        for (int j = 0; j < 8; ++j) __builtin_nontemporal_store((f32x4){bflo(w[j].x), bfhi(w[j].x), bflo(w[j].y), bfhi(w[j].y)} * rstd * gp[64 * j], xr + 64 * j);
    }
}
__device__ __forceinline__ void seq_of_row(int r, int& base, int& t, int& rows) {
    if (r < MPROMPT) { base = r & ~(TP - 1); t = r & (TP - 1); rows = TP / 64; } else { const int q = r - MPROMPT; base = MPROMPT + (q & ~(TS - 1)); t = q & (TS - 1); rows = TS / 64; }
}
__device__ __forceinline__ void seq_of_index(int s, int& base, int& T) { if (s < 8) { base = s * TP; T = TP; } else { base = MPROMPT + (s - 8) * TS; T = TS; } }

struct S5Par { float dre, ang, fre, fim; };
__device__ __forceinline__ S5Par s5_par(FA, int l, int dir, int g, int p) {
    const int pi = ((l * 2 + dir) * 64 + g) * 64 + p;
    const float are = AIN(14)[pi], aim = AIN(15)[pi], dt = expf(AIN(16)[(l * 2 + dir) * 64 + g]);
    const float mag = __expf(dt * are), ang = dt * aim; float sn_, cs_; fast_sincos(ang, sn_, cs_); const float abr = mag * cs_, abi = mag * sn_;
    const float den = are * are + aim * aim, nr = abr - 1.0f;
    S5Par r; r.dre = dt * are; r.ang = ang; r.fre = (nr * are + abi * aim) / den; r.fim = (abi * are - nr * aim) / den; return r;
}
__device__ __forceinline__ void s5_pow(const S5Par& q, float e, float& pr, float& pim) { const float m = __expf(e * q.dre); float s, c; fast_sincos(e * q.ang, s, c); pr = m * c; pim = m * s; }
__device__ __forceinline__ void s5_ops(FA, int l) {
    bf16* BE = WSP(bf16, WS_S5E); bf16* BY = WSP(bf16, WS_S5Y); const int lane = F.lane;
    for (int task = F.gw; task < 64 * 16 * 2; task += F.NGW) {
        const int chalf = task & 1, g = task >> 5, tau = (task >> 1) & 15; float kf[4] = {0.f, 0.f, 0.f, 0.f}, kb[4] = {0.f, 0.f, 0.f, 0.f};
#pragma unroll 1
        for (int dir = 0; dir < 2; ++dir) {
            const S5Par q = s5_par(F, A, l, dir, g, lane); float pr, pim; s5_pow(q, (float)tau, pr, pim);
            const size_t pi = (size_t)(((l * 2 + dir) * 64 + g) * 64 + lane);
            float wr_[16], wi_[16];
#pragma unroll
            for (int c = 0; c < 16; ++c) { const float br = AIN(17)[pi * 16 + c], bi = AIN(18)[pi * 16 + c]; const float bbr = q.fre * br - q.fim * bi, bbi = q.fre * bi + q.fim * br;
                wr_[c] = pr * bbr - pim * bbi; wi_[c] = pr * bbi + pim * bbr; }
#pragma unroll 1
            for (int c = 8 * chalf; c < 8 * chalf + 8; ++c) { const size_t ci = ((size_t)((l * 2 + dir) * 64 + g) * 16 + c) * 64 + lane; const float cr = AIN(19)[ci], cim = AIN(20)[ci];
#pragma unroll
                for (int cp = 0; cp < 16; ++cp) { const float v = wave_sum(cr * wr_[cp] - cim * wi_[cp], lane);
                    if (lane == c * 4 + (cp >> 2)) { if (dir == 0) kf[cp & 3] = v; else kb[cp & 3] = v; } } }
        }
        const int c = lane >> 2, cp0 = 4 * (lane & 3);
        if ((c >> 3) != chalf) continue;
        if (tau == 0) {
            float v[4];
#pragma unroll
            for (int j = 0; j < 4; ++j) v[j] = kf[j] + kb[j] + ((cp0 + j == c) ? AIN(21)[l * 1024 + g * 16 + c] : 0.f);
            for (int i = 0; i < 16; ++i) { v2u w; w.x = pk2(v[0], v[1]); w.y = pk2(v[2], v[3]); *(v2u*)(BY + ((size_t)g * 256 + i * 16 + c) * 512 + i * 16 + cp0) = w; }
        } else {
            v2u wf, wb; wf.x = pk2(kf[0], kf[1]); wf.y = pk2(kf[2], kf[3]); wb.x = pk2(kb[0], kb[1]); wb.y = pk2(kb[2], kb[3]);
            for (int s = 0; s + tau < 16; ++s) { const int i = s + tau;
                *(v2u*)(BY + ((size_t)g * 256 + i * 16 + c) * 512 + s * 16 + cp0) = wf;
                *(v2u*)(BY + ((size_t)g * 256 + s * 16 + c) * 512 + i * 16 + cp0) = wb; }
        }
    }
    const int gt = F.bid * 512 + F.tid, ngt = F.G * 512;
    for (int t = gt; t < 64 * 16 * 16 * 2 * 8; t += ngt) {
        const int po = t & 7, dir = (t >> 3) & 1, c = (t >> 4) & 15, i = (t >> 8) & 15, g = t >> 12; const float e = dir ? (float)(16 - i) : (float)(i + 1);
        float re[8], im[8];
#pragma unroll
        for (int j = 0; j < 8; ++j) { const int p = po * 8 + j; const S5Par q = s5_par(F, A, l, dir, g, p); float pr, pim; s5_pow(q, e, pr, pim);
            const size_t ci = ((size_t)((l * 2 + dir) * 64 + g) * 16 + c) * 64 + p; const float cr = AIN(19)[ci], cim = AIN(20)[ci];
            re[j] = cr * pr - cim * pim; im[j] = -(cr * pim + cim * pr); }
        bf16* row = BY + ((size_t)g * 256 + i * 16 + c) * 512 + 256 + dir * 128 + po * 8;
        v4u w; w.x = pk2(re[0], re[1]); w.y = pk2(re[2], re[3]); w.z = pk2(re[4], re[5]); w.w = pk2(re[6], re[7]); *(v4u*)row = w;
        w.x = pk2(im[0], im[1]); w.y = pk2(im[2], im[3]); w.z = pk2(im[4], im[5]); w.w = pk2(im[6], im[7]); *(v4u*)(row + 64) = w;
    }
    for (int t = gt; t < 64 * 2 * 64 * 16; t += ngt) {
        const int s = t & 15, p = (t >> 4) & 63, dir = (t >> 10) & 1, g = t >> 11; const float e = dir ? (float)s : (float)(15 - s);
        const S5Par q = s5_par(F, A, l, dir, g, p); float pr, pim; s5_pow(q, e, pr, pim);
        const size_t pi = (size_t)(((l * 2 + dir) * 64 + g) * 64 + p); float re[16], im[16];
#pragma unroll
        for (int c = 0; c < 16; ++c) { const float br = AIN(17)[pi * 16 + c], bi = AIN(18)[pi * 16 + c]; const float bbr = q.fre * br - q.fim * bi, bbi = q.fre * bi + q.fim * br;
            re[c] = pr * bbr - pim * bbi; im[c] = pr * bbi + pim * bbr; }
        bf16* rr = BE + ((size_t)g * 256 + dir * 128 + p) * 256 + s * 16; bf16* ri = rr + 64 * 256;
        v4u w; w.x = pk2(re[0], re[1]); w.y = pk2(re[2], re[3]); w.z = pk2(re[4], re[5]); w.w = pk2(re[6], re[7]); *(v4u*)rr = w;
        w.x = pk2(re[8], re[9]); w.y = pk2(re[10], re[11]); w.z = pk2(re[12], re[13]); w.w = pk2(re[14], re[15]); *(v4u*)(rr + 8) = w;
        w.x = pk2(im[0], im[1]); w.y = pk2(im[2], im[3]); w.z = pk2(im[4], im[5]); w.w = pk2(im[6], im[7]); *(v4u*)ri = w;
        w.x = pk2(im[8], im[9]); w.y = pk2(im[10], im[11]); w.z = pk2(im[12], im[13]); w.w = pk2(im[14], im[15]); *(v4u*)(ri + 8) = w;
    }
}
__device__ __forceinline__ void s5_carry(FA, int l, int w0, int nw) {
    const bf16* E = WSP(bf16, WS_E); bf16* UX = WSP(bf16, WS_UX); const int lane = F.lane;
    for (int task = w0; task < 12 * 64 * 2; task += nw) {
        const int dir = task & 1, g = (task >> 1) & 63, s = task >> 7; int base, T; seq_of_index(s, base, T);
        const int c0 = base >> 4, nch = T >> 4;
        const S5Par q = s5_par(F, A, l, dir, g, lane); float ar, ai; s5_pow(q, 16.0f, ar, ai);
        float xr = 0.f, xi = 0.f;
        float er[8], ei[8];
#pragma unroll
        for (int j = 0; j < 8; ++j) { const int n = dir ? nch - 1 - j : j; const bf16* ep = E + ((size_t)g * 2048 + c0 + n) * 256 + dir * 128 + lane; er[j] = bf2f(ep[0]); ei[j] = bf2f(ep[64]); }
        for (int n0 = 0; n0 < nch; n0 += 8) {
            float fr_[8], fi_[8];
            const int n1 = n0 + 8 < nch ? n0 + 8 : n0;
#pragma unroll
            for (int j = 0; j < 8; ++j) { const int n = dir ? nch - 1 - (n1 + j) : n1 + j; const bf16* ep = E + ((size_t)g * 2048 + c0 + n) * 256 + dir * 128 + lane; fr_[j] = bf2f(ep[0]); fi_[j] = bf2f(ep[64]); }
#pragma unroll
            for (int j = 0; j < 8; ++j) { const int n = dir ? nch - 1 - (n0 + j) : n0 + j; bf16* xp = UX + ((size_t)g * 2048 + c0 + n) * 512 + 256 + dir * 128 + lane;
                xp[0] = (bf16)f2bf(xr); xp[64] = (bf16)f2bf(xi);
                const float nr = ar * xr - ai * xi + er[j], ni = ar * xi + ai * xr + ei[j]; xr = nr; xi = ni; }
#pragma unroll
            for (int j = 0; j < 8; ++j) { er[j] = fr_[j]; ei[j] = fi_[j]; }
        }
    }
}
typedef short s16x4 __attribute__((ext_vector_type(4)));
__device__ __forceinline__ unsigned hoff(unsigned row, unsigned ch) { return 256u * row + 16u * (ch ^ (((row & 3u) << 2) | ((row >> 2) & 3u))); }
__device__ __forceinline__ s16x4 tr_read(const LAS unsigned char* p) { return __builtin_bit_cast(s16x4, __builtin_amdgcn_ds_read_tr16_b64_v4i16((LAS s16x4*)p)); }
__device__ __forceinline__ bf16x8 tr_frag(const LAS unsigned char* tile, int lane, int c, int rowbase0, int rowbase1) {
    const unsigned g = lane >> 4, q = (lane & 15) >> 2, p = lane & 3;
    const s16x4 a = tr_read(tile + hoff(rowbase0 + 4 * g + q, 2 * c + (p >> 1)) + 8 * (p & 1)), b = tr_read(tile + hoff(rowbase1 + 4 * g + q, 2 * c + (p >> 1)) + 8 * (p & 1));
    bf16x8 r; r[0] = a[0]; r[1] = a[1]; r[2] = a[2]; r[3] = a[3]; r[4] = b[0]; r[5] = b[1]; r[6] = b[2]; r[7] = b[3]; return r;
}
__device__ __forceinline__ void lds8(const LAS float* p, float (&v)[8]) { const f32x4 a = *(const LAS f32x4*)p, b = *(const LAS f32x4*)(p + 4); v[0] = a[0]; v[1] = a[1]; v[2] = a[2]; v[3] = a[3]; v[4] = b[0]; v[5] = b[1]; v[6] = b[2]; v[7] = b[3]; }
constexpr int HG_BST = 136;
constexpr int HG_BF_OFF = 0, HG_BB_OFF = 64 * HG_BST * 4, HG_V_OFF = 2 * 64 * HG_BST * 4, HG_Q_OFF = HG_V_OFF + 16384, HG_K2_OFF = HG_Q_OFF;
constexpr int HG_OST = 132;
static_assert(2 * 64 * HG_OST * 4 <= HG_V_OFF && HG_K2_OFF + 2 * 16384 <= RING_BYTES, "HGRN2 LDS map");
struct HgTiles { v4u lw[4]; v4u tv[2], tq[2]; };
__device__ __forceinline__ void hg_issue(Frame& F, HgTiles& T, const bf16* LFF, const bf16* LFB, const bf16* VH, const bf16* QH, int cu) {
    const int head = cu & 3, cg = cu >> 2;
    const unsigned lt = (unsigned)((F.tid >> 4) * 512 + 8 * (F.tid & 15));
#pragma unroll
    for (int i = 0; i < 2; ++i) { const size_t go = (size_t)(64 * cg + 32 * i) * 512 + head * 128;
        T.lw[i] = *(const v4u*)(LFF + go + lt); T.lw[2 + i] = *(const v4u*)(LFB + go + lt);
        T.tv[i] = *(const v4u*)(VH + go + lt); if (QH) T.tq[i] = *(const v4u*)(QH + go + lt); }
}
__device__ __forceinline__ void hg_commit_scan(Frame& F, const HgTiles& T, bool hasq) {
#pragma unroll
    for (int i = 0; i < 2; ++i) { const int idx = F.tid + 512 * i, p = idx >> 4, ch = idx & 15;
#pragma unroll
        for (int dir = 0; dir < 2; ++dir) { const v4u w = T.lw[2 * dir + i]; LAS float* bp = (LAS float*)(F.lds + (dir ? HG_BB_OFF : HG_BF_OFF)) + p * HG_BST + 8 * ch;
            *(LAS f32x4*)bp = (f32x4){bflo(w.x), bfhi(w.x), bflo(w.y), bfhi(w.y)}; *(LAS f32x4*)(bp + 4) = (f32x4){bflo(w.z), bfhi(w.z), bflo(w.w), bfhi(w.w)}; }
        *(LAS v4u*)(F.lds + HG_V_OFF + hoff(p, ch)) = T.tv[i]; if (hasq) *(LAS v4u*)(F.lds + HG_Q_OFF + hoff(p, ch)) = T.tq[i]; }
    __syncthreads();
    if (F.tid < 128) { LAS float* bt = (LAS float*)(F.lds + HG_BF_OFF) + F.tid; float a = 0.f;
#pragma unroll 1
        for (int j0 = 0; j0 < 64; j0 += 8) { float v[8];
#pragma unroll
            for (int k = 0; k < 8; ++k) v[k] = bt[(j0 + k) * HG_BST];
#pragma unroll
            for (int k = 0; k < 8; ++k) { a += v[k]; bt[(j0 + k) * HG_BST] = a; } } }
    else if (F.tid < 256) { LAS float* bt = (LAS float*)(F.lds + HG_BB_OFF) + (F.tid - 128); float a = 0.f;
#pragma unroll 1
        for (int j0 = 0; j0 < 64; j0 += 8) { float v[8];
#pragma unroll
            for (int k = 0; k < 8; ++k) v[k] = bt[(63 - j0 - k) * HG_BST];
#pragma unroll
            for (int k = 0; k < 8; ++k) { a += v[k]; bt[(63 - j0 - k) * HG_BST] = a; } } }
    __syncthreads();
}
__device__ __forceinline__ void hg_phase_a(FA) {
    const bf16* LFF = WSP(bf16, WS_LFF); const bf16* LFB = WSP(bf16, WS_LFB); const bf16* VH = WSP(bf16, WS_VH); bf16* LT = WSP(bf16, WS_LT); float* HD = WSP(float, WS_HD);
    const int lane = F.lane, w = F.wave, g = lane >> 4, wdir = w >> 2, wq = w & 3;
    HgTiles T; if (F.bid < 2048) hg_issue(F, T, LFF, LFB, VH, nullptr, F.bid);
    for (int cu = F.bid; cu < 2048; cu += F.G) {
        hg_commit_scan(F, T, false);
        if (cu + F.G < 2048) hg_issue(F, T, LFF, LFB, VH, nullptr, cu + F.G);
#pragma unroll
        for (int i = 0; i < 4; ++i) { const int idx = F.tid + 512 * i, dir = idx >> 10, p = (idx >> 4) & 63, ch = idx & 15;
            const LAS float* bt = (const LAS float*)(F.lds + (dir ? HG_BB_OFF : HG_BF_OFF)); const LAS float* bj = bt + p * HG_BST + 8 * ch; const LAS float* bl = bt + (dir ? 0 : 63) * HG_BST + 8 * ch;
            const bool edge = dir ? (p == 63) : (p == 0); const int pst = edge ? 0 : (dir ? HG_BST : -HG_BST);
            float kt[8], vb[8], vp[8], vl[8]; lds8(bj, vb); lds8(bj + pst, vp); lds8(bl, vl);
#pragma unroll
            for (int e = 0; e < 8; ++e) { const float bb = vb[e], bp = edge ? 0.f : vp[e]; kt[e] = (1.0f - __expf(bb - bp)) * __expf(vl[e] - bb); }
            v4u o; o.x = pk2(kt[0], kt[1]); o.y = pk2(kt[2], kt[3]); o.z = pk2(kt[4], kt[5]); o.w = pk2(kt[6], kt[7]);
            *(LAS v4u*)(F.lds + HG_K2_OFF + dir * 16384 + hoff(p, ch)) = o; }
        if (F.tid < 256) { const int dir = F.tid >> 7, d = F.tid & 127; HD[(size_t)((cu * 2) + dir) * 128 + d] = __expf(((const LAS float*)(F.lds + (dir ? HG_BB_OFF : HG_BF_OFF)))[(dir ? 0 : 63) * HG_BST + d]); }
        __syncthreads();
        f32x4 acc[2][8];
#pragma unroll
        for (int mb = 0; mb < 2; ++mb)
#pragma unroll
            for (int c = 0; c < 8; ++c) acc[mb][c] = (f32x4){0.f, 0.f, 0.f, 0.f};
#pragma unroll
        for (int ks = 0; ks < 2; ++ks) {
            bf16x8 a[2];
#pragma unroll
            for (int mb = 0; mb < 2; ++mb) a[mb] = tr_frag(F.lds + HG_K2_OFF + wdir * 16384, lane, 2 * wq + mb, 32 * ks, 32 * ks + 16);
#pragma unroll
            for (int c = 0; c < 8; ++c) { const bf16x8 bv = tr_frag(F.lds + HG_V_OFF, lane, c, 32 * ks, 32 * ks + 16);
#pragma unroll
                for (int mb = 0; mb < 2; ++mb) acc[mb][c] = __builtin_amdgcn_mfma_f32_16x16x32_bf16(a[mb], bv, acc[mb][c], 0, 0, 0); } }
        bf16* lt = LT + (size_t)(cu * 2 + wdir) * 16384;
#pragma unroll
        for (int mb = 0; mb < 2; ++mb)
#pragma unroll
            for (int c = 0; c < 8; ++c) { v2u o; o.x = pk2(acc[mb][c][0], acc[mb][c][1]); o.y = pk2(acc[mb][c][2], acc[mb][c][3]);
                { const int mbg = 2 * wq + mb, ksq = mbg >> 1, gp = 2 * (mbg & 1) + (g >> 1); *(v2u*)(lt + (size_t)((c * 4 + ksq) * 64 + gp * 16 + (lane & 15)) * 8 + 4 * (g & 1)) = o; } }
        __syncthreads();
    }
}
__device__ __forceinline__ void hg_phase_b(FA) {
    const bf16* LT = WSP(bf16, WS_LT); const float* HD = WSP(float, WS_HD); bf16* SIN = WSP(bf16, WS_SIN); const int lane = F.lane;
    for (int tk = F.gw; tk < 3072; tk += F.NGW) {
        int idx, smp; if (tk < 1024) { idx = tk; smp = 0; } else if (tk < 2048) { idx = tk - 1024; smp = 1; } else { idx = tk - 1024; smp = 0; }
        const int eg = idx & 31, dir = (idx >> 5) & 1, head = (idx >> 6) & 3, sq = idx >> 8;
        const int c0 = smp ? (MPROMPT / 64) + sq * (TS / 64) : sq * (TP / 64), nch = smp ? TS / 64 : TP / 64;
        const int e0 = eg * 512 + lane * 8, d0 = 32 * (eg & 3) + 8 * (lane >> 4);
        float S[8];
#pragma unroll
        for (int e = 0; e < 8; ++e) S[e] = 0.f;
        v4u l4[4]; f32x4 da[4], db[4];
#pragma unroll
        for (int i = 0; i < 4; ++i) { const int cg = c0 + (dir ? nch - 1 - i : i); const size_t u = (size_t)((cg * 4 + head) * 2 + dir);
            l4[i] = *(const v4u*)(LT + u * 16384 + e0); da[i] = *(const f32x4*)(HD + u * 128 + d0); db[i] = *(const f32x4*)(HD + u * 128 + d0 + 4); }
        for (int n0 = 0; n0 < nch; n0 += 4) {
            v4u m4[4]; f32x4 ea[4], eb[4]; const int n1 = n0 + 4 < nch ? n0 + 4 : n0;
#pragma unroll
            for (int i = 0; i < 4; ++i) { const int cg = c0 + (dir ? nch - 1 - (n1 + i) : n1 + i); const size_t u = (size_t)((cg * 4 + head) * 2 + dir);
                m4[i] = *(const v4u*)(LT + u * 16384 + e0); ea[i] = *(const f32x4*)(HD + u * 128 + d0); eb[i] = *(const f32x4*)(HD + u * 128 + d0 + 4); }
#pragma unroll
            for (int i = 0; i < 4; ++i) { const int cg = c0 + (dir ? nch - 1 - (n0 + i) : n0 + i); const size_t u = (size_t)((cg * 4 + head) * 2 + dir);
                v4u o; o.x = pk2(S[0], S[1]); o.y = pk2(S[2], S[3]); o.z = pk2(S[4], S[5]); o.w = pk2(S[6], S[7]); *(v4u*)(SIN + u * 16384 + e0) = o;
                S[0] = da[i][0] * S[0] + bflo(l4[i].x); S[1] = da[i][1] * S[1] + bfhi(l4[i].x); S[2] = da[i][2] * S[2] + bflo(l4[i].y); S[3] = da[i][3] * S[3] + bfhi(l4[i].y);
                S[4] = db[i][0] * S[4] + bflo(l4[i].z); S[5] = db[i][1] * S[5] + bfhi(l4[i].z); S[6] = db[i][2] * S[6] + bflo(l4[i].w); S[7] = db[i][3] * S[7] + bfhi(l4[i].w); }
#pragma unroll
            for (int i = 0; i < 4; ++i) { l4[i] = m4[i]; da[i] = ea[i]; db[i] = eb[i]; }
        }
    }
}
__device__ __forceinline__ void hg_phase_c(FA, const float* gnorm) {
    const bf16* LFF = WSP(bf16, WS_LFF); const bf16* LFB = WSP(bf16, WS_LFB); const bf16* VH = WSP(bf16, WS_VH); const bf16* QH = WSP(bf16, WS_QH); const bf16* SIN = WSP(bf16, WS_SIN);
    const bf16* GH = WSP(bf16, WS_GH); bf16* CAT = WSP(bf16, WS_CAT);
    const int lane = F.lane, w = F.wave, g = lane >> 4, tl = lane & 15, dir = w >> 2, PI = w & 3;
    const LAS float* bt = (const LAS float*)(F.lds + (dir ? HG_BB_OFF : HG_BF_OFF));
    const int pst = dir ? HG_BST : -HG_BST;
    const bool hasref = dir ? (PI < 3) : (PI > 0); const int refrow = hasref ? (dir ? 16 * PI + 16 : 16 * PI - 1) : 0;
    HgTiles T; if (F.bid < 2048) hg_issue(F, T, LFF, LFB, VH, QH, F.bid);
    for (int cu = F.bid; cu < 2048; cu += F.G) {
        const int head = cu & 3, cg = cu >> 2;
        const bf16* st = SIN + (size_t)(cu * 2 + dir) * 16384;
        bf16x8 sb[2][4];
#pragma unroll
        for (int c = 0; c < 2; ++c)
#pragma unroll
            for (int ks = 0; ks < 4; ++ks) sb[c][ks] = *(const bf16x8*)(st + (size_t)((c * 4 + ks) * 64 + lane) * 8);
        hg_commit_scan(F, T, true);
        const int p = 16 * PI + tl;
        bf16x8 qt[4], qh[4]; f32x4 acc[8];
#pragma unroll
        for (int c = 0; c < 8; ++c) acc[c] = (f32x4){0.f, 0.f, 0.f, 0.f};
#pragma unroll
        for (int ks = 0; ks < 4; ++ks) { const int d0 = 32 * ks + 8 * g; const LAS float* bj = bt + p * HG_BST + d0; const LAS float* br = bt + refrow * HG_BST + d0;
            const v4u q4 = *(const LAS v4u*)(F.lds + HG_Q_OFF + hoff(p, 4 * ks + g)); const float qv[8] = {bflo(q4.x), bfhi(q4.x), bflo(q4.y), bfhi(q4.y), bflo(q4.z), bfhi(q4.z), bflo(q4.w), bfhi(q4.w)};
            float a[8], h[8], vb[8], vr[8]; lds8(bj, vb); lds8(br, vr);
#pragma unroll
            for (int e = 0; e < 8; ++e) { const float bb = vb[e], rr = hasref ? vr[e] : 0.f; a[e] = qv[e] * __expf(bb); h[e] = qv[e] * __expf(bb - rr); }
            v4u o; o.x = pk2(a[0], a[1]); o.y = pk2(a[2], a[3]); o.z = pk2(a[4], a[5]); o.w = pk2(a[6], a[7]); qt[ks] = __builtin_bit_cast(bf16x8, o);
            o.x = pk2(h[0], h[1]); o.y = pk2(h[2], h[3]); o.z = pk2(h[4], h[5]); o.w = pk2(h[6], h[7]); qh[ks] = __builtin_bit_cast(bf16x8, o); }
#pragma unroll
        for (int cb = 0; cb < 4; ++cb) {
            bf16x8 sn[2][4];
            if (cb < 3) {
#pragma unroll
                for (int c = 0; c < 2; ++c)
#pragma unroll
                    for (int ks = 0; ks < 4; ++ks) sn[c][ks] = *(const bf16x8*)(st + (size_t)(((2 * cb + 2 + c) * 4 + ks) * 64 + lane) * 8); }
#pragma unroll
            for (int c = 0; c < 2; ++c)
#pragma unroll
                for (int ks = 0; ks < 4; ++ks) acc[2 * cb + c] = __builtin_amdgcn_mfma_f32_16x16x32_bf16(qt[ks], sb[c][ks], acc[2 * cb + c], 0, 0, 0);
            if (cb < 3) {
#pragma unroll
                for (int c = 0; c < 2; ++c)
#pragma unroll
                    for (int ks = 0; ks < 4; ++ks) sb[c][ks] = sn[c][ks]; }
        }
        if (cu + F.G < 2048) hg_issue(F, T, LFF, LFB, VH, QH, cu + F.G);
#pragma unroll 1
        for (int jp = 0; jp < 2; ++jp) {
            if (dir ? (2 * jp + 1 < PI) : (2 * jp > PI)) continue;
            f32x4 pt[2];
#pragma unroll
            for (int jj = 0; jj < 2; ++jj) { const int PJ = 2 * jp + jj; pt[jj] = (f32x4){0.f, 0.f, 0.f, 0.f};
                if (dir ? (PJ >= PI) : (PJ <= PI)) { const int s = 16 * PJ + tl; const bool edge = dir ? (s == 63) : (s == 0);
#pragma unroll
                    for (int ks = 0; ks < 4; ++ks) { const int d0 = 32 * ks + 8 * g; const LAS float* bs = bt + s * HG_BST + d0; const LAS float* br = bt + refrow * HG_BST + d0;
                        float kh[8], vb[8], vp[8], vr[8]; lds8(bs, vb); lds8(bs + (edge ? 0 : pst), vp); lds8(br, vr);
#pragma unroll
                        for (int e = 0; e < 8; ++e) { const float bb = vb[e], bp = edge ? 0.f : vp[e], rr = hasref ? vr[e] : 0.f; kh[e] = (1.0f - __expf(bb - bp)) * __expf(rr - bb); }
                        v4u o; o.x = pk2(kh[0], kh[1]); o.y = pk2(kh[2], kh[3]); o.z = pk2(kh[4], kh[5]); o.w = pk2(kh[6], kh[7]);
                        pt[jj] = __builtin_amdgcn_mfma_f32_16x16x32_bf16(__builtin_bit_cast(bf16x8, o), qh[ks], pt[jj], 0, 0, 0); }
                    if (PJ == PI) {
#pragma unroll
                        for (int r = 0; r < 4; ++r) if (dir ? (4 * g + r < tl) : (4 * g + r > tl)) pt[jj][r] = 0.f; }
                } }
            v4u pa; pa.x = pk2(pt[0][0], pt[0][1]); pa.y = pk2(pt[0][2], pt[0][3]); pa.z = pk2(pt[1][0], pt[1][1]); pa.w = pk2(pt[1][2], pt[1][3]);
#pragma unroll
            for (int cq = 0; cq < 2; ++cq) { bf16x8 bv[4];
#pragma unroll
                for (int c = 0; c < 4; ++c) bv[c] = tr_frag(F.lds + HG_V_OFF, lane, 4 * cq + c, 32 * jp, 32 * jp + 16);
#pragma unroll
                for (int c = 0; c < 4; ++c) acc[4 * cq + c] = __builtin_amdgcn_mfma_f32_16x16x32_bf16(__builtin_bit_cast(bf16x8, pa), bv[c], acc[4 * cq + c], 0, 0, 0); }
        }
        __syncthreads();
        const int fpos = 8 * w + (lane >> 3), fvc = lane & 7; const size_t ftok = (size_t)(64 * cg + fpos);
        v4u ghv[2]; f32x4 gnv[4];
#pragma unroll
        for (int hh = 0; hh < 2; ++hh) { ghv[hh] = *(const v4u*)(GH + ftok * 512 + head * 128 + 16 * fvc + 8 * hh); gnv[2 * hh] = *(const f32x4*)(gnorm + head * 128 + 16 * fvc + 8 * hh); gnv[2 * hh + 1] = *(const f32x4*)(gnorm + head * 128 + 16 * fvc + 8 * hh + 4); }
        { LAS float* ob = (LAS float*)F.lds + dir * 64 * HG_OST;
#pragma unroll
            for (int r = 0; r < 4; ++r)
#pragma unroll
                for (int c = 0; c < 8; ++c) ob[(16 * PI + 4 * g + r) * HG_OST + 16 * c + tl] = acc[c][r]; }
        __syncthreads();
        { const int pos = 8 * w + (lane >> 3), vc = lane & 7; const LAS float* o0 = (const LAS float*)F.lds + pos * HG_OST + 16 * vc; const LAS float* o1 = o0 + 64 * HG_OST;
            float x[16]; float ss = 0.f;
#pragma unroll
            for (int i = 0; i < 4; ++i) { const f32x4 a = *(const LAS f32x4*)(o0 + 4 * i), b2 = *(const LAS f32x4*)(o1 + 4 * i);
#pragma unroll
                for (int e = 0; e < 4; ++e) { const float v = a[e] + b2[e]; x[4 * i + e] = v; ss += v * v; } }
            ss += xshfl<1>(ss, lane); ss += xshfl<2>(ss, lane); ss += xshfl<4>(ss, lane);
            const float rstd = fast_rsq(ss * (1.0f / 128.0f) + EPS);
            bf16* op = CAT + ftok * DM + 512 + head * 128 + 16 * vc;
#pragma unroll
            for (int hh = 0; hh < 2; ++hh) { const v4u gh = ghv[hh]; const f32x4 g0 = gnv[2 * hh], g1 = gnv[2 * hh + 1]; const float* xx = x + 8 * hh;
                v4u o; o.x = pk2(xx[0] * rstd * g0[0] * bflo(gh.x), xx[1] * rstd * g0[1] * bfhi(gh.x)); o.y = pk2(xx[2] * rstd * g0[2] * bflo(gh.y), xx[3] * rstd * g0[3] * bfhi(gh.y));
                o.z = pk2(xx[4] * rstd * g1[0] * bflo(gh.z), xx[5] * rstd * g1[1] * bfhi(gh.z)); o.w = pk2(xx[6] * rstd * g1[2] * bflo(gh.w), xx[7] * rstd * g1[3] * bfhi(gh.w));
                *(v4u*)(op + 8 * hh) = o; } }
        __syncthreads();
    }
}

__device__ __forceinline__ void na_phase(FA, const float* relb, const float* qng, const float* kng) {
    const bf16* Q = WSP(bf16, WS_Q); const bf16* K = WSP(bf16, WS_K); const bf16* V = WSP(bf16, WS_V); bf16* O = WSP(bf16, WS_O);
    const int lane = F.lane, w = F.wave, g = lane >> 4, tl = lane & 15, qb = w & 3, hh = w >> 2;
    const int kb_lo = qb >= 2 ? qb - 1 : 0, kb_hi = qb <= 1 ? qb + 1 : 3;
    LAS float* btab = (LAS float*)(F.lds + NA_BIAS_OFF); int hp_loaded = -1;
    float Bnd; { float mq = wave_max(fabsf(qng[lane]), lane), mk = wave_max(fabsf(kng[lane]), lane), mb = 0.f;
        for (int i = lane; i < 8 * 15 * 31; i += 64) mb = fmaxf(mb, fabsf(relb[i]));
        Bnd = 8.0f * mq * mk + wave_max(mb, lane); }
    constexpr int NA_V_OFF = RING_OFF, NA_K_OFF = RING_OFF + 65536;
    const unsigned vlt = (unsigned)((F.tid >> 4) * 512 + 8 * (F.tid & 15)), vlds = hoff(F.tid >> 4, F.tid & 15);
    const unsigned klt = (unsigned)(tl * 512 + 8 * g);
    v4u vv[8], kk[8];
#define NA_ISSUE(uu, ss) do { const int hp_ = (uu) & 3, R_ = (uu) >> 2; int Rb_, gr_, rows_; \
        if (R_ < MPROMPT / 64) { Rb_ = R_ & ~31; gr_ = R_ & 31; rows_ = 32; } else { Rb_ = 256 + ((R_ - 256) & ~63); gr_ = (R_ - 256) & 63; rows_ = 64; } \
        const size_t go_ = (size_t)((Rb_ + min(max(gr_ - 4, 0), rows_ - 8)) * 64 + 256 * (ss)) * 512 + hp_ * 128; \
        _Pragma("unroll") for (int i = 0; i < 8; ++i) { vv[i] = *(const v4u*)(V + go_ + (size_t)(32 * i) * 512 + vlt); kk[i] = *(const v4u*)(K + go_ + (size_t)(32 * i) * 512 + vlt); } } while (0)
    if (F.bid < 512 * 4) NA_ISSUE(F.bid, 0);
    for (int u = F.bid; u < 512 * 4; u += F.G) {
        const int hp = u & 3, R = u >> 2; int Rb, gr, rows;
        if (R < MPROMPT / 64) { Rb = R & ~31; gr = R & 31; rows = 32; } else { Rb = 256 + ((R - 256) & ~63); gr = (R - 256) & 63; rows = 64; }
        const int rs = min(max(gr - 4, 0), rows - 8), head = 2 * hp + hh;
        const int gc = 16 * qb + tl, cs = min(max(gc - 8, 0), 48), qrow = R * 64 + gc;
        bf16x8 qf[2];
#pragma unroll
        for (int ks = 0; ks < 2; ++ks) qf[ks] = *(const bf16x8*)(Q + (size_t)(R * 64 + 16 * qb) * 512 + head * 64 + 32 * ks + klt);
        if (hp != hp_loaded) { for (int i = F.tid; i < 2 * 15 * 31; i += 512) btab[i] = relb[hp * 2 * 15 * 31 + i] - Bnd; hp_loaded = hp; }
        f32x4 acc[4];
#pragma unroll
        for (int db = 0; db < 4; ++db) acc[db] = (f32x4){0.f, 0.f, 0.f, 0.f};
        float lrun = 0.f;
#pragma unroll 1
        for (int sg = 0; sg < 2; ++sg) {
#pragma unroll
            for (int i = 0; i < 8; ++i) { *(LAS v4u*)(F.lds + NA_V_OFF + vlds + 8192 * i) = vv[i]; *(LAS v4u*)(F.lds + NA_K_OFF + vlds + 8192 * i) = kk[i]; }
            __syncthreads();
            if (sg == 0) NA_ISSUE(u, 1); else if (u + F.G < 512 * 4) NA_ISSUE(u + F.G, 0);
#pragma unroll
            for (int al = 0; al < 4; ++al) {
                const int dr = rs + 4 * sg + al - gr; const LAS float* brow = btab + (hh * 15 + dr + 7) * 31 + 15 - gc;
                f32x4 st[4];
#pragma unroll
                for (int kb = 0; kb < 4; ++kb) { st[kb] = (f32x4){0.f, 0.f, 0.f, 0.f};
                    if (kb >= kb_lo && kb <= kb_hi) {
#pragma unroll
                        for (int ks = 0; ks < 2; ++ks) st[kb] = __builtin_amdgcn_mfma_f32_16x16x32_bf16(*(const LAS bf16x8*)(F.lds + NA_K_OFF + hoff(64 * al + 16 * kb + tl, 8 * hh + 4 * ks + g)), qf[ks], st[kb], 0, 0, 0); } }
#pragma unroll
                for (int kb = 0; kb < 4; ++kb) {
                    if (kb < kb_lo || kb > kb_hi) continue;
                    float bv[4], ev[4];
#pragma unroll
                    for (int r = 0; r < 4; ++r) { const int kc = 16 * kb + 4 * g + r; bv[r] = brow[min(max(kc, cs), cs + 15)]; }
#pragma unroll
                    for (int r = 0; r < 4; ++r) ev[r] = __expf(st[kb][r] * 0.125f + bv[r]);
#pragma unroll
                    for (int r = 0; r < 4; ++r) { const int kc = 16 * kb + 4 * g + r; const float p = (kc >= cs && kc < cs + 16) ? ev[r] : 0.f; st[kb][r] = p; lrun += p; } }
#pragma unroll
                for (int kp2 = 0; kp2 < 2; ++kp2) {
                    if (2 * kp2 + 1 < kb_lo || 2 * kp2 > kb_hi) continue;
                    v4u pb; pb.x = pk2(st[2 * kp2][0], st[2 * kp2][1]); pb.y = pk2(st[2 * kp2][2], st[2 * kp2][3]); pb.z = pk2(st[2 * kp2 + 1][0], st[2 * kp2 + 1][1]); pb.w = pk2(st[2 * kp2 + 1][2], st[2 * kp2 + 1][3]);
                    bf16x8 va[4];
#pragma unroll
                    for (int db = 0; db < 4; ++db) va[db] = tr_frag(F.lds + NA_V_OFF, lane, 4 * hh + db, 64 * al + 32 * kp2, 64 * al + 32 * kp2 + 16);
#pragma unroll
                    for (int db = 0; db < 4; ++db) acc[db] = __builtin_amdgcn_mfma_f32_16x16x32_bf16(va[db], __builtin_bit_cast(bf16x8, pb), acc[db], 0, 0, 0);
                }
            }
            __syncthreads();
        }
        lrun += xshfl<16>(lrun, lane); lrun += xshfl<32>(lrun, lane);
        const float inv = 1.0f / lrun;
        bf16* op = O + (size_t)qrow * 512 + head * 64 + 4 * g;
#pragma unroll
        for (int db = 0; db < 4; ++db) { v2u o; o.x = pk2(acc[db][0] * inv, acc[db][1] * inv); o.y = pk2(acc[db][2] * inv, acc[db][3] * inv); *(v2u*)(op + 16 * db) = o; }
    }
#undef NA_ISSUE
}

__device__ __forceinline__ void post_phase(FA, int l) {
    const bf16* O = WSP(bf16, WS_O); const bf16* Y2 = WSP(bf16, WS_Y2); bf16* CAT = WSP(bf16, WS_CAT);
    const float* ga = AIN(11) + l * 512; const float* gc = AIN(24) + l * 1024; const int lane = F.lane;
    for (int r = F.gw; r < MTOK; r += F.NGW) {
        {
            const v4u w = *(const v4u*)(O + (size_t)r * 512 + 8 * lane); float x[8] = {bflo(w.x), bfhi(w.x), bflo(w.y), bfhi(w.y), bflo(w.z), bfhi(w.z), bflo(w.w), bfhi(w.w)}; float s = 0.f;
#pragma unroll
            for (int i = 0; i < 8; ++i) s += x[i] * x[i];
            const float rstd = fast_rsq(wave_sum(s, F.lane) * (1.0f / 512.0f) + EPS); const f32x4 g0 = *(const f32x4*)(ga + 8 * lane), g1 = *(const f32x4*)(ga + 8 * lane + 4);
            v4u o; o.x = pk2(x[0] * rstd * g0[0], x[1] * rstd * g0[1]); o.y = pk2(x[2] * rstd * g0[2], x[3] * rstd * g0[3]); o.z = pk2(x[4] * rstd * g1[0], x[5] * rstd * g1[1]); o.w = pk2(x[6] * rstd * g1[2], x[7] * rstd * g1[3]);
            *(v4u*)(CAT + (size_t)r * DM + 8 * lane) = o; }
        {
            float s = 0.f; v4u w[2];
#pragma unroll
            for (int hh = 0; hh < 2; ++hh) { w[hh] = *(const v4u*)(Y2 + (size_t)r * 1024 + 512 * hh + 8 * lane);
                s += bflo(w[hh].x) * bflo(w[hh].x) + bfhi(w[hh].x) * bfhi(w[hh].x) + bflo(w[hh].y) * bflo(w[hh].y) + bfhi(w[hh].y) * bfhi(w[hh].y) + bflo(w[hh].z) * bflo(w[hh].z) + bfhi(w[hh].z) * bfhi(w[hh].z) + bflo(w[hh].w) * bflo(w[hh].w) + bfhi(w[hh].w) * bfhi(w[hh].w); }
            const float rstd = fast_rsq(wave_sum(s, F.lane) * (1.0f / 1024.0f) + EPS);
#pragma unroll
            for (int hh = 0; hh < 2; ++hh) { const f32x4 g0 = *(const f32x4*)(gc + 512 * hh + 8 * lane), g1 = *(const f32x4*)(gc + 512 * hh + 8 * lane + 4);
                v4u o; o.x = pk2(bflo(w[hh].x) * rstd * g0[0], bfhi(w[hh].x) * rstd * g0[1]); o.y = pk2(bflo(w[hh].y) * rstd * g0[2], bfhi(w[hh].y) * rstd * g0[3]);
                o.z = pk2(bflo(w[hh].z) * rstd * g1[0], bfhi(w[hh].z) * rstd * g1[1]); o.w = pk2(bflo(w[hh].w) * rstd * g1[2], bfhi(w[hh].w) * rstd * g1[3]);
                *(v4u*)(CAT + (size_t)r * DM + 1024 + 512 * hh + 8 * lane) = o; } }
    }
}

__global__ void __launch_bounds__(NWAVES * 64, 2) enc_fwd(const Args A) {
    extern __shared__ __attribute__((aligned(16))) unsigned char lds[];
    Frame F;
    F.lds = (LAS unsigned char*)lds; F.MISC = (volatile LAS unsigned*)(F.lds + MISC_OFF);
    F.tid = threadIdx.x; F.lane = F.tid & 63; F.wave = __builtin_amdgcn_readfirstlane(F.tid >> 6);
    const int wave0 = F.wave;
    F.G = gridDim.x; F.gw = blockIdx.x * NWAVES + F.wave; F.NGW = F.G * NWAVES; F.bid = blockIdx.x; F.ws = (unsigned char*)A.in[32]; F.X = (float*)A.in[31]; F.zi = 0;

    for (int u = F.tid; u < (LDS_BYTES - LDSCTL_OFF) / 4; u += NWAVES * 64) ((LAS unsigned*)(F.lds + LDSCTL_OFF))[u] = 0u;
    __syncthreads();
    if (!MK_PER_PHASE) (void)xcd_barrier_post((unsigned*)((unsigned char*)A.in[32] + WS_CTL) + CW_BAR, (volatile LAS unsigned*)((LAS unsigned char*)lds + MISC_OFF) + 8);
#define GRID_BAR() do { if (MK_PER_PHASE) { if (F.tid == 0) __hip_atomic_store((gu32*)(F.ws + WS_CTL) + CW_TMO, 0xBADBA0u, RLX_AGENT); } \
    else { unsigned zb_ = 0u; asm volatile("" : "+v"(zb_)); zb_ = (unsigned)__builtin_amdgcn_readfirstlane((int)zb_); unsigned char* wsb_ = (unsigned char*)A.in[32 + (int)zb_]; \
           XcdBarrier b_; b_.bar = (unsigned*)(wsb_ + WS_CTL) + CW_BAR; b_.x = xb_xcc_id(); b_.t0 = (wave0 == 0) && (fresh_lane() == 0); b_.st = (volatile LAS unsigned*)((LAS unsigned char*)lds + MISC_OFF) + 8; xcd_barrier(b_); } } while (0)
#ifndef ONLY
#define ONLY -1
#endif
#define IN(k) ((ONLY < 0 || ((k) - p0) == ONLY) && A.ph_lo <= (k) && (k) < A.ph_hi)
#define SEAM(k) do { if (IN(k) && IN((k) + 1)) GRID_BAR(); } while (0)
#define PHASE_BEGIN() do { int t_ = wave0 * 64 + fresh_lane(); asm volatile("" : "+v"(t_)); F.tid = t_; F.lane = t_ & 63; F.wave = __builtin_amdgcn_readfirstlane(t_ >> 6); \
        int b_ = blockIdx.x; asm volatile("" : "+v"(b_)); b_ = __builtin_amdgcn_readfirstlane(b_); F.bid = b_; F.G = gridDim.x; F.NGW = F.G * NWAVES; F.gw = b_ * NWAVES + F.wave; \
        unsigned z_ = 0u; asm volatile("" : "+v"(z_)); z_ = (unsigned)__builtin_amdgcn_readfirstlane((int)z_); F.zi = (int)z_; F.ws = (unsigned char*)AIN(32); F.X = (float*)AIN(31); } while (0)
    for (int l = 0; l < NL; ++l) {
        const int p0 = l * PH_PER_LAYER;
#define SSP(ll, k) (WSP(u64, WS_SS) + (size_t)(1 + 4 * (ll) + (k)) * MTOK)
        if (IN(p0 + 0)) { PHASE_BEGIN();
            if (F.wave & 1) { s5_ops(F, A, l); conv_layer(F, A, l); } else { conv_layer(F, A, l); s5_ops(F, A, l); }
            if (l == 0) { lb_table(F, A); prep_phase(F, A); }
        }
        SEAM(p0 + 0);
#define HOFF(hf) ((size_t)(hf) * MPROMPT)
#define FFN_UP(hf, WOFF, SA, SB, UB) do { PHASE_BEGIN(); pg8::Gemm g{WSP(bf16, WS_XB) + HOFF(hf) * DM, WSP(bf16, WOFF), MPROMPT, 2 * FF, DM, DM, DM}; pg8::StaticOrder S; S.init(MPROMPT, 2 * FF, F.G, F.bid, WGM_UP); \
            EpiSwiGLU E{WSP(bf16, WS_H) + HOFF(hf) * FF, RowScale{(SA) + HOFF(hf), (SB) + HOFF(hf), UB}}; pg8::gemm_phase<EpiSwiGLU, pg8::StaticOrder, true, true>(F.lds + RING_OFF, g, S, E, F.tid); } while (0)
#define FFN_DN(hf, WOFF, PRE, HASPRE, PREG, SSA, SSB, GB) do { PHASE_BEGIN(); pg8::Gemm g{WSP(bf16, WS_H) + HOFF(hf) * FF, WSP(bf16, WOFF), MPROMPT, DM, FF, FF, FF}; pg8::StaticOrder S; S.init(MPROMPT, DM, F.G, F.bid, WGM_DN); \
            u64* ssb_ = (SSB); EpiResid E{WSP(bf16, WS_XB) + HOFF(hf) * DM, 0.5f, (PRE) + HOFF(hf), HASPRE, PREG, (SSA) + HOFF(hf), ssb_ ? ssb_ + HOFF(hf) : nullptr, GB}; \
            pg8::gemm_phase<EpiResid, pg8::StaticOrder, true, true>(F.lds + RING_OFF, g, S, E, F.tid); } while (0)
        if (IN(p0 + 1)) { FFN_UP(0, WS_WGU1, l ? SSP(l - 1, 2) : WSP(u64, WS_SS), l ? SSP(l - 1, 3) : WSP(u64, WS_SS), l != 0); }
        SEAM(p0 + 1);
        if (IN(p0 + 2)) { FFN_DN(0, WS_WD1, l ? SSP(l - 1, 2) : SSP(l, 0), l != 0, l ? AIN(30) + (l - 1) * DM : nullptr, SSP(l, 0), (u64*)nullptr, nullptr); __syncthreads();
                          FFN_UP(1, WS_WGU1, l ? SSP(l - 1, 2) : WSP(u64, WS_SS), l ? SSP(l - 1, 3) : WSP(u64, WS_SS), l != 0); }
        SEAM(p0 + 2);
        if (IN(p0 + 3)) { FFN_DN(1, WS_WD1, l ? SSP(l - 1, 2) : SSP(l, 0), l != 0, l ? AIN(30) + (l - 1) * DM : nullptr, SSP(l, 0), (u64*)nullptr, nullptr); }
        SEAM(p0 + 3);
        if (IN(p0 + 4)) { PHASE_BEGIN(); pg8::Gemm g{WSP(bf16, WS_XB), WSP(bf16, WS_WIN), MTOK, INC, DM, DM, DM}; pg8::StaticOrder S; S.init(MTOK, INC, F.G, F.bid, WGM_IN);
            EpiWin E{WSP(bf16, WS_Q), WSP(bf16, WS_K), WSP(bf16, WS_V), WSP(bf16, WS_QH), WSP(bf16, WS_VH), WSP(bf16, WS_GH), WSP(bf16, WS_LFF), WSP(bf16, WS_LFB), WSP(bf16, WS_UX),
                     AIN(8) + l * 64, AIN(9) + l * 64, WSP(float, WS_TAB) + l * 1024, RowScale{SSP(l, 0), SSP(l, 0), false}};
            pg8::gemm_phase<EpiWin, pg8::StaticOrder, true, true>(F.lds + RING_OFF, g, S, E, F.tid); }
        SEAM(p0 + 4);
        if (IN(p0 + 5)) { PHASE_BEGIN(); pg8::Gemm g{WSP(bf16, WS_UX), WSP(bf16, WS_S5E), 64 * 2048, 64 * 256, 256, 512, 256}; S5Order S{F.G, F.bid};
            EpiS5E E{WSP(bf16, WS_E)}; pg8::gemm_phase<EpiS5E, S5Order, false, true>(F.lds + RING_OFF, g, S, E, F.tid);
            __syncthreads(); hg_phase_a(F, A);
        }
        SEAM(p0 + 5);
        if (IN(p0 + 6)) { PHASE_BEGIN();
            hg_phase_b(F, A);
            if (F.gw < 1536) s5_carry(F, A, l, F.gw, 1536);
            __syncthreads(); na_phase(F, A, AIN(10) + l * (8 * 15 * 31), AIN(8) + l * 64, AIN(9) + l * 64);
        }
        SEAM(p0 + 6);
        if (IN(p0 + 7)) { PHASE_BEGIN(); pg8::Gemm g{WSP(bf16, WS_UX), WSP(bf16, WS_S5Y), 64 * 2048, 64 * 256, 512, 512, 512}; S5Order S{F.G, F.bid};
            EpiS5Y E{WSP(bf16, WS_YPRE)}; pg8::gemm_phase<EpiS5Y, S5Order, true, true>(F.lds + RING_OFF, g, S, E, F.tid);
            __syncthreads(); hg_phase_c(F, A, AIN(13) + l * 512);
        }
        SEAM(p0 + 7);
        if (IN(p0 + 8)) { PHASE_BEGIN(); pg8::Gemm g{WSP(bf16, WS_YPRE), WSP(bf16, WS_WGLU), MTOK, S5W, S5W, S5W, S5W}; pg8::StaticOrder S; S.init(MTOK, S5W, F.G, F.bid, WGM_DN);
            EpiGLU E{WSP(bf16, WS_YPRE), AIN(23) + l * S5W, WSP(bf16, WS_Y2)}; pg8::gemm_phase<EpiGLU, pg8::StaticOrder, true, true>(F.lds + RING_OFF, g, S, E, F.tid); }
        SEAM(p0 + 8);
        if (IN(p0 + 9)) { PHASE_BEGIN(); post_phase(F, A, l); }
        SEAM(p0 + 9);
        if (IN(p0 + 10)) { PHASE_BEGIN(); pg8::Gemm g{WSP(bf16, WS_CAT), WSP(bf16, WS_WOUT), MTOK, DM, DM, DM, DM}; pg8::StaticOrder S; S.init(MTOK, DM, F.G, F.bid, WGM_DN);
            EpiResid E{WSP(bf16, WS_XB), 1.0f, SSP(l, 1), false, nullptr, SSP(l, 1), nullptr, nullptr}; pg8::gemm_phase<EpiResid, pg8::StaticOrder, true, true>(F.lds + RING_OFF, g, S, E, F.tid); }
        SEAM(p0 + 10);
        if (IN(p0 + 11)) { FFN_UP(0, WS_WGU2, SSP(l, 1), SSP(l, 1), false); }
        SEAM(p0 + 11);
        if (IN(p0 + 12)) { FFN_DN(0, WS_WD2, SSP(l, 2), false, nullptr, SSP(l, 2), SSP(l, 3), AIN(30) + l * DM); __syncthreads();
                           FFN_UP(1, WS_WGU2, SSP(l, 1), SSP(l, 1), false); }
        SEAM(p0 + 12);
        if (IN(p0 + 13)) { FFN_DN(1, WS_WD2, SSP(l, 2), false, nullptr, SSP(l, 2), SSP(l, 3), AIN(30) + l * DM); }
        if (l == NL - 1) SEAM(p0 + 13);
        if (IN(p0 + 14) && l == NL - 1) { PHASE_BEGIN(); out_norm_phase(F, A, SSP(l, 2), AIN(30) + l * DM); }
        SEAM(p0 + 14);
    }
#undef IN
#undef SEAM
}

extern "C" void kernel_launch(void* const* d_in, const int* in_sizes, int n_in, void* d_out, int out_size, void* d_ws, size_t ws_size, hipStream_t stream) {
    static int grid = 0;
    if (grid == 0) {
        if (n_in != 31 || out_size != MTOK * DM || ws_size < WS_END) { fprintf(stderr, "kernel_launch: unexpected shapes: n_in %d out %d ws %zu (need %zu); nothing launched\n", n_in, out_size, ws_size, (size_t)WS_END); grid = -1; return; }
        int dev = 0, cus = 0, per_cu = 0;
        if (hipGetDevice(&dev) != hipSuccess || hipDeviceGetAttribute(&cus, hipDeviceAttributeMultiprocessorCount, dev) != hipSuccess) { grid = -1; return; }
        if (hipFuncSetAttribute((const void*)enc_fwd, hipFuncAttributeMaxDynamicSharedMemorySize, LDS_BYTES) != hipSuccess) { fprintf(stderr, "kernel_launch: hipFuncSetAttribute failed\n"); grid = -1; return; }
        if (hipOccupancyMaxActiveBlocksPerMultiprocessor(&per_cu, (const void*)enc_fwd, NWAVES * 64, LDS_BYTES) != hipSuccess || per_cu < 1)
            fprintf(stderr, "kernel_launch: note: occupancy query reports %d workgroups per CU\n", per_cu);
        (void)hipGetLastError();
        grid = cus;
    }
    if (grid < 0) return;
    static_assert(WS_SS + SS_BYTES == WS_CTL && WS_CTL + CTL_ZERO_BYTES == WS_END, "row sums and control words are one contiguous region");
    if (hipMemsetAsync((char*)d_ws + WS_SS, 0, SS_BYTES + CTL_ZERO_BYTES, stream) != hipSuccess) { fprintf(stderr, "kernel_launch: memset failed\n"); return; }
    Args a{};
    for (int i = 0; i < 31; ++i) a.in[i] = (const float*)d_in[i];
    a.in[31] = (const float*)d_out; a.in[32] = (const float*)d_ws; a.li = 0; a.pad = 0;
#if MK_PER_PHASE
    for (int p = 0; p < N_PHASES; ++p) { a.ph_lo = p; a.ph_hi = p + 1; hipLaunchKernelGGL(enc_fwd, dim3(grid), dim3(NWAVES * 64), LDS_BYTES, stream, a); }
#else
    a.ph_lo = 0; a.ph_hi = N_PHASES; hipLaunchKernelGGL(enc_fwd, dim3(grid), dim3(NWAVES * 64), LDS_BYTES, stream, a);
#endif
    const hipError_t le = hipPeekAtLastError();
    if (le != hipSuccess) fprintf(stderr, "kernel_launch: launch failed: %s\n", hipGetErrorName(le));
}
```

```cpp
#include <hip/hip_runtime.h>
#include <cstdio>
#include <cstdint>
namespace pg8 {
#define PG8_LAS __attribute__((address_space(3)))
typedef unsigned short bf16_t;
typedef short bf16x8 __attribute__((ext_vector_type(8)));
typedef float f32x4 __attribute__((ext_vector_type(4)));
typedef unsigned u32x4 __attribute__((ext_vector_type(4)));
constexpr int BM = 256, BK = 64, HALF = 128, HTB = HALF * BK * 2  , STAGE_BYTES = 8 * HTB, NXCD = 8, WGM = 8;

__host__ __device__ __forceinline__ int lds_byte(int r, int c) { const int st = (r >> 4) * 2 + (c >> 5), rr = r & 15, cc = c & 31, ob = rr * 64 + cc * 2; return st * 1024 + (ob ^ (((ob >> 9) & 1) << 5)); }
__host__ __device__ __forceinline__ void stage_rc(int b, int& R, int& C) { const int st = b / 1024, sb = b % 1024, swz = sb ^ (((sb >> 9) & 1) << 5); R = (st >> 1) * 16 + swz / 64; C = (st & 1) * 32 + (swz % 64) / 2; }
__host__ __device__ __forceinline__ int perm32(int rho) { const int n = rho >> 4, i = rho & 15; return 8 * (i >> 2) + 4 * n + (i & 3); }

struct Unit { int pm, pn; };
struct Gemm { const bf16_t* A; const bf16_t* Bt; int M, N, K, lda, ldb; };

struct StaticOrder {
    int nM, nN, nwg, G, c, wgm;
    __host__ __device__ void init(int M, int N, int G_, int c_, int wgm_ = WGM) { nM = M / BM; nN = N / BM; nwg = nM * nN; G = G_; c = c_; wgm = wgm_; }
    __host__ __device__ bool next(int i, Unit& u) const {
        const long L = (long)i * G + c; if (L >= nwg) return false;
        int wgid = (int)L; { const int q = nwg / NXCD, r = nwg % NXCD, xcd = wgid % NXCD, off = wgid / NXCD; wgid = (xcd < r ? xcd * (q + 1) : r * (q + 1) + (xcd - r) * q) + off; }
        const int nig = wgm * nN, gid = wgid / nig, fm = gid * wgm, gsz = (nM - fm) < wgm ? (nM - fm) : wgm;
        u.pm = fm + ((wgid % nig) % gsz); u.pn = (wgid % nig) / gsz; return true;
    }
    __device__ __forceinline__ void a_ready(const Unit&) const {}
    __device__ __forceinline__ void done(const Unit&) const {}
};

template <class Epi, class Sched, bool ALIGN_EPI = false, bool SP2 = false>
__device__ __forceinline__ void gemm_phase(PG8_LAS unsigned char* lds, const Gemm g, const Sched& S, const Epi& E, int tid_in) {
    int tid_ = tid_in; asm volatile("" : "+v"(tid_));
    const int tid = tid_, wid = __builtin_amdgcn_readfirstlane(tid >> 6), lane = tid & 63, wr = wid >> 2, wc = wid & 3, fr = lane & 15, fq = lane >> 4;
    const int K = g.K, nt = K / BK;
    unsigned voffA[2], voffB[2];
#pragma unroll
    for (int i = 0; i < 2; ++i) { int R, C; stage_rc(tid * 16 + i * 8192, R, C); const int Rb = Epi::PERM ? ((R & ~31) + perm32(R & 31)) : R;
        voffA[i] = (unsigned)(R * g.lda + C) * 2u; voffB[i] = (unsigned)(Rb * g.ldb + C) * 2u; }
    const size_t kstep = (size_t)(BK * 2);
    const size_t hstepA = (size_t)HALF * g.lda * 2, hstepB = (size_t)HALF * g.ldb * 2;
    const size_t tstepA = 2 * hstepA, tstepB = 2 * hstepB;
    const unsigned ldsw = (unsigned)wid * 1024u;
    const int aoff = lds_byte(wr * 64 + fr, fq * 8), boff = lds_byte(wc * 32 + fr, fq * 8);
#define PG8_SA(b, h) (((b) * 2 + (h)) * HTB)
#define PG8_SB(b, h) ((4 + (b) * 2 + (h)) * HTB)
#define PG8_STAGE(bufoff, gbase, voff) do { _Pragma("unroll") for (int _i = 0; _i < 2; ++_i) \
        __builtin_amdgcn_global_load_lds((const unsigned*)((const char*)(gbase) + (voff)[_i]), (PG8_LAS unsigned*)(lds + (bufoff) + ldsw + _i * 8192), 16, 0, 0); } while (0)
#define PG8_LDA(dst, b, h) do { _Pragma("unroll") for (int m = 0; m < 4; ++m) _Pragma("unroll") for (int k = 0; k < 2; ++k) dst[m][k] = *(const PG8_LAS bf16x8*)(lds + PG8_SA(b, h) + aoff + m * 2048 + k * 1024); } while (0)
#define PG8_LDB(dst, b, h) do { _Pragma("unroll") for (int n = 0; n < 2; ++n) _Pragma("unroll") for (int k = 0; k < 2; ++k) dst[n][k] = *(const PG8_LAS bf16x8*)(lds + PG8_SB(b, h) + boff + n * 2048 + k * 1024); } while (0)
#define PG8_MMA(ai, bj, At, Bt) do { __builtin_amdgcn_s_setprio(1); _Pragma("unroll") for (int m = 0; m < 4; ++m) _Pragma("unroll") for (int n = 0; n < 2; ++n) _Pragma("unroll") for (int k = 0; k < 2; ++k) \
        acc[ai][bj][m][n] = __builtin_amdgcn_mfma_f32_16x16x32_bf16(Bt[n][k], At[m][k], acc[ai][bj][m][n], 0, 0, 0); __builtin_amdgcn_s_setprio(0); } while (0)
#define PG8_WAIT_V(n) asm volatile("s_waitcnt vmcnt(" #n ")" ::: "memory")
#define PG8_WAIT_L(n) asm volatile("s_waitcnt lgkmcnt(" #n ")" ::: "memory")
#define PG8_BAR __builtin_amdgcn_s_barrier()
#define PG8_SCHED __builtin_amdgcn_sched_barrier(0)
    Unit cur, nxt; int ui = 0;
    if (!S.next(0, cur)) return;
    f32x4 acc[2][2][4][2];
#pragma unroll
    for (int a = 0; a < 2; ++a)
#pragma unroll
        for (int b = 0; b < 2; ++b)
#pragma unroll
            for (int m = 0; m < 4; ++m)
#pragma unroll
                for (int n = 0; n < 2; ++n) acc[a][b][m][n] = (f32x4){0.f, 0.f, 0.f, 0.f};
    bf16x8 At[4][2], B0[2][2], B1[2][2];
    const char* cA = (const char*)g.A + (size_t)cur.pm * tstepA; const char* cB = (const char*)g.Bt + (size_t)cur.pn * tstepB;
#define PG8_KT(x) ((Epi::KROT != 0 ? (size_t)(((x) + Epi::KROT) & (nt - 1)) : (size_t)(x)) * kstep)
    S.a_ready(cur);
    E.first(cur, lds, tid);
    if constexpr (SP2) {
        PG8_STAGE(PG8_SB(0, 0), cB + PG8_KT(0), voffB); PG8_STAGE(PG8_SB(0, 1), cB + hstepB + PG8_KT(0), voffB); PG8_STAGE(PG8_SA(0, 0), cA + PG8_KT(0), voffA); PG8_STAGE(PG8_SA(0, 1), cA + hstepA + PG8_KT(0), voffA);
        if (wr == 1) PG8_BAR;
        PG8_WAIT_V(2); PG8_BAR;
        PG8_STAGE(PG8_SB(1, 0), cB + PG8_KT(1), voffB); PG8_STAGE(PG8_SA(1, 0), cA + PG8_KT(1), voffA); PG8_STAGE(PG8_SB(1, 1), cB + hstepB + PG8_KT(1), voffB);
        PG8_WAIT_V(6); PG8_BAR;
    } else {
        PG8_STAGE(PG8_SB(0, 0), cB + PG8_KT(0), voffB); PG8_STAGE(PG8_SA(0, 0), cA + PG8_KT(0), voffA); PG8_STAGE(PG8_SB(0, 1), cB + hstepB + PG8_KT(0), voffB); PG8_STAGE(PG8_SA(0, 1), cA + hstepA + PG8_KT(0), voffA);
        if (wr == 1) PG8_BAR;
        PG8_WAIT_V(4); PG8_BAR;
        PG8_STAGE(PG8_SB(1, 0), cB + PG8_KT(1), voffB); PG8_STAGE(PG8_SA(1, 0), cA + PG8_KT(1), voffA); PG8_STAGE(PG8_SB(1, 1), cB + hstepB + PG8_KT(1), voffB);
        PG8_WAIT_V(6); PG8_BAR;
    }
    for (;;) {
        const bool has_next = S.next(ui + 1, nxt);
        const char* nA = has_next ? (const char*)g.A + (size_t)nxt.pm * tstepA : cA; const char* nB = has_next ? (const char*)g.Bt + (size_t)nxt.pn * tstepB : cB;
        for (int t = 0; t < nt; t += 2) {
            const bool last = (t == nt - 2);
            const char* a1 = cA + PG8_KT(t + 1);
            const char* a2 = last ? nA + PG8_KT(0) : cA + PG8_KT(t + 2); const char* b2 = last ? nB + PG8_KT(0) : cB + PG8_KT(t + 2);
            const char* a3 = Epi::KROT != 0 ? (last ? nA + PG8_KT(1) : cA + PG8_KT(t + 3)) : a2 + kstep; const char* b3 = Epi::KROT != 0 ? (last ? nB + PG8_KT(1) : cB + PG8_KT(t + 3)) : b2 + kstep;
            if constexpr (Epi::KROT != 0) { if (t == Epi::HOOK0 || t == Epi::HOOK1) E.khook(acc, t, wr, fr, ui, lds); }
            if (last && has_next) S.a_ready(nxt);
            if constexpr (SP2) {
            PG8_LDB(B0, 0, 0); PG8_LDB(B1, 0, 1); PG8_SCHED; PG8_LDA(At, 0, 0); PG8_STAGE(PG8_SA(1, 1), a1 + hstepA, voffA);
            PG8_WAIT_V(8); PG8_WAIT_L(0); PG8_BAR; PG8_MMA(0, 0, At, B0); PG8_MMA(0, 1, At, B1); PG8_BAR; PG8_SCHED;
            PG8_LDA(At, 0, 1); PG8_STAGE(PG8_SB(0, 0), b2, voffB); PG8_STAGE(PG8_SB(0, 1), b2 + hstepB, voffB); PG8_STAGE(PG8_SA(0, 0), a2, voffA);
            PG8_WAIT_V(8); PG8_WAIT_L(0); PG8_BAR; PG8_MMA(1, 0, At, B0); PG8_MMA(1, 1, At, B1); PG8_BAR; PG8_SCHED;
            PG8_LDB(B0, 1, 0); PG8_LDB(B1, 1, 1); PG8_SCHED; PG8_LDA(At, 1, 0); PG8_STAGE(PG8_SA(0, 1), a2 + hstepA, voffA);
            PG8_WAIT_V(8); PG8_WAIT_L(0); PG8_BAR; PG8_MMA(0, 0, At, B0); PG8_MMA(0, 1, At, B1); PG8_BAR; PG8_SCHED;
            PG8_LDA(At, 1, 1); PG8_STAGE(PG8_SB(1, 0), b3, voffB); PG8_STAGE(PG8_SB(1, 1), b3 + hstepB, voffB); PG8_STAGE(PG8_SA(1, 0), a3, voffA);
            PG8_WAIT_V(8); PG8_WAIT_L(0); PG8_BAR; PG8_MMA(1, 0, At, B0); PG8_MMA(1, 1, At, B1); PG8_BAR; PG8_SCHED;
            } else {
            PG8_LDB(B0, 0, 0); PG8_SCHED; PG8_LDA(At, 0, 0); PG8_STAGE(PG8_SA(1, 1), a1 + hstepA, voffA);
            PG8_WAIT_L(8); PG8_BAR; PG8_WAIT_L(0); PG8_MMA(0, 0, At, B0); PG8_BAR; PG8_SCHED;
            PG8_LDB(B1, 0, 1); PG8_STAGE(PG8_SB(0, 0), b2, voffB);
            PG8_BAR; PG8_WAIT_L(0); PG8_MMA(0, 1, At, B1); PG8_BAR;
            PG8_LDA(At, 0, 1); PG8_STAGE(PG8_SA(0, 0), a2, voffA);
            PG8_BAR; PG8_WAIT_L(0); PG8_MMA(1, 0, At, B0); PG8_BAR; PG8_SCHED;
            PG8_STAGE(PG8_SB(0, 1), b2 + hstepB, voffB);
            PG8_WAIT_V(6); PG8_BAR; PG8_MMA(1, 1, At, B1); PG8_BAR;
            PG8_LDB(B0, 1, 0); PG8_SCHED; PG8_LDA(At, 1, 0); PG8_STAGE(PG8_SA(0, 1), a2 + hstepA, voffA);
            PG8_WAIT_L(8); PG8_BAR; PG8_WAIT_L(0); PG8_MMA(0, 0, At, B0); PG8_BAR; PG8_SCHED;
            PG8_LDB(B1, 1, 1); PG8_STAGE(PG8_SB(1, 0), b3, voffB);
            PG8_BAR; PG8_WAIT_L(0); PG8_MMA(0, 1, At, B1); PG8_BAR;
            PG8_LDA(At, 1, 1); PG8_STAGE(PG8_SA(1, 0), a3, voffA);
            PG8_BAR; PG8_WAIT_L(0); PG8_MMA(1, 0, At, B0); PG8_BAR; PG8_SCHED;
            PG8_STAGE(PG8_SB(1, 1), b3 + hstepB, voffB);
            PG8_WAIT_V(6); PG8_BAR; PG8_MMA(1, 1, At, B1); PG8_BAR;
            }
        }
        if constexpr (ALIGN_EPI) { if (wr == 0) PG8_BAR; }
        if constexpr (!Epi::AFTER_DRAIN) { E(acc, cur, wr, wc, fr, fq, ui, has_next, nxt, lds, tid); S.done(cur); }
        if (!has_next) break;
#pragma unroll
        for (int a = 0; a < 2; ++a)
#pragma unroll
            for (int b = 0; b < 2; ++b)
#pragma unroll
                for (int m = 0; m < 4; ++m)
#pragma unroll
                    for (int n = 0; n < 2; ++n) acc[a][b][m][n] = (f32x4){0.f, 0.f, 0.f, 0.f};
        cur = nxt; cA = nA; cB = nB; ++ui;
        if constexpr (ALIGN_EPI) { if (wr == 1) PG8_BAR; }
    }
    PG8_WAIT_V(0);
    if constexpr (!ALIGN_EPI) { if (wr == 0) PG8_BAR; }
    PG8_BAR;
    if constexpr (Epi::AFTER_DRAIN) { E.fused(acc, cur, wr, wc, fr, fq, lds, wid, lane); S.done(cur); }
#undef PG8_KT
#undef PG8_SA
#undef PG8_SB
#undef PG8_STAGE
#undef PG8_LDA
#undef PG8_LDB
#undef PG8_MMA
#undef PG8_WAIT_V
#undef PG8_WAIT_L
#undef PG8_BAR
#undef PG8_SCHED
}
}

constexpr int NWAVES = 8;
#ifndef WGM_UP
#define WGM_UP 8
#endif
#ifndef WGM_DN
#define WGM_DN 4
#endif
#ifndef WGM_IN
#define WGM_IN 4
#endif
#ifndef MK_PER_PHASE
#define MK_PER_PHASE 0
#endif
constexpr int DM = 2048, FF = 5632, NL = 4, MTOK = 32768, MPROMPT = 16384, TP = 2048, TS = 4096;
constexpr int INC = 5120, NAW = 512, HGW = 512, S5W = 1024;
constexpr float EPS = 1e-6f;
constexpr int PH_PER_LAYER = 14, N_PHASES = NL * PH_PER_LAYER;

constexpr size_t MiB = 1u << 20;
constexpr size_t WS_CTL = 1477 * MiB, CTL_ZERO_BYTES = 1 * MiB;
constexpr size_t WS_TAB = 1 * MiB;
constexpr size_t WS_WGU1 = 2 * MiB, WS_WD1 = 46 * MiB, WS_WIN = 68 * MiB, WS_WGLU = 88 * MiB, WS_WOUT = 90 * MiB, WS_WGU2 = 98 * MiB, WS_WD2 = 142 * MiB;
constexpr size_t WS_XB = 164 * MiB;
constexpr size_t WS_H = 292 * MiB;
constexpr size_t WS_Q = 292 * MiB, WS_K = 324 * MiB, WS_V = 356 * MiB, WS_QH = 388 * MiB, WS_VH = 420 * MiB, WS_GH = 452 * MiB, WS_LFF = 484 * MiB, WS_LFB = 548 * MiB;
constexpr size_t WS_UX = 644 * MiB;
constexpr size_t WS_CAT = 772 * MiB;
constexpr size_t WS_YPRE = 900 * MiB, WS_Y2 = 964 * MiB;
constexpr size_t WS_O = 1028 * MiB;
constexpr size_t WS_OF = 1060 * MiB, WS_OB = 1124 * MiB;
constexpr size_t WS_YF = 1188 * MiB;
constexpr size_t WS_S5E = 1316 * MiB, WS_S5Y = 1324 * MiB;
constexpr size_t WS_E = WS_YF;
constexpr size_t WS_LT = WS_OF;
constexpr size_t WS_SIN = 1340 * MiB;
constexpr size_t WS_HD = 1468 * MiB;
constexpr size_t WS_SS = 1470 * MiB, SS_BYTES = 7 * MiB;
constexpr size_t WS_END = 1478 * MiB;
constexpr int CW_TMO = 0, CW_CODE = 1, CW_BAR = 4096;

constexpr int RING_OFF = 0, RING_BYTES = 131072;
constexpr int LDSCTL_OFF = RING_BYTES, MISC_OFF = LDSCTL_OFF + 320;
constexpr int LDS_BYTES = 147456;

#define GAS __attribute__((address_space(1)))
#define LAS __attribute__((address_space(3)))
typedef unsigned short bf16;
typedef unsigned v4u __attribute__((ext_vector_type(4)));
typedef unsigned v2u __attribute__((ext_vector_type(2)));
typedef float f32x4 __attribute__((ext_vector_type(4)));
typedef short bf16x8 __attribute__((ext_vector_type(8)));
typedef GAS unsigned gu32;
#define RLX_AGENT __ATOMIC_RELAXED, __HIP_MEMORY_SCOPE_AGENT
#define LDS_WAIT() asm volatile("s_waitcnt lgkmcnt(0)" ::: "memory")
#define VM_WAIT() asm volatile("s_waitcnt vmcnt(0)" ::: "memory")
__device__ __forceinline__ unsigned f2bf(float f) { unsigned u = __builtin_bit_cast(unsigned, f); return (u + 0x7fffu + ((u >> 16) & 1u)) >> 16; }
typedef float f32x2_t __attribute__((ext_vector_type(2)));
typedef __bf16 bf16x2_t __attribute__((ext_vector_type(2)));
__device__ __forceinline__ unsigned pk2(float lo, float hi) { const f32x2_t v = {lo, hi}; const bf16x2_t b = __builtin_convertvector(v, bf16x2_t); return __builtin_bit_cast(unsigned, b); }
__device__ __forceinline__ float bflo(unsigned w) { return __builtin_bit_cast(float, w << 16); }
__device__ __forceinline__ float bfhi(unsigned w) { return __builtin_bit_cast(float, w & 0xffff0000u); }
__device__ __forceinline__ float bf2f(bf16 b) { return __builtin_bit_cast(float, ((unsigned)b) << 16); }
__device__ __forceinline__ float fast_rcp(float x) { return __builtin_amdgcn_rcpf(x); }
__device__ __forceinline__ float fast_rsq(float x) { return __builtin_amdgcn_rsqf(x); }
__device__ __forceinline__ void fast_sincos(float x, float& s, float& c) { float r = x * 0.15915494309189535f; r = r - floorf(r); s = __builtin_amdgcn_sinf(r); c = __builtin_amdgcn_cosf(r); }
__device__ __forceinline__ float sigmoidf_(float x) { return fast_rcp(1.0f + __expf(-x)); }
__device__ __forceinline__ float siluf_(float x) { return x * sigmoidf_(x); }
__device__ __forceinline__ float gelu_tanh(float x) {
    const float t = 1.5957691216057308f * (x + 0.044715f * x * x * x);
    return x * sigmoidf_(t);
}
template <int MASK> __device__ __forceinline__ float xshfl(float v, int lane) {
    if (MASK < 32) return __builtin_bit_cast(float, __builtin_amdgcn_ds_swizzle(__builtin_bit_cast(int, v), (MASK << 10) | 0x1f));
    else return __builtin_bit_cast(float, __builtin_amdgcn_ds_bpermute((lane ^ 32) << 2, __builtin_bit_cast(int, v)));
}
__device__ __forceinline__ float lane_bcast(float v, int src) { return __builtin_bit_cast(float, __builtin_amdgcn_ds_bpermute(src << 2, __builtin_bit_cast(int, v))); }
__device__ __forceinline__ float wave_sum(float v, int lane) {
    v += xshfl<1>(v, lane); v += xshfl<2>(v, lane); v += xshfl<4>(v, lane); v += xshfl<8>(v, lane); v += xshfl<16>(v, lane); v += xshfl<32>(v, lane); return v;
}
__device__ __forceinline__ float wave_max(float v, int lane) {
    v = fmaxf(v, xshfl<1>(v, lane)); v = fmaxf(v, xshfl<2>(v, lane)); v = fmaxf(v, xshfl<4>(v, lane)); v = fmaxf(v, xshfl<8>(v, lane)); v = fmaxf(v, xshfl<16>(v, lane)); v = fmaxf(v, xshfl<32>(v, lane)); return v;
}
typedef unsigned long long u64;
__device__ __forceinline__ u64 ss_fix(float s) { return (u64)(s * 1048576.0f + 0.5f); }
__device__ __forceinline__ float ss_val(u64 v) { return (float)v * (1.0f / 1048576.0f); }
constexpr int ROWSC_OFF = RING_BYTES + 1024;
constexpr int NA_BIAS_OFF = RING_BYTES + 4096;
struct RowScale {
    const u64* ssa; const u64* ssb; bool useb;
    __device__ __forceinline__ float conv(u64 a, u64 b2) const { const float rs = fast_rsq(ss_val(a) * (1.0f / DM) + EPS); const float r2 = fast_rsq(rs * rs * ss_val(b2) * (1.0f / DM) + EPS); return useb ? rs * r2 : rs; }
    __device__ __forceinline__ void issue(int pm, int tid, u64& a, u64& b2) const { a = ssa[pm * 256 + (tid & 255)]; b2 = ssb[pm * 256 + (tid & 255)]; }
    __device__ __forceinline__ void commit(LAS unsigned char* lds, int slot, int tid, u64 a, u64 b2) const { ((LAS float*)(lds + ROWSC_OFF))[slot * 256 + (tid & 255)] = conv(a, b2); }
    __device__ __forceinline__ float get(LAS unsigned char* lds, int slot, int idx) const { return ((LAS float*)(lds + ROWSC_OFF))[slot * 256 + idx]; }
};
#define XB_TMO      128
#define XB_XCNT(j)  (256  + 64 * (j))
#define XB_XSUB(j)  (1280 + 64 * (j))
#define XB_XGEN(j)  (2304 + 64 * (j))
#define XB_TOP      3328
#define XB_TOPGEN   3392
#define XCD_BAR_WORDS 3456
#define XB_SPIN_CAP (1u << 18)

__device__ __forceinline__ unsigned xb_ld(unsigned* p)              { return __hip_atomic_load(p, __ATOMIC_RELAXED, __HIP_MEMORY_SCOPE_AGENT); }
__device__ __forceinline__ unsigned xb_add(unsigned* p, unsigned v) { return __hip_atomic_fetch_add(p, v, __ATOMIC_RELAXED, __HIP_MEMORY_SCOPE_AGENT); }
__device__ __forceinline__ unsigned xb_xcc_id() { return (unsigned)__builtin_amdgcn_s_getreg((3 << 11) | 20) & 0xFu; }
#define XB_SPIN(cond, bar) do { unsigned _sp = 0; while (cond) { __builtin_amdgcn_s_sleep(1); \
    if ((++_sp & 255u) == 0u) { if (xb_ld(&(bar)[XB_TMO])) break; if (_sp > XB_SPIN_CAP) { atomicAdd(&(bar)[XB_TMO], 1u); break; } } } } while (0)

struct XcdBarrier {
    unsigned* bar; unsigned x;
    volatile LAS unsigned* st;
    bool t0;
};

__device__ __forceinline__ XcdBarrier xcd_barrier_post(unsigned* bar, volatile LAS unsigned* st) {
    XcdBarrier b; b.bar = bar; b.x = xb_xcc_id(); b.st = st; b.t0 = (threadIdx.x == 0);
    if (threadIdx.x == 0) (void)xb_add(&bar[XB_XCNT(b.x)], 1u);
    return b;
}
__device__ __forceinline__ void xcd_barrier_complete(unsigned* bar, unsigned x, unsigned& nloc, unsigned& nx) {
    const unsigned G = gridDim.x * gridDim.y * gridDim.z;
    unsigned sum, cnt, mine, sp = 0u;
    for (;;) {
        sum = 0u; cnt = 0u; mine = 0u;
#pragma unroll
        for (unsigned j = 0; j < 16; ++j) { const unsigned c = xb_ld(&bar[XB_XCNT(j)]); sum += c; cnt += (c > 0u) ? 1u : 0u; mine = (j == x) ? c : mine; }
        if (sum == G) break;
        __builtin_amdgcn_s_sleep(1);
        if ((++sp & 255u) == 0u) { if (xb_ld(&bar[XB_TMO])) break; if (sp > XB_SPIN_CAP) { atomicAdd(&bar[XB_TMO], 1u); break; } }
    }
    nloc = mine > 0u ? mine : 1u; nx = cnt > 0u ? cnt : 1u;
}

__device__ __forceinline__ void xcd_barrier(const XcdBarrier& b) {
    asm volatile("s_waitcnt vmcnt(0)" ::: "memory");
    __syncthreads();
    if (b.t0) {
        unsigned* bar = b.bar;
        __builtin_amdgcn_s_waitcnt(0);
        unsigned nloc = b.st[0], nx = b.st[1];
        if (nloc == 0u) { xcd_barrier_complete(bar, b.x, nloc, nx); b.st[0] = nloc; b.st[1] = nx; }
        const unsigned old = xb_add(&bar[XB_XSUB(b.x)], 1u);
        const unsigned gen = old / nloc;
        if (old + 1u == (gen + 1u) * nloc) {
            __builtin_amdgcn_fence(__ATOMIC_RELEASE, "agent");
            asm volatile("s_waitcnt vmcnt(0)" ::: "memory");
            const unsigned og = xb_add(&bar[XB_TOP], 1u);
            const unsigned tg = og / nx;
            if (og + 1u == (tg + 1u) * nx) xb_add(&bar[XB_TOPGEN], 1u);
            else XB_SPIN(xb_ld(&bar[XB_TOPGEN]) == tg, bar);
            __builtin_amdgcn_fence(__ATOMIC_ACQUIRE, "agent");
            xb_add(&bar[XB_XGEN(b.x)], 1u);
            asm volatile("s_waitcnt vmcnt(0)" ::: "memory");
        } else {
            XB_SPIN(xb_ld(&bar[XB_XGEN(b.x)]) == gen, bar);
            __builtin_amdgcn_fence(__ATOMIC_ACQUIRE, "agent");
            asm volatile("s_waitcnt vmcnt(0)" ::: "memory");
        }
    }
    __syncthreads();
}

using pg8::Unit;
struct EpiSwiGLU {
    static constexpr bool PERM = true, AFTER_DRAIN = false; static constexpr int KROT = 0;
    __device__ __forceinline__ void first(const Unit& u, LAS unsigned char* lds, int tid) const { u64 a, b2; rsc.issue(u.pm, tid, a, b2); rsc.commit(lds, 0, tid, a, b2); }
    bf16* H; RowScale rsc;
    __device__ __forceinline__ void operator()(const f32x4 (&acc)[2][2][4][2], const Unit& u, int wr, int wc, int fr, int fq, int ui, bool has_next, const Unit& nxt, LAS unsigned char* lds, int tid) const {
        const int row0 = u.pm * 256 + wr * 64 + fr, col0 = u.pn * 128 + wc * 32 + 8 * fq;
        u64 na, nb; rsc.issue(has_next ? nxt.pm : u.pm, tid, na, nb);
#pragma unroll
        for (int ai = 0; ai < 2; ++ai)
#pragma unroll
            for (int m = 0; m < 4; ++m) {
                const int row = row0 + ai * 128 + m * 16;
                const float rs = rsc.get(lds, ui & 1, ai * 128 + wr * 64 + m * 16 + fr);
                bf16* rowp = H + (size_t)row * FF + col0;
                float h[8];
#pragma unroll
                for (int n = 0; n < 2; ++n)
#pragma unroll
                    for (int i = 0; i < 4; ++i) { const float g = acc[ai][0][m][n][i] * rs, uu = acc[ai][1][m][n][i] * rs; h[4 * n + i] = siluf_(g) * uu; }
                v4u w; w.x = pk2(h[0], h[1]); w.y = pk2(h[2], h[3]); w.z = pk2(h[4], h[5]); w.w = pk2(h[6], h[7]);
                *(v4u*)rowp = w;
            }
        rsc.commit(lds, (ui + 1) & 1, tid, na, nb);
    }
};
struct EpiResid {
    static constexpr bool PERM = true, AFTER_DRAIN = false; static constexpr int KROT = 0;
    __device__ __forceinline__ void first(const Unit&, LAS unsigned char*, int) const {}
    bf16* XB; float scale; const u64* pre_ss; bool has_pre; const float* pre_g; u64* ssa; u64* ssb; const float* gb;
    __device__ __forceinline__ void operator()(const f32x4 (&acc)[2][2][4][2], const Unit& u, int wr, int wc, int fr, int fq, int ui, bool has_next, const Unit& nxt, LAS unsigned char* lds, int tid) const {
        const int row0 = u.pm * 256 + wr * 64 + fr, col0 = u.pn * 256 + wc * 32 + 8 * fq;
        f32x4 pg[2][2], g2[2][2];
#pragma unroll
        for (int bj = 0; bj < 2; ++bj)
#pragma unroll
            for (int n = 0; n < 2; ++n) { pg[bj][n] = has_pre ? *(const f32x4*)(pre_g + col0 + bj * 128 + n * 4) : (f32x4){1.f, 1.f, 1.f, 1.f};
                if (ssb) { const f32x4 t = *(const f32x4*)(gb + col0 + bj * 128 + n * 4); g2[bj][n] = t * t; } else g2[bj][n] = (f32x4){0.f, 0.f, 0.f, 0.f}; }
#pragma unroll
        for (int ai = 0; ai < 2; ++ai) {
            v4u xw[4][2]; u64 ps[4];
#pragma unroll
            for (int m = 0; m < 4; ++m) { const int row = row0 + ai * 128 + m * 16; ps[m] = pre_ss[row];
#pragma unroll
                for (int bj = 0; bj < 2; ++bj) xw[m][bj] = *(const v4u*)(XB + (size_t)row * DM + col0 + bj * 128); }
#pragma unroll
            for (int m = 0; m < 4; ++m) {
                const int row = row0 + ai * 128 + m * 16;
                const float r1 = has_pre ? fast_rsq(ss_val(ps[m]) * (1.0f / DM) + EPS) : 1.0f;
                float sa = 0.f, sb = 0.f;
#pragma unroll
                for (int bj = 0; bj < 2; ++bj) { const v4u w0 = xw[m][bj]; f32x4 xn[2];
                    const f32x4 xo[2] = {(f32x4){bflo(w0.x), bfhi(w0.x), bflo(w0.y), bfhi(w0.y)}, (f32x4){bflo(w0.z), bfhi(w0.z), bflo(w0.w), bfhi(w0.w)}};
#pragma unroll
                    for (int n = 0; n < 2; ++n) { xn[n] = xo[n] * (pg[bj][n] * r1) + acc[ai][bj][m][n] * scale;
                        const f32x4 sq = xn[n] * xn[n]; sa += (sq[0] + sq[1]) + (sq[2] + sq[3]);
                        if (ssb) { const f32x4 sg = sq * g2[bj][n]; sb += (sg[0] + sg[1]) + (sg[2] + sg[3]); } }
                    v4u w; w.x = pk2(xn[0][0], xn[0][1]); w.y = pk2(xn[0][2], xn[0][3]); w.z = pk2(xn[1][0], xn[1][1]); w.w = pk2(xn[1][2], xn[1][3]);
                    *(v4u*)(XB + (size_t)row * DM + col0 + bj * 128) = w; }
                sa += xshfl<16>(sa, 16 * fq + fr); sa += xshfl<32>(sa, 16 * fq + fr);
                if (ssb) { sb += xshfl<16>(sb, 16 * fq + fr); sb += xshfl<32>(sb, 16 * fq + fr); }
                if (fq == 0) { atomicAdd(ssa + row, ss_fix(sa)); if (ssb) atomicAdd(ssb + row, ss_fix(sb)); }
            }
        }
    }
};
struct EpiResidW {
    static constexpr bool PERM = true, AFTER_DRAIN = false; static constexpr int KROT = 16, HOOK0 = 16, HOOK1 = 24;
    bf16* XB; const u64* ssA; const u64* ssC; u64* ssa;
    typedef float f32x2w __attribute__((ext_vector_type(2)));
    __device__ __forceinline__ f32x2w conv(u64 a, u64 cc) const { const float ra = fast_rsq(ss_val(a) * (1.0f / 512.0f) + EPS), rc = fast_rsq(ss_val(cc) * (1.0f / 1024.0f) + EPS); return (f32x2w){ra, rc / ra}; }
    __device__ __forceinline__ void first(const Unit& u, LAS unsigned char* lds, int tid) const { const u64 a = ssA[u.pm * 256 + (tid & 255)], cc = ssC[u.pm * 256 + (tid & 255)]; ((LAS f32x2w*)(lds + ROWSC_OFF))[tid & 255] = conv(a, cc); }
    __device__ __forceinline__ void khook(f32x4 (&acc)[2][2][4][2], int t, int wr, int fr, int ui, LAS unsigned char* lds) const {
        const LAS f32x2w* sl = (const LAS f32x2w*)(lds + ROWSC_OFF) + (ui & 1) * 256;
#pragma unroll
        for (int ai = 0; ai < 2; ++ai)
#pragma unroll
            for (int m = 0; m < 4; ++m) { const f32x2w sc = sl[ai * 128 + wr * 64 + m * 16 + fr]; const float f = (t == HOOK0) ? sc.y : sc.x;
#pragma unroll
                for (int bj = 0; bj < 2; ++bj)
#pragma unroll
                    for (int n = 0; n < 2; ++n) acc[ai][bj][m][n] = acc[ai][bj][m][n] * f; }
    }
    __device__ __forceinline__ void operator()(const f32x4 (&acc)[2][2][4][2], const Unit& u, int wr, int wc, int fr, int fq, int ui, bool has_next, const Unit& nxt, LAS unsigned char* lds, int tid) const {
        const int row0 = u.pm * 256 + wr * 64 + fr, col0 = u.pn * 256 + wc * 32 + 8 * fq;
        const int pmn = has_next ? nxt.pm : u.pm; const u64 na = ssA[pmn * 256 + (tid & 255)], nc = ssC[pmn * 256 + (tid & 255)];
#pragma unroll
        for (int ai = 0; ai < 2; ++ai) {
            v4u xw[4][2];
#pragma unroll
            for (int m = 0; m < 4; ++m)
#pragma unroll
                for (int bj = 0; bj < 2; ++bj) xw[m][bj] = *(const v4u*)(XB + (size_t)(row0 + ai * 128 + m * 16) * DM + col0 + bj * 128);
#pragma unroll
            for (int m = 0; m < 4; ++m) {
                const int row = row0 + ai * 128 + m * 16; float sa = 0.f;
#pragma unroll
                for (int bj = 0; bj < 2; ++bj) { const v4u w0 = xw[m][bj]; f32x4 xn[2];
                    const f32x4 xo[2] = {(f32x4){bflo(w0.x), bfhi(w0.x), bflo(w0.y), bfhi(w0.y)}, (f32x4){bflo(w0.z), bfhi(w0.z), bflo(w0.w), bfhi(w0.w)}};
#pragma unroll
                    for (int n = 0; n < 2; ++n) { xn[n] = xo[n] + acc[ai][bj][m][n]; const f32x4 sq = xn[n] * xn[n]; sa += (sq[0] + sq[1]) + (sq[2] + sq[3]); }
                    v4u w; w.x = pk2(xn[0][0], xn[0][1]); w.y = pk2(xn[0][2], xn[0][3]); w.z = pk2(xn[1][0], xn[1][1]); w.w = pk2(xn[1][2], xn[1][3]);
                    *(v4u*)(XB + (size_t)row * DM + col0 + bj * 128) = w; }
                sa += xshfl<16>(sa, 16 * fq + fr); sa += xshfl<32>(sa, 16 * fq + fr);
                if (fq == 0) atomicAdd(ssa + row, ss_fix(sa));
            }
        }
        ((LAS f32x2w*)(lds + ROWSC_OFF))[((ui + 1) & 1) * 256 + (tid & 255)] = conv(na, nc);
    }
};
struct EpiWin {
    static constexpr bool PERM = true, AFTER_DRAIN = false; static constexpr int KROT = 0;
    __device__ __forceinline__ void first(const Unit& u, LAS unsigned char* lds, int tid) const { u64 a, b2; rsc.issue(u.pm, tid, a, b2); rsc.commit(lds, 0, tid, a, b2); }
    bf16 *Q, *K, *V, *QH, *VH, *GH, *LFF, *LFB; bf16* UX; const float *qn, *kn, *lb; RowScale rsc;
    __device__ __forceinline__ void operator()(const f32x4 (&acc_)[2][2][4][2], const Unit& u, int wr, int wc, int fr, int fq, int ui, bool has_next, const Unit& nxt, LAS unsigned char* lds, int tid) const {
        const int row0 = u.pm * 256 + wr * 64 + fr, pn = u.pn, seg = pn >> 1;
        u64 na, nb; rsc.issue(has_next ? nxt.pm : u.pm, tid, na, nb);
        f32x4 acc[2][2][4][2];
#pragma unroll
        for (int ai = 0; ai < 2; ++ai)
#pragma unroll
            for (int m = 0; m < 4; ++m) { const float rs = rsc.get(lds, ui & 1, ai * 128 + wr * 64 + m * 16 + fr);
#pragma unroll
                for (int bj = 0; bj < 2; ++bj)
#pragma unroll
                    for (int n = 0; n < 2; ++n) acc[ai][bj][m][n] = acc_[ai][bj][m][n] * rs; }
        const int cbase = (pn & 1) * 256 + 64 * wc + 8 * fq;
        if (seg <= 1) {
            const float* gn = seg == 0 ? qn : kn; bf16* dst = seg == 0 ? Q : K;
            float gv[2][8];
#pragma unroll
            for (int bj = 0; bj < 2; ++bj) { const f32x4 a = *(const f32x4*)(gn + 32 * bj + 8 * fq), b = *(const f32x4*)(gn + 32 * bj + 8 * fq + 4);
                gv[bj][0] = a[0]; gv[bj][1] = a[1]; gv[bj][2] = a[2]; gv[bj][3] = a[3]; gv[bj][4] = b[0]; gv[bj][5] = b[1]; gv[bj][6] = b[2]; gv[bj][7] = b[3]; }
#pragma unroll
            for (int ai = 0; ai < 2; ++ai)
#pragma unroll
                for (int m = 0; m < 4; ++m) {
                    float ss = 0.f;
#pragma unroll
                    for (int bj = 0; bj < 2; ++bj)
#pragma unroll
                        for (int n = 0; n < 2; ++n) { const f32x4 x = acc[ai][bj][m][n]; ss += (x[0] * x[0] + x[1] * x[1]) + (x[2] * x[2] + x[3] * x[3]); }
                    ss += xshfl<16>(ss, 16 * fq + fr); ss += xshfl<32>(ss, 16 * fq + fr);
                    const float rstd = fast_rsq(ss * (1.0f / 64.0f) + EPS);
                    bf16* rowp = dst + (size_t)(row0 + ai * 128 + m * 16) * 512 + cbase;
#pragma unroll
                    for (int bj = 0; bj < 2; ++bj) { const f32x4 x0 = acc[ai][bj][m][0] * rstd, x1 = acc[ai][bj][m][1] * rstd; v4u w;
                        w.x = pk2(x0[0] * gv[bj][0], x0[1] * gv[bj][1]); w.y = pk2(x0[2] * gv[bj][2], x0[3] * gv[bj][3]); w.z = pk2(x1[0] * gv[bj][4], x1[1] * gv[bj][5]); w.w = pk2(x1[2] * gv[bj][6], x1[3] * gv[bj][7]);
                        *(v4u*)(rowp + 32 * bj) = w; }
                }
        } else if (seg == 2 || seg == 3 || seg == 6 || seg == 7) {
            bf16* dst = seg == 2 ? V : (seg == 3 ? QH : (seg == 6 ? VH : GH)); const bool act = (seg == 3 || seg == 7);
#pragma unroll
            for (int ai = 0; ai < 2; ++ai)
#pragma unroll
                for (int m = 0; m < 4; ++m) {
                    bf16* rowp = dst + (size_t)(row0 + ai * 128 + m * 16) * 512 + cbase;
#pragma unroll
                    for (int bj = 0; bj < 2; ++bj) { f32x4 x0 = acc[ai][bj][m][0], x1 = acc[ai][bj][m][1];
                        if (act) {
#pragma unroll
                            for (int i = 0; i < 4; ++i) { x0[i] = siluf_(x0[i]); x1[i] = siluf_(x1[i]); } }
                        v4u w; w.x = pk2(x0[0], x0[1]); w.y = pk2(x0[2], x0[3]); w.z = pk2(x1[0], x1[1]); w.w = pk2(x1[2], x1[3]);
                        *(v4u*)(rowp + 32 * bj) = w; }
                }
        } else if (seg == 4 || seg == 5) {
            bf16* dst = seg == 4 ? LFF : LFB; const float* lbp = lb + (seg - 4) * 512 + cbase;
            f32x4 lbv[2][2];
#pragma unroll
            for (int bj = 0; bj < 2; ++bj) { lbv[bj][0] = *(const f32x4*)(lbp + 32 * bj); lbv[bj][1] = *(const f32x4*)(lbp + 32 * bj + 4); }
#pragma unroll
            for (int ai = 0; ai < 2; ++ai)
#pragma unroll
                for (int m = 0; m < 4; ++m) {
                    bf16* rowp = dst + (size_t)(row0 + ai * 128 + m * 16) * 512 + cbase;
#pragma unroll
                    for (int bj = 0; bj < 2; ++bj) { float o[8];
#pragma unroll
                        for (int n = 0; n < 2; ++n)
#pragma unroll
                            for (int i = 0; i < 4; ++i) { const float l = lbv[bj][n][i]; o[4 * n + i] = 0.69314718056f * __builtin_amdgcn_logf(l + (1.0f - l) * sigmoidf_(acc[ai][bj][m][n][i])); }
                        v4u w; w.x = pk2(o[0], o[1]); w.y = pk2(o[2], o[3]); w.z = pk2(o[4], o[5]); w.w = pk2(o[6], o[7]);
                        *(v4u*)(rowp + 32 * bj) = w; }
                }
        } else {
#pragma unroll
            for (int ai = 0; ai < 2; ++ai)
#pragma unroll
                for (int m = 0; m < 4; ++m) {
                    const int row = row0 + ai * 128 + m * 16;
#pragma unroll
                    for (int bj = 0; bj < 2; ++bj) { const int g = (pn - 16) * 16 + 4 * wc + 2 * bj + (fq >> 1);
                        bf16* p = UX + ((size_t)g * 2048 + (row >> 4)) * 512 + (row & 15) * 16 + 8 * (fq & 1);
                        const f32x4 x0 = acc[ai][bj][m][0], x1 = acc[ai][bj][m][1];
                        v4u w; w.x = pk2(x0[0], x0[1]); w.y = pk2(x0[2], x0[3]); w.z = pk2(x1[0], x1[1]); w.w = pk2(x1[2], x1[3]);
                        *(v4u*)p = w; }
                }
        }
        rsc.commit(lds, (ui + 1) & 1, tid, na, nb);
    }
};
struct EpiGLU {
    static constexpr bool PERM = true, AFTER_DRAIN = false; static constexpr int KROT = 0;
    __device__ __forceinline__ void first(const Unit&, LAS unsigned char*, int) const {}
    const bf16* YPRE; const float* bias; bf16* CATC; u64* ssc;
    __device__ __forceinline__ void operator()(const f32x4 (&acc)[2][2][4][2], const Unit& u, int wr, int wc, int fr, int fq, int ui, bool has_next, const Unit& nxt, LAS unsigned char* lds, int tid) const {
        const int row0 = u.pm * 256 + wr * 64 + fr, col0 = u.pn * 256 + wc * 32 + 8 * fq;
        f32x4 bv[2][2];
#pragma unroll
        for (int bj = 0; bj < 2; ++bj) { bv[bj][0] = *(const f32x4*)(bias + col0 + bj * 128); bv[bj][1] = *(const f32x4*)(bias + col0 + bj * 128 + 4); }
#pragma unroll
        for (int ai = 0; ai < 2; ++ai) {
            v4u ypv[4][2];
#pragma unroll
            for (int m = 0; m < 4; ++m)
#pragma unroll
                for (int bj = 0; bj < 2; ++bj) ypv[m][bj] = *(const v4u*)(YPRE + (size_t)(row0 + ai * 128 + m * 16) * S5W + col0 + bj * 128);
#pragma unroll
            for (int m = 0; m < 4; ++m) {
                const int row = row0 + ai * 128 + m * 16; const size_t off = (size_t)row * DM + col0; float ss = 0.f;
#pragma unroll
                for (int bj = 0; bj < 2; ++bj) { const v4u yp = ypv[m][bj];
                    const f32x4 z0 = acc[ai][bj][m][0] + bv[bj][0], z1 = acc[ai][bj][m][1] + bv[bj][1];
                    const float y[8] = {bflo(yp.x) * sigmoidf_(z0[0]), bfhi(yp.x) * sigmoidf_(z0[1]), bflo(yp.y) * sigmoidf_(z0[2]), bfhi(yp.y) * sigmoidf_(z0[3]),
                                        bflo(yp.z) * sigmoidf_(z1[0]), bfhi(yp.z) * sigmoidf_(z1[1]), bflo(yp.w) * sigmoidf_(z1[2]), bfhi(yp.w) * sigmoidf_(z1[3])};
#pragma unroll
                    for (int e = 0; e < 8; ++e) ss += y[e] * y[e];
                    v4u w; w.x = pk2(y[0], y[1]); w.y = pk2(y[2], y[3]); w.z = pk2(y[4], y[5]); w.w = pk2(y[6], y[7]);
                    *(v4u*)(CATC + off + bj * 128) = w; }
                ss += xshfl<16>(ss, 16 * fq + fr); ss += xshfl<32>(ss, 16 * fq + fr);
                if (fq == 0) atomicAdd(ssc + row, ss_fix(ss));
            }
        }
    }
};

struct S5Order {
    int G, c;
    __device__ __forceinline__ bool next(int i, Unit& u) const {
        int g, rt;
        if (G == 256) { if (i >= 2) return false; const int x = c & 7, s = c >> 3; g = 32 * i + x * 4 + (s >> 3); rt = s & 7; }
        else { const int id = i * G + c; if (id >= 512) return false; g = id >> 3; rt = id & 7; }
        u.pm = g * 8 + rt; u.pn = g; return true;
    }
    __device__ __forceinline__ void a_ready(const Unit&) const {}
    __device__ __forceinline__ void done(const Unit&) const {}
};
struct EpiS5E {
    static constexpr bool PERM = false, AFTER_DRAIN = false; static constexpr int KROT = 0;
    __device__ __forceinline__ void first(const Unit&, LAS unsigned char*, int) const {}
    bf16* E;
    __device__ __forceinline__ void operator()(const f32x4 (&acc)[2][2][4][2], const Unit& u, int wr, int wc, int fr, int fq, int ui, bool has_next, const Unit& nxt, LAS unsigned char* lds, int tid) const {
        const int row0 = u.pm * 256 + wr * 64 + fr, col0 = wc * 32 + 4 * fq;
#pragma unroll
        for (int ai = 0; ai < 2; ++ai)
#pragma unroll
            for (int m = 0; m < 4; ++m) { bf16* rowp = E + (size_t)(row0 + ai * 128 + m * 16) * 256 + col0;
#pragma unroll
                for (int bj = 0; bj < 2; ++bj)
#pragma unroll
                    for (int n = 0; n < 2; ++n) { const f32x4 x = acc[ai][bj][m][n]; v2u w; w.x = pk2(x[0], x[1]); w.y = pk2(x[2], x[3]); *(v2u*)(rowp + bj * 128 + n * 16) = w; } }
    }
};
struct EpiS5Y {
    static constexpr bool PERM = true, AFTER_DRAIN = false; static constexpr int KROT = 0;
    __device__ __forceinline__ void first(const Unit&, LAS unsigned char*, int) const {}
    bf16* YPRE;
    __device__ __forceinline__ void operator()(const f32x4 (&acc)[2][2][4][2], const Unit& u, int wr, int wc, int fr, int fq, int ui, bool has_next, const Unit& nxt, LAS unsigned char* lds, int tid) const {
        const int g = u.pn, chunk0 = (u.pm & 7) * 256 + wr * 64 + fr;
#pragma unroll
        for (int ai = 0; ai < 2; ++ai)
#pragma unroll
            for (int m = 0; m < 4; ++m) { const int chunk = chunk0 + ai * 128 + m * 16;
#pragma unroll
                for (int bj = 0; bj < 2; ++bj) { const int tok = chunk * 16 + 8 * bj + 2 * wc + (fq >> 1);
                    const f32x4 x0 = acc[ai][bj][m][0], x1 = acc[ai][bj][m][1];
                    v4u w; w.x = pk2(gelu_tanh(x0[0]), gelu_tanh(x0[1])); w.y = pk2(gelu_tanh(x0[2]), gelu_tanh(x0[3])); w.z = pk2(gelu_tanh(x1[0]), gelu_tanh(x1[1])); w.w = pk2(gelu_tanh(x1[2]), gelu_tanh(x1[3]));
                    *(v4u*)(YPRE + (size_t)tok * S5W + g * 16 + 8 * (fq & 1)) = w; } }
    }
};

struct Frame {
    LAS unsigned char* lds;
    volatile LAS unsigned* MISC;
    int tid, lane, wave, G, gw, NGW, bid, zi;
    unsigned char* ws; float* X;
};
struct Args { const float* in[33]; int ph_lo, ph_hi, li, pad; };
#define WSP(T, off) ((T*)(F.ws + (off)))
__device__ __forceinline__ int fresh_lane() { unsigned z = 0u; asm volatile("" : "+v"(z)); return (int)__builtin_amdgcn_mbcnt_hi(~0u, __builtin_amdgcn_mbcnt_lo(~0u, z)); }
template <class T> __device__ __forceinline__ T* opaque_ptr(T* p) {
    unsigned long long w = (unsigned long long)p; unsigned lo = (unsigned)w, hi = (unsigned)(w >> 32);
    asm volatile("" : "+v"(lo), "+v"(hi));
    lo = (unsigned)__builtin_amdgcn_readfirstlane((int)lo); hi = (unsigned)__builtin_amdgcn_readfirstlane((int)hi);
    return (T*)(((unsigned long long)hi << 32) | lo);
}
#define FA Frame& F, const Args& A
#define AIN(k) (A.in[(k) + F.zi])

__device__ __forceinline__ void conv_item(const float* W, int Nsrc, int K, int src_col0, bf16* WT, int dst_row0, int k0, LAS float* scr, int lane, const float* ga = nullptr, const float* gb = nullptr) {
    float wv[32];
#pragma unroll
    for (int i = 0; i < 32; ++i) { const int kk = 2 * i + (lane >> 5); wv[i] = __builtin_nontemporal_load(W + (size_t)(k0 + kk) * Nsrc + src_col0 + (lane & 31)); }
    const int c = lane & 7;
    f32x4 g0 = (f32x4){1.f, 1.f, 1.f, 1.f}, g1 = g0;
    if (ga) { g0 = *(const f32x4*)(ga + k0 + 8 * c); g1 = *(const f32x4*)(ga + k0 + 8 * c + 4); if (gb) { g0 = g0 * *(const f32x4*)(gb + k0 + 8 * c); g1 = g1 * *(const f32x4*)(gb + k0 + 8 * c + 4); } }
#pragma unroll
    for (int i = 0; i < 32; ++i) { const int kk = 2 * i + (lane >> 5); scr[kk * 33 + (lane & 31)] = wv[i]; }
    LDS_WAIT(); asm volatile("" ::: "memory");
#pragma unroll
    for (int j = 0; j < 4; ++j) { const int n = (lane >> 3) + 8 * j; const LAS float* s = scr + (8 * c) * 33 + n;
        v4u o; o.x = pk2(s[0 * 33] * g0[0], s[1 * 33] * g0[1]); o.y = pk2(s[2 * 33] * g0[2], s[3 * 33] * g0[3]); o.z = pk2(s[4 * 33] * g1[0], s[5 * 33] * g1[1]); o.w = pk2(s[6 * 33] * g1[2], s[7 * 33] * g1[3]);
        *(GAS v4u*)(WT + (size_t)(dst_row0 + n) * K + k0 + 8 * c) = o; }
    LDS_WAIT(); asm volatile("" ::: "memory");
}
__device__ __forceinline__ void conv_layer(FA, int l) {
    LAS float* scr = (LAS float*)(F.lds + RING_OFF + F.wave * 16384);
    constexpr int I_GU = 32 * 352, I_D = 88 * 64, I_IN = 32 * 160, I_GLU = 16 * 32, I_OUT = 32 * 64;
    constexpr int NITEMS = 2 * I_GU + 2 * I_D + I_IN + I_GLU + I_OUT;
    const size_t wff = (size_t)DM * FF;
    for (int it = F.gw; it < NITEMS; it += F.NGW) {
        int r = it;
        if (r < 2 * I_GU) { const int second = r >= I_GU; if (second) r -= I_GU;
            const int kb = r / 352, nbd = r % 352, tile = nbd >> 3, pb = nbd & 7, bj = pb >> 2, sub = pb & 3;
            const float* W = AIN(second ? (bj ? 28 : 27) : (bj ? 4 : 3)) + (size_t)l * wff;
            conv_item(W, FF, DM, 128 * tile + 32 * sub, WSP(bf16, second ? WS_WGU2 : WS_WGU1), 32 * nbd, 64 * kb, scr, F.lane, AIN(second ? 26 : 2) + l * DM, (!second && l > 0) ? AIN(30) + (l - 1) * DM : nullptr); continue; }
        r -= 2 * I_GU;
        if (r < 2 * I_D) { const int second = r >= I_D; if (second) r -= I_D;
            const int kb = r / 64, nbd = r % 64;
            conv_item(AIN(second ? 29 : 5) + (size_t)l * wff, DM, FF, 32 * nbd, WSP(bf16, second ? WS_WD2 : WS_WD1), 32 * nbd, 64 * kb, scr, F.lane); continue; }
        r -= 2 * I_D;
        if (r < I_IN) { const int kb = r / 160, nbd = r % 160, tile = nbd >> 3, pb = nbd & 7, bj = pb >> 2, wc = pb & 3;
            conv_item(AIN(7) + (size_t)l * DM * INC, INC, DM, 256 * tile + 32 * (2 * wc + bj), WSP(bf16, WS_WIN), 32 * nbd, 64 * kb, scr, F.lane, AIN(6) + l * DM); continue; }
        r -= I_IN;
        if (r < I_GLU) { const int kb = r / 32, nbd = r % 32;
            conv_item(AIN(22) + (size_t)l * S5W * S5W, S5W, S5W, 32 * nbd, WSP(bf16, WS_WGLU), 32 * nbd, 64 * kb, scr, F.lane); continue; }
        r -= I_GLU;
        { const int kb = r / 64, nbd = r % 64;
            const int k0 = 64 * kb;
            conv_item(AIN(25) + (size_t)l * DM * DM, DM, DM, 32 * nbd, WSP(bf16, WS_WOUT), 32 * nbd, k0, scr, F.lane, k0 < 512 ? AIN(11) + l * 512 : (k0 < 1024 ? nullptr : AIN(24) + l * 1024 - 1024)); }
    }
}
__device__ __forceinline__ void lb_table(FA) {
    float* LB = WSP(float, WS_TAB); const float* lg = AIN(12);
    for (int i = blockIdx.x * 512 + F.tid; i < 1024; i += F.G * 512) {
        float v[NL], mx = -1e30f;
#pragma unroll
        for (int l = 0; l < NL; ++l) { v[l] = lg[l * 1024 + i]; mx = fmaxf(mx, v[l]); }
        float s = 0.f;
#pragma unroll
        for (int l = 0; l < NL; ++l) { v[l] = expf(v[l] - mx); s += v[l]; }
        float c = 0.f;
#pragma unroll
        for (int l = 0; l < NL; ++l) { if (l > 0) c += v[l] / s; LB[l * 1024 + i] = c; }
    }
}
__device__ __forceinline__ const float* in_row(FA, int r) { return r < MPROMPT ? AIN(0) + (size_t)r * DM : AIN(1) + (size_t)(r - MPROMPT) * DM; }
__device__ __forceinline__ void prep_phase(FA) {
    bf16* XB = WSP(bf16, WS_XB); u64* SS0 = WSP(u64, WS_SS);
    for (int r = F.gw; r < MTOK; r += F.NGW) {
        const f32x4* xr = (const f32x4*)in_row(F, A, r) + F.lane; f32x4 v[8]; float s = 0.f;
#pragma unroll
        for (int j = 0; j < 8; ++j) { v[j] = __builtin_nontemporal_load(xr + 64 * j); s += (v[j][0] * v[j][0] + v[j][1] * v[j][1]) + (v[j][2] * v[j][2] + v[j][3] * v[j][3]); }
        s = wave_sum(s, F.lane); if (F.lane == 0) SS0[r] = ss_fix(s);
        v2u* o = (v2u*)(XB + (size_t)r * DM) + F.lane;
#pragma unroll
        for (int j = 0; j < 8; ++j) { v2u w; w.x = pk2(v[j][0], v[j][1]); w.y = pk2(v[j][2], v[j][3]); o[64 * j] = w; }
    }
}
__device__ __forceinline__ void out_norm_phase(FA, const u64* ss, const float* g) {
    const bf16* XB = WSP(bf16, WS_XB);
    for (int r = F.gw; r < MTOK; r += F.NGW) {
        f32x4* xr = (f32x4*)(F.X + (size_t)r * DM) + F.lane; const f32x4* gp = (const f32x4*)g + F.lane; const v2u* xb = (const v2u*)(XB + (size_t)r * DM) + F.lane;
        const float rstd = fast_rsq(ss_val(ss[r]) * (1.0f / DM) + EPS);
        v2u w[8];
#pragma unroll
        for (int j = 0; j < 8; ++j) w[j] = xb[64 * j];
#pragma unroll
        for (int j = 0; j < 8; ++j) __builtin_nontemporal_store((f32x4){bflo(w[j].x), bfhi(w[j].x), bflo(w[j].y), bfhi(w[j].y)} * rstd * gp[64 * j], xr + 64 * j);
    }
}
__device__ __forceinline__ void seq_of_row(int r, int& base, int& t, int& rows) {
    if (r < MPROMPT) { base = r & ~(TP - 1); t = r & (TP - 1); rows = TP / 64; } else { const int q = r - MPROMPT; base = MPROMPT + (q & ~(TS - 1)); t = q & (TS - 1); rows = TS / 64; }
}
__device__ __forceinline__ void seq_of_index(int s, int& base, int& T) { if (s < 8) { base = s * TP; T = TP; } else { base = MPROMPT + (s - 8) * TS; T = TS; } }

struct S5Par { float dre, ang, fre, fim; };
__device__ __forceinline__ S5Par s5_par(FA, int l, int dir, int g, int p) {
    const int pi = ((l * 2 + dir) * 64 + g) * 64 + p;
    const float are = AIN(14)[pi], aim = AIN(15)[pi], dt = expf(AIN(16)[(l * 2 + dir) * 64 + g]);
    const float mag = __expf(dt * are), ang = dt * aim; float sn_, cs_; fast_sincos(ang, sn_, cs_); const float abr = mag * cs_, abi = mag * sn_;
    const float den = are * are + aim * aim, nr = abr - 1.0f;
    S5Par r; r.dre = dt * are; r.ang = ang; r.fre = (nr * are + abi * aim) / den; r.fim = (abi * are - nr * aim) / den; return r;
}
__device__ __forceinline__ void s5_pow(const S5Par& q, float e, float& pr, float& pim) { const float m = __expf(e * q.dre); float s, c; fast_sincos(e * q.ang, s, c); pr = m * c; pim = m * s; }
__device__ __forceinline__ void s5_ops(FA, int l) {
    bf16* BE = WSP(bf16, WS_S5E); bf16* BY = WSP(bf16, WS_S5Y); const int lane = F.lane;
    for (int task = F.gw; task < 64 * 16 * 2; task += F.NGW) {
        const int chalf = task & 1, g = task >> 5, tau = (task >> 1) & 15; float kf[4] = {0.f, 0.f, 0.f, 0.f}, kb[4] = {0.f, 0.f, 0.f, 0.f};
#pragma unroll 1
        for (int dir = 0; dir < 2; ++dir) {
            const S5Par q = s5_par(F, A, l, dir, g, lane); float pr, pim; s5_pow(q, (float)tau, pr, pim);
            const size_t pi = (size_t)(((l * 2 + dir) * 64 + g) * 64 + lane);
            float wr_[16], wi_[16];
#pragma unroll
            for (int c = 0; c < 16; ++c) { const float br = AIN(17)[pi * 16 + c], bi = AIN(18)[pi * 16 + c]; const float bbr = q.fre * br - q.fim * bi, bbi = q.fre * bi + q.fim * br;
                wr_[c] = pr * bbr - pim * bbi; wi_[c] = pr * bbi + pim * bbr; }
#pragma unroll 1
            for (int c = 8 * chalf; c < 8 * chalf + 8; ++c) { const size_t ci = ((size_t)((l * 2 + dir) * 64 + g) * 16 + c) * 64 + lane; const float cr = AIN(19)[ci], cim = AIN(20)[ci];
#pragma unroll
                for (int cp = 0; cp < 16; ++cp) { const float v = wave_sum(cr * wr_[cp] - cim * wi_[cp], lane);
                    if (lane == c * 4 + (cp >> 2)) { if (dir == 0) kf[cp & 3] = v; else kb[cp & 3] = v; } } }
        }
        const int c = lane >> 2, cp0 = 4 * (lane & 3);
        if ((c >> 3) != chalf) continue;
        if (tau == 0) {
            float v[4];
#pragma unroll
            for (int j = 0; j < 4; ++j) v[j] = kf[j] + kb[j] + ((cp0 + j == c) ? AIN(21)[l * 1024 + g * 16 + c] : 0.f);
            for (int i = 0; i < 16; ++i) { v2u w; w.x = pk2(v[0], v[1]); w.y = pk2(v[2], v[3]); *(v2u*)(BY + ((size_t)g * 256 + i * 16 + c) * 512 + i * 16 + cp0) = w; }
        } else {
            v2u wf, wb; wf.x = pk2(kf[0], kf[1]); wf.y = pk2(kf[2], kf[3]); wb.x = pk2(kb[0], kb[1]); wb.y = pk2(kb[2], kb[3]);
            for (int s = 0; s + tau < 16; ++s) { const int i = s + tau;
                *(v2u*)(BY + ((size_t)g * 256 + i * 16 + c) * 512 + s * 16 + cp0) = wf;
                *(v2u*)(BY + ((size_t)g * 256 + s * 16 + c) * 512 + i * 16 + cp0) = wb; }
        }
    }
    const int gt = F.bid * 512 + F.tid, ngt = F.G * 512;
    for (int t = gt; t < 64 * 16 * 16 * 2 * 8; t += ngt) {
        const int po = t & 7, dir = (t >> 3) & 1, c = (t >> 4) & 15, i = (t >> 8) & 15, g = t >> 12; const float e = dir ? (float)(16 - i) : (float)(i + 1);
        float re[8], im[8];
#pragma unroll
        for (int j = 0; j < 8; ++j) { const int p = po * 8 + j; const S5Par q = s5_par(F, A, l, dir, g, p); float pr, pim; s5_pow(q, e, pr, pim);
            const size_t ci = ((size_t)((l * 2 + dir) * 64 + g) * 16 + c) * 64 + p; const float cr = AIN(19)[ci], cim = AIN(20)[ci];
            re[j] = cr * pr - cim * pim; im[j] = -(cr * pim + cim * pr); }
        bf16* row = BY + ((size_t)g * 256 + i * 16 + c) * 512 + 256 + dir * 128 + po * 8;
        v4u w; w.x = pk2(re[0], re[1]); w.y = pk2(re[2], re[3]); w.z = pk2(re[4], re[5]); w.w = pk2(re[6], re[7]); *(v4u*)row = w;
        w.x = pk2(im[0], im[1]); w.y = pk2(im[2], im[3]); w.z = pk2(im[4], im[5]); w.w = pk2(im[6], im[7]); *(v4u*)(row + 64) = w;
    }
    for (int t = gt; t < 64 * 2 * 64 * 16; t += ngt) {
        const int s = t & 15, p = (t >> 4) & 63, dir = (t >> 10) & 1, g = t >> 11; const float e = dir ? (float)s : (float)(15 - s);
        const S5Par q = s5_par(F, A, l, dir, g, p); float pr, pim; s5_pow(q, e, pr, pim);
        const size_t pi = (size_t)(((l * 2 + dir) * 64 + g) * 64 + p); float re[16], im[16];
#pragma unroll
        for (int c = 0; c < 16; ++c) { const float br = AIN(17)[pi * 16 + c], bi = AIN(18)[pi * 16 + c]; const float bbr = q.fre * br - q.fim * bi, bbi = q.fre * bi + q.fim * br;
            re[c] = pr * bbr - pim * bbi; im[c] = pr * bbi + pim * bbr; }
        bf16* rr = BE + ((size_t)g * 256 + dir * 128 + p) * 256 + s * 16; bf16* ri = rr + 64 * 256;
        v4u w; w.x = pk2(re[0], re[1]); w.y = pk2(re[2], re[3]); w.z = pk2(re[4], re[5]); w.w = pk2(re[6], re[7]); *(v4u*)rr = w;
        w.x = pk2(re[8], re[9]); w.y = pk2(re[10], re[11]); w.z = pk2(re[12], re[13]); w.w = pk2(re[14], re[15]); *(v4u*)(rr + 8) = w;
        w.x = pk2(im[0], im[1]); w.y = pk2(im[2], im[3]); w.z = pk2(im[4], im[5]); w.w = pk2(im[6], im[7]); *(v4u*)ri = w;
        w.x = pk2(im[8], im[9]); w.y = pk2(im[10], im[11]); w.z = pk2(im[12], im[13]); w.w = pk2(im[14], im[15]); *(v4u*)(ri + 8) = w;
    }
}
__device__ __forceinline__ void s5_carry(FA, int l, int w0, int nw) {
    const bf16* E = WSP(bf16, WS_E); bf16* UX = WSP(bf16, WS_UX); const int lane = F.lane;
    for (int task = w0; task < 12 * 64 * 2; task += nw) {
        const int dir = task & 1, g = (task >> 1) & 63, s = task >> 7; int base, T; seq_of_index(s, base, T);
        const int c0 = base >> 4, nch = T >> 4;
        const S5Par q = s5_par(F, A, l, dir, g, lane); float ar, ai; s5_pow(q, 16.0f, ar, ai);
        float xr = 0.f, xi = 0.f;
        float er[8], ei[8];
#pragma unroll
        for (int j = 0; j < 8; ++j) { const int n = dir ? nch - 1 - j : j; const bf16* ep = E + ((size_t)g * 2048 + c0 + n) * 256 + dir * 128 + lane; er[j] = bf2f(ep[0]); ei[j] = bf2f(ep[64]); }
        for (int n0 = 0; n0 < nch; n0 += 8) {
            float fr_[8], fi_[8];
            const int n1 = n0 + 8 < nch ? n0 + 8 : n0;
#pragma unroll
            for (int j = 0; j < 8; ++j) { const int n = dir ? nch - 1 - (n1 + j) : n1 + j; const bf16* ep = E + ((size_t)g * 2048 + c0 + n) * 256 + dir * 128 + lane; fr_[j] = bf2f(ep[0]); fi_[j] = bf2f(ep[64]); }
#pragma unroll
            for (int j = 0; j < 8; ++j) { const int n = dir ? nch - 1 - (n0 + j) : n0 + j; bf16* xp = UX + ((size_t)g * 2048 + c0 + n) * 512 + 256 + dir * 128 + lane;
                xp[0] = (bf16)f2bf(xr); xp[64] = (bf16)f2bf(xi);
                const float nr = ar * xr - ai * xi + er[j], ni = ar * xi + ai * xr + ei[j]; xr = nr; xi = ni; }
#pragma unroll
            for (int j = 0; j < 8; ++j) { er[j] = fr_[j]; ei[j] = fi_[j]; }
        }
    }
}
typedef short s16x4 __attribute__((ext_vector_type(4)));
__device__ __forceinline__ unsigned hoff(unsigned row, unsigned ch) { return 256u * row + 16u * (ch ^ (((row & 3u) << 2) | ((row >> 2) & 3u))); }
__device__ __forceinline__ s16x4 tr_read(const LAS unsigned char* p) { return __builtin_bit_cast(s16x4, __builtin_amdgcn_ds_read_tr16_b64_v4i16((LAS s16x4*)p)); }
__device__ __forceinline__ bf16x8 tr_frag(const LAS unsigned char* tile, int lane, int c, int rowbase0, int rowbase1) {
    const unsigned g = lane >> 4, q = (lane & 15) >> 2, p = lane & 3;
    const s16x4 a = tr_read(tile + hoff(rowbase0 + 4 * g + q, 2 * c + (p >> 1)) + 8 * (p & 1)), b = tr_read(tile + hoff(rowbase1 + 4 * g + q, 2 * c + (p >> 1)) + 8 * (p & 1));
    bf16x8 r; r[0] = a[0]; r[1] = a[1]; r[2] = a[2]; r[3] = a[3]; r[4] = b[0]; r[5] = b[1]; r[6] = b[2]; r[7] = b[3]; return r;
}
__device__ __forceinline__ void lds8(const LAS float* p, float (&v)[8]) { const f32x4 a = *(const LAS f32x4*)p, b = *(const LAS f32x4*)(p + 4); v[0] = a[0]; v[1] = a[1]; v[2] = a[2]; v[3] = a[3]; v[4] = b[0]; v[5] = b[1]; v[6] = b[2]; v[7] = b[3]; }
constexpr int HG_BST = 136;
constexpr int HG_BF_OFF = 0, HG_BB_OFF = 64 * HG_BST * 4, HG_V_OFF = 2 * 64 * HG_BST * 4, HG_Q_OFF = HG_V_OFF + 16384, HG_K2_OFF = HG_Q_OFF;
constexpr int HG_OST = 132;
static_assert(2 * 64 * HG_OST * 4 <= HG_V_OFF && HG_K2_OFF + 2 * 16384 <= RING_BYTES, "HGRN2 LDS map");
struct HgTiles { v4u lw[4]; v4u tv[2], tq[2]; };
__device__ __forceinline__ void hg_issue(Frame& F, HgTiles& T, const bf16* LFF, const bf16* LFB, const bf16* VH, const bf16* QH, int cu) {
    const int head = cu & 3, cg = cu >> 2;
    const unsigned lt = (unsigned)((F.tid >> 4) * 512 + 8 * (F.tid & 15));
#pragma unroll
    for (int i = 0; i < 2; ++i) { const size_t go = (size_t)(64 * cg + 32 * i) * 512 + head * 128;
        T.lw[i] = *(const v4u*)(LFF + go + lt); T.lw[2 + i] = *(const v4u*)(LFB + go + lt);
        T.tv[i] = *(const v4u*)(VH + go + lt); if (QH) T.tq[i] = *(const v4u*)(QH + go + lt); }
}
__device__ __forceinline__ void hg_commit_scan(Frame& F, const HgTiles& T, bool hasq) {
#pragma unroll
    for (int i = 0; i < 2; ++i) { const int idx = F.tid + 512 * i, p = idx >> 4, ch = idx & 15;
#pragma unroll
        for (int dir = 0; dir < 2; ++dir) { const v4u w = T.lw[2 * dir + i]; LAS float* bp = (LAS float*)(F.lds + (dir ? HG_BB_OFF : HG_BF_OFF)) + p * HG_BST + 8 * ch;
            *(LAS f32x4*)bp = (f32x4){bflo(w.x), bfhi(w.x), bflo(w.y), bfhi(w.y)}; *(LAS f32x4*)(bp + 4) = (f32x4){bflo(w.z), bfhi(w.z), bflo(w.w), bfhi(w.w)}; }
        *(LAS v4u*)(F.lds + HG_V_OFF + hoff(p, ch)) = T.tv[i]; if (hasq) *(LAS v4u*)(F.lds + HG_Q_OFF + hoff(p, ch)) = T.tq[i]; }
    __syncthreads();
    if (F.tid < 128) { LAS float* bt = (LAS float*)(F.lds + HG_BF_OFF) + F.tid; float a = 0.f;
#pragma unroll 1
        for (int j0 = 0; j0 < 64; j0 += 8) { float v[8];
#pragma unroll
            for (int k = 0; k < 8; ++k) v[k] = bt[(j0 + k) * HG_BST];
#pragma unroll
            for (int k = 0; k < 8; ++k) { a += v[k]; bt[(j0 + k) * HG_BST] = a; } } }
    else if (F.tid < 256) { LAS float* bt = (LAS float*)(F.lds + HG_BB_OFF) + (F.tid - 128); float a = 0.f;
#pragma unroll 1
        for (int j0 = 0; j0 < 64; j0 += 8) { float v[8];
#pragma unroll
            for (int k = 0; k < 8; ++k) v[k] = bt[(63 - j0 - k) * HG_BST];
#pragma unroll
            for (int k = 0; k < 8; ++k) { a += v[k]; bt[(63 - j0 - k) * HG_BST] = a; } } }
    __syncthreads();
}
__device__ __forceinline__ void hg_phase_a(FA) {
    const bf16* LFF = WSP(bf16, WS_LFF); const bf16* LFB = WSP(bf16, WS_LFB); const bf16* VH = WSP(bf16, WS_VH); bf16* LT = WSP(bf16, WS_LT); float* HD = WSP(float, WS_HD);
    const int lane = F.lane, w = F.wave, g = lane >> 4, wdir = w >> 2, wq = w & 3;
    HgTiles T; if (F.bid < 2048) hg_issue(F, T, LFF, LFB, VH, nullptr, F.bid);
    for (int cu = F.bid; cu < 2048; cu += F.G) {
        hg_commit_scan(F, T, false);
        if (cu + F.G < 2048) hg_issue(F, T, LFF, LFB, VH, nullptr, cu + F.G);
#pragma unroll
        for (int i = 0; i < 4; ++i) { const int idx = F.tid + 512 * i, dir = idx >> 10, p = (idx >> 4) & 63, ch = idx & 15;
            const LAS float* bt = (const LAS float*)(F.lds + (dir ? HG_BB_OFF : HG_BF_OFF)); const LAS float* bj = bt + p * HG_BST + 8 * ch; const LAS float* bl = bt + (dir ? 0 : 63) * HG_BST + 8 * ch;
            const bool edge = dir ? (p == 63) : (p == 0); const int pst = edge ? 0 : (dir ? HG_BST : -HG_BST);
            float kt[8], vb[8], vp[8], vl[8]; lds8(bj, vb); lds8(bj + pst, vp); lds8(bl, vl);
#pragma unroll
            for (int e = 0; e < 8; ++e) { const float bb = vb[e], bp = edge ? 0.f : vp[e]; kt[e] = (1.0f - __expf(bb - bp)) * __expf(vl[e] - bb); }
            v4u o; o.x = pk2(kt[0], kt[1]); o.y = pk2(kt[2], kt[3]); o.z = pk2(kt[4], kt[5]); o.w = pk2(kt[6], kt[7]);
            *(LAS v4u*)(F.lds + HG_K2_OFF + dir * 16384 + hoff(p, ch)) = o; }
        if (F.tid < 256) { const int dir = F.tid >> 7, d = F.tid & 127; HD[(size_t)((cu * 2) + dir) * 128 + d] = __expf(((const LAS float*)(F.lds + (dir ? HG_BB_OFF : HG_BF_OFF)))[(dir ? 0 : 63) * HG_BST + d]); }
        __syncthreads();
        f32x4 acc[2][8];
#pragma unroll
        for (int mb = 0; mb < 2; ++mb)
#pragma unroll
            for (int c = 0; c < 8; ++c) acc[mb][c] = (f32x4){0.f, 0.f, 0.f, 0.f};
#pragma unroll
        for (int ks = 0; ks < 2; ++ks) {
            bf16x8 a[2];
#pragma unroll
            for (int mb = 0; mb < 2; ++mb) a[mb] = tr_frag(F.lds + HG_K2_OFF + wdir * 16384, lane, 2 * wq + mb, 32 * ks, 32 * ks + 16);
#pragma unroll
            for (int c = 0; c < 8; ++c) { const bf16x8 bv = tr_frag(F.lds + HG_V_OFF, lane, c, 32 * ks, 32 * ks + 16);
#pragma unroll
                for (int mb = 0; mb < 2; ++mb) acc[mb][c] = __builtin_amdgcn_mfma_f32_16x16x32_bf16(a[mb], bv, acc[mb][c], 0, 0, 0); } }
        bf16* lt = LT + (size_t)(cu * 2 + wdir) * 16384;
#pragma unroll
        for (int mb = 0; mb < 2; ++mb)
#pragma unroll
            for (int c = 0; c < 8; ++c) { v2u o; o.x = pk2(acc[mb][c][0], acc[mb][c][1]); o.y = pk2(acc[mb][c][2], acc[mb][c][3]);
                { const int mbg = 2 * wq + mb, ksq = mbg >> 1, gp = 2 * (mbg & 1) + (g >> 1); *(v2u*)(lt + (size_t)((c * 4 + ksq) * 64 + gp * 16 + (lane & 15)) * 8 + 4 * (g & 1)) = o; } }
        __syncthreads();
    }
}
__device__ __forceinline__ void hg_phase_b(FA) {
    const bf16* LT = WSP(bf16, WS_LT); const float* HD = WSP(float, WS_HD); bf16* SIN = WSP(bf16, WS_SIN); const int lane = F.lane;
    for (int tk = F.gw; tk < 3072; tk += F.NGW) {
        int idx, smp; if (tk < 1024) { idx = tk; smp = 0; } else if (tk < 2048) { idx = tk - 1024; smp = 1; } else { idx = tk - 1024; smp = 0; }
        const int eg = idx & 31, dir = (idx >> 5) & 1, head = (idx >> 6) & 3, sq = idx >> 8;
        const int c0 = smp ? (MPROMPT / 64) + sq * (TS / 64) : sq * (TP / 64), nch = smp ? TS / 64 : TP / 64;
        const int e0 = eg * 512 + lane * 8, d0 = 32 * (eg & 3) + 8 * (lane >> 4);
        float S[8];
#pragma unroll
        for (int e = 0; e < 8; ++e) S[e] = 0.f;
        v4u l4[4]; f32x4 da[4], db[4];
#pragma unroll
        for (int i = 0; i < 4; ++i) { const int cg = c0 + (dir ? nch - 1 - i : i); const size_t u = (size_t)((cg * 4 + head) * 2 + dir);
            l4[i] = *(const v4u*)(LT + u * 16384 + e0); da[i] = *(const f32x4*)(HD + u * 128 + d0); db[i] = *(const f32x4*)(HD + u * 128 + d0 + 4); }
        for (int n0 = 0; n0 < nch; n0 += 4) {
            v4u m4[4]; f32x4 ea[4], eb[4]; const int n1 = n0 + 4 < nch ? n0 + 4 : n0;
#pragma unroll
            for (int i = 0; i < 4; ++i) { const int cg = c0 + (dir ? nch - 1 - (n1 + i) : n1 + i); const size_t u = (size_t)((cg * 4 + head) * 2 + dir);
                m4[i] = *(const v4u*)(LT + u * 16384 + e0); ea[i] = *(const f32x4*)(HD + u * 128 + d0); eb[i] = *(const f32x4*)(HD + u * 128 + d0 + 4); }
#pragma unroll
            for (int i = 0; i < 4; ++i) { const int cg = c0 + (dir ? nch - 1 - (n0 + i) : n0 + i); const size_t u = (size_t)((cg * 4 + head) * 2 + dir);
                v4u o; o.x = pk2(S[0], S[1]); o.y = pk2(S[2], S[3]); o.z = pk2(S[4], S[5]); o.w = pk2(S[6], S[7]); *(v4u*)(SIN + u * 16384 + e0) = o;
                S[0] = da[i][0] * S[0] + bflo(l4[i].x); S[1] = da[i][1] * S[1] + bfhi(l4[i].x); S[2] = da[i][2] * S[2] + bflo(l4[i].y); S[3] = da[i][3] * S[3] + bfhi(l4[i].y);
                S[4] = db[i][0] * S[4] + bflo(l4[i].z); S[5] = db[i][1] * S[5] + bfhi(l4[i].z); S[6] = db[i][2] * S[6] + bflo(l4[i].w); S[7] = db[i][3] * S[7] + bfhi(l4[i].w); }
#pragma unroll
            for (int i = 0; i < 4; ++i) { l4[i] = m4[i]; da[i] = ea[i]; db[i] = eb[i]; }
        }
    }
}
__device__ __forceinline__ void hg_phase_c(FA, const float* gnorm) {
    const bf16* LFF = WSP(bf16, WS_LFF); const bf16* LFB = WSP(bf16, WS_LFB); const bf16* VH = WSP(bf16, WS_VH); const bf16* QH = WSP(bf16, WS_QH); const bf16* SIN = WSP(bf16, WS_SIN);
    const bf16* GH = WSP(bf16, WS_GH); bf16* CAT = WSP(bf16, WS_CAT);
    const int lane = F.lane, w = F.wave, g = lane >> 4, tl = lane & 15, dir = w >> 2, PI = w & 3;
    const LAS float* bt = (const LAS float*)(F.lds + (dir ? HG_BB_OFF : HG_BF_OFF));
    const int pst = dir ? HG_BST : -HG_BST;
    const bool hasref = dir ? (PI < 3) : (PI > 0); const int refrow = hasref ? (dir ? 16 * PI + 16 : 16 * PI - 1) : 0;
    HgTiles T; if (F.bid < 2048) hg_issue(F, T, LFF, LFB, VH, QH, F.bid);
    for (int cu = F.bid; cu < 2048; cu += F.G) {
        const int head = cu & 3, cg = cu >> 2;
        const bf16* st = SIN + (size_t)(cu * 2 + dir) * 16384;
        bf16x8 sb[2][4];
#pragma unroll
        for (int c = 0; c < 2; ++c)
#pragma unroll
            for (int ks = 0; ks < 4; ++ks) sb[c][ks] = *(const bf16x8*)(st + (size_t)((c * 4 + ks) * 64 + lane) * 8);
        hg_commit_scan(F, T, true);
        const int p = 16 * PI + tl;
        bf16x8 qt[4], qh[4]; f32x4 acc[8];
#pragma unroll
        for (int c = 0; c < 8; ++c) acc[c] = (f32x4){0.f, 0.f, 0.f, 0.f};
#pragma unroll
        for (int ks = 0; ks < 4; ++ks) { const int d0 = 32 * ks + 8 * g; const LAS float* bj = bt + p * HG_BST + d0; const LAS float* br = bt + refrow * HG_BST + d0;
            const v4u q4 = *(const LAS v4u*)(F.lds + HG_Q_OFF + hoff(p, 4 * ks + g)); const float qv[8] = {bflo(q4.x), bfhi(q4.x), bflo(q4.y), bfhi(q4.y), bflo(q4.z), bfhi(q4.z), bflo(q4.w), bfhi(q4.w)};
            float a[8], h[8], vb[8], vr[8]; lds8(bj, vb); lds8(br, vr);
#pragma unroll
            for (int e = 0; e < 8; ++e) { const float bb = vb[e], rr = hasref ? vr[e] : 0.f; a[e] = qv[e] * __expf(bb); h[e] = qv[e] * __expf(bb - rr); }
            v4u o; o.x = pk2(a[0], a[1]); o.y = pk2(a[2], a[3]); o.z = pk2(a[4], a[5]); o.w = pk2(a[6], a[7]); qt[ks] = __builtin_bit_cast(bf16x8, o);
            o.x = pk2(h[0], h[1]); o.y = pk2(h[2], h[3]); o.z = pk2(h[4], h[5]); o.w = pk2(h[6], h[7]); qh[ks] = __builtin_bit_cast(bf16x8, o); }
#pragma unroll
        for (int cb = 0; cb < 4; ++cb) {
            bf16x8 sn[2][4];
            if (cb < 3) {
#pragma unroll
                for (int c = 0; c < 2; ++c)
#pragma unroll
                    for (int ks = 0; ks < 4; ++ks) sn[c][ks] = *(const bf16x8*)(st + (size_t)(((2 * cb + 2 + c) * 4 + ks) * 64 + lane) * 8); }
#pragma unroll
            for (int c = 0; c < 2; ++c)
#pragma unroll
                for (int ks = 0; ks < 4; ++ks) acc[2 * cb + c] = __builtin_amdgcn_mfma_f32_16x16x32_bf16(qt[ks], sb[c][ks], acc[2 * cb + c], 0, 0, 0);
            if (cb < 3) {
#pragma unroll
                for (int c = 0; c < 2; ++c)
#pragma unroll
                    for (int ks = 0; ks < 4; ++ks) sb[c][ks] = sn[c][ks]; }
        }
        if (cu + F.G < 2048) hg_issue(F, T, LFF, LFB, VH, QH, cu + F.G);
#pragma unroll 1
        for (int jp = 0; jp < 2; ++jp) {
            if (dir ? (2 * jp + 1 < PI) : (2 * jp > PI)) continue;
            f32x4 pt[2];
#pragma unroll
            for (int jj = 0; jj < 2; ++jj) { const int PJ = 2 * jp + jj; pt[jj] = (f32x4){0.f, 0.f, 0.f, 0.f};
                if (dir ? (PJ >= PI) : (PJ <= PI)) { const int s = 16 * PJ + tl; const bool edge = dir ? (s == 63) : (s == 0);
#pragma unroll
                    for (int ks = 0; ks < 4; ++ks) { const int d0 = 32 * ks + 8 * g; const LAS float* bs = bt + s * HG_BST + d0; const LAS float* br = bt + refrow * HG_BST + d0;
                        float kh[8], vb[8], vp[8], vr[8]; lds8(bs, vb); lds8(bs + (edge ? 0 : pst), vp); lds8(br, vr);
#pragma unroll
                        for (int e = 0; e < 8; ++e) { const float bb = vb[e], bp = edge ? 0.f : vp[e], rr = hasref ? vr[e] : 0.f; kh[e] = (1.0f - __expf(bb - bp)) * __expf(rr - bb); }
                        v4u o; o.x = pk2(kh[0], kh[1]); o.y = pk2(kh[2], kh[3]); o.z = pk2(kh[4], kh[5]); o.w = pk2(kh[6], kh[7]);
                        pt[jj] = __builtin_amdgcn_mfma_f32_16x16x32_bf16(__builtin_bit_cast(bf16x8, o), qh[ks], pt[jj], 0, 0, 0); }
                    if (PJ == PI) {
#pragma unroll
                        for (int r = 0; r < 4; ++r) if (dir ? (4 * g + r < tl) : (4 * g + r > tl)) pt[jj][r] = 0.f; }
                } }
            v4u pa; pa.x = pk2(pt[0][0], pt[0][1]); pa.y = pk2(pt[0][2], pt[0][3]); pa.z = pk2(pt[1][0], pt[1][1]); pa.w = pk2(pt[1][2], pt[1][3]);
#pragma unroll
            for (int cq = 0; cq < 2; ++cq) { bf16x8 bv[4];
#pragma unroll
                for (int c = 0; c < 4; ++c) bv[c] = tr_frag(F.lds + HG_V_OFF, lane, 4 * cq + c, 32 * jp, 32 * jp + 16);
#pragma unroll
                for (int c = 0; c < 4; ++c) acc[4 * cq + c] = __builtin_amdgcn_mfma_f32_16x16x32_bf16(__builtin_bit_cast(bf16x8, pa), bv[c], acc[4 * cq + c], 0, 0, 0); }
        }
        __syncthreads();
        const int fpos = 8 * w + (lane >> 3), fvc = lane & 7; const size_t ftok = (size_t)(64 * cg + fpos);
        v4u ghv[2]; f32x4 gnv[4];
#pragma unroll
        for (int hh = 0; hh < 2; ++hh) { ghv[hh] = *(const v4u*)(GH + ftok * 512 + head * 128 + 16 * fvc + 8 * hh); gnv[2 * hh] = *(const f32x4*)(gnorm + head * 128 + 16 * fvc + 8 * hh); gnv[2 * hh + 1] = *(const f32x4*)(gnorm + head * 128 + 16 * fvc + 8 * hh + 4); }
        { LAS float* ob = (LAS float*)F.lds + dir * 64 * HG_OST;
#pragma unroll
            for (int r = 0; r < 4; ++r)
#pragma unroll
                for (int c = 0; c < 8; ++c) ob[(16 * PI + 4 * g + r) * HG_OST + 16 * c + tl] = acc[c][r]; }
        __syncthreads();
        { const int pos = 8 * w + (lane >> 3), vc = lane & 7; const LAS float* o0 = (const LAS float*)F.lds + pos * HG_OST + 16 * vc; const LAS float* o1 = o0 + 64 * HG_OST;
            float x[16]; float ss = 0.f;
#pragma unroll
            for (int i = 0; i < 4; ++i) { const f32x4 a = *(const LAS f32x4*)(o0 + 4 * i), b2 = *(const LAS f32x4*)(o1 + 4 * i);
#pragma unroll
                for (int e = 0; e < 4; ++e) { const float v = a[e] + b2[e]; x[4 * i + e] = v; ss += v * v; } }
            ss += xshfl<1>(ss, lane); ss += xshfl<2>(ss, lane); ss += xshfl<4>(ss, lane);
            const float rstd = fast_rsq(ss * (1.0f / 128.0f) + EPS);
            bf16* op = CAT + ftok * DM + 512 + head * 128 + 16 * vc;
#pragma unroll
            for (int hh = 0; hh < 2; ++hh) { const v4u gh = ghv[hh]; const f32x4 g0 = gnv[2 * hh], g1 = gnv[2 * hh + 1]; const float* xx = x + 8 * hh;
                v4u o; o.x = pk2(xx[0] * rstd * g0[0] * bflo(gh.x), xx[1] * rstd * g0[1] * bfhi(gh.x)); o.y = pk2(xx[2] * rstd * g0[2] * bflo(gh.y), xx[3] * rstd * g0[3] * bfhi(gh.y));
                o.z = pk2(xx[4] * rstd * g1[0] * bflo(gh.z), xx[5] * rstd * g1[1] * bfhi(gh.z)); o.w = pk2(xx[6] * rstd * g1[2] * bflo(gh.w), xx[7] * rstd * g1[3] * bfhi(gh.w));
                *(v4u*)(op + 8 * hh) = o; } }
        __syncthreads();
    }
}

__device__ __forceinline__ void na_phase(FA, const float* relb, const float* qng, const float* kng, u64* ssA) {
    const bf16* Q = WSP(bf16, WS_Q); const bf16* K = WSP(bf16, WS_K); const bf16* V = WSP(bf16, WS_V); bf16* CAT = WSP(bf16, WS_CAT);
    const int lane = F.lane, w = F.wave, g = lane >> 4, tl = lane & 15, qb = w & 3, hh = w >> 2;
    const int kb_lo = qb >= 2 ? qb - 1 : 0, kb_hi = qb <= 1 ? qb + 1 : 3;
    LAS float* btab = (LAS float*)(F.lds + NA_BIAS_OFF); int hp_loaded = -1;
    float Bnd; { float mq = wave_max(fabsf(qng[lane]), lane), mk = wave_max(fabsf(kng[lane]), lane), mb = 0.f;
        for (int i = lane; i < 8 * 15 * 31; i += 64) mb = fmaxf(mb, fabsf(relb[i]));
        Bnd = 8.0f * mq * mk + wave_max(mb, lane); }
    constexpr int NA_V_OFF = RING_OFF, NA_K_OFF = RING_OFF + 65536;
    const unsigned vlt = (unsigned)((F.tid >> 4) * 512 + 8 * (F.tid & 15)), vlds = hoff(F.tid >> 4, F.tid & 15);
    const unsigned klt = (unsigned)(tl * 512 + 8 * g);
    v4u vv[8], kk[8];
#define NA_ISSUE(uu, ss) do { const int hp_ = (uu) & 3, R_ = (uu) >> 2; int Rb_, gr_, rows_; \
        if (R_ < MPROMPT / 64) { Rb_ = R_ & ~31; gr_ = R_ & 31; rows_ = 32; } else { Rb_ = 256 + ((R_ - 256) & ~63); gr_ = (R_ - 256) & 63; rows_ = 64; } \
        const size_t go_ = (size_t)((Rb_ + min(max(gr_ - 4, 0), rows_ - 8)) * 64 + 256 * (ss)) * 512 + hp_ * 128; \
        _Pragma("unroll") for (int i = 0; i < 8; ++i) { vv[i] = *(const v4u*)(V + go_ + (size_t)(32 * i) * 512 + vlt); kk[i] = *(const v4u*)(K + go_ + (size_t)(32 * i) * 512 + vlt); } } while (0)
    if (F.bid < 512 * 4) NA_ISSUE(F.bid, 0);
    for (int u = F.bid; u < 512 * 4; u += F.G) {
        const int hp = u & 3, R = u >> 2; int Rb, gr, rows;
        if (R < MPROMPT / 64) { Rb = R & ~31; gr = R & 31; rows = 32; } else { Rb = 256 + ((R - 256) & ~63); gr = (R - 256) & 63; rows = 64; }
        const int rs = min(max(gr - 4, 0), rows - 8), head = 2 * hp + hh;
        const int gc = 16 * qb + tl, cs = min(max(gc - 8, 0), 48), qrow = R * 64 + gc;
        bf16x8 qf[2];
#pragma unroll
        for (int ks = 0; ks < 2; ++ks) qf[ks] = *(const bf16x8*)(Q + (size_t)(R * 64 + 16 * qb) * 512 + head * 64 + 32 * ks + klt);
        if (hp != hp_loaded) { for (int i = F.tid; i < 2 * 15 * 31; i += 512) btab[i] = relb[hp * 2 * 15 * 31 + i] - Bnd; hp_loaded = hp; }
        f32x4 acc[4];
#pragma unroll
        for (int db = 0; db < 4; ++db) acc[db] = (f32x4){0.f, 0.f, 0.f, 0.f};
        float lrun = 0.f;
#pragma unroll 1
        for (int sg = 0; sg < 2; ++sg) {
#pragma unroll
            for (int i = 0; i < 8; ++i) { *(LAS v4u*)(F.lds + NA_V_OFF + vlds + 8192 * i) = vv[i]; *(LAS v4u*)(F.lds + NA_K_OFF + vlds + 8192 * i) = kk[i]; }
            __syncthreads();
            if (sg == 0) NA_ISSUE(u, 1); else if (u + F.G < 512 * 4) NA_ISSUE(u + F.G, 0);
#pragma unroll 1
            for (int al = 0; al < 4; ++al) {
                const int dr = rs + 4 * sg + al - gr; const LAS float* brow = btab + (hh * 15 + dr + 7) * 31 + 15 - gc;
                f32x4 st[4];
#pragma unroll
                for (int kb = 0; kb < 4; ++kb) { st[kb] = (f32x4){0.f, 0.f, 0.f, 0.f};
                    if (kb >= kb_lo && kb <= kb_hi) {
#pragma unroll
                        for (int ks = 0; ks < 2; ++ks) st[kb] = __builtin_amdgcn_mfma_f32_16x16x32_bf16(*(const LAS bf16x8*)(F.lds + NA_K_OFF + hoff(64 * al + 16 * kb + tl, 8 * hh + 4 * ks + g)), qf[ks], st[kb], 0, 0, 0); } }
#pragma unroll
                for (int kb = 0; kb < 4; ++kb) {
                    if (kb < kb_lo || kb > kb_hi) continue;
                    float bv[4], ev[4];
#pragma unroll
                    for (int r = 0; r < 4; ++r) { const int kc = 16 * kb + 4 * g + r; bv[r] = brow[min(max(kc, cs), cs + 15)]; }
#pragma unroll
                    for (int r = 0; r < 4; ++r) ev[r] = __expf(st[kb][r] * 0.125f + bv[r]);
#pragma unroll
                    for (int r = 0; r < 4; ++r) { const int kc = 16 * kb + 4 * g + r; const float p = (kc >= cs && kc < cs + 16) ? ev[r] : 0.f; st[kb][r] = p; lrun += p; } }
#pragma unroll
                for (int kp2 = 0; kp2 < 2; ++kp2) {
                    if (2 * kp2 + 1 < kb_lo || 2 * kp2 > kb_hi) continue;
                    v4u pb; pb.x = pk2(st[2 * kp2][0], st[2 * kp2][1]); pb.y = pk2(st[2 * kp2][2], st[2 * kp2][3]); pb.z = pk2(st[2 * kp2 + 1][0], st[2 * kp2 + 1][1]); pb.w = pk2(st[2 * kp2 + 1][2], st[2 * kp2 + 1][3]);
                    bf16x8 va[4];
#pragma unroll
                    for (int db = 0; db < 4; ++db) va[db] = tr_frag(F.lds + NA_V_OFF, lane, 4 * hh + db, 64 * al + 32 * kp2, 64 * al + 32 * kp2 + 16);
#pragma unroll
                    for (int db = 0; db < 4; ++db) acc[db] = __builtin_amdgcn_mfma_f32_16x16x32_bf16(va[db], __builtin_bit_cast(bf16x8, pb), acc[db], 0, 0, 0);
                }
            }
            __syncthreads();
        }
        lrun += xshfl<16>(lrun, lane); lrun += xshfl<32>(lrun, lane);
        const float inv = 1.0f / lrun;
        bf16* op = CAT + (size_t)qrow * DM + head * 64 + 4 * g; float ssq = 0.f;
#pragma unroll
        for (int db = 0; db < 4; ++db) { const f32x4 ov = acc[db] * inv; ssq += (ov[0] * ov[0] + ov[1] * ov[1]) + (ov[2] * ov[2] + ov[3] * ov[3]);
            v2u o; o.x = pk2(ov[0], ov[1]); o.y = pk2(ov[2], ov[3]); *(v2u*)(op + 16 * db) = o; }
        ssq += xshfl<16>(ssq, lane); ssq += xshfl<32>(ssq, lane);
        if (g == 0) atomicAdd(ssA + qrow, ss_fix(ssq));
    }
#undef NA_ISSUE
}

__device__ __forceinline__ void post_phase(FA, int l) {
    const bf16* O = WSP(bf16, WS_O); const bf16* Y2 = WSP(bf16, WS_Y2); bf16* CAT = WSP(bf16, WS_CAT);
    const float* ga = AIN(11) + l * 512; const float* gc = AIN(24) + l * 1024; const int lane = F.lane;
    for (int r = F.gw; r < MTOK; r += F.NGW) {
        {
            const v4u w = *(const v4u*)(O + (size_t)r * 512 + 8 * lane); float x[8] = {bflo(w.x), bfhi(w.x), bflo(w.y), bfhi(w.y), bflo(w.z), bfhi(w.z), bflo(w.w), bfhi(w.w)}; float s = 0.f;
#pragma unroll
            for (int i = 0; i < 8; ++i) s += x[i] * x[i];
            const float rstd = fast_rsq(wave_sum(s, F.lane) * (1.0f / 512.0f) + EPS); const f32x4 g0 = *(const f32x4*)(ga + 8 * lane), g1 = *(const f32x4*)(ga + 8 * lane + 4);
            v4u o; o.x = pk2(x[0] * rstd * g0[0], x[1] * rstd * g0[1]); o.y = pk2(x[2] * rstd * g0[2], x[3] * rstd * g0[3]); o.z = pk2(x[4] * rstd * g1[0], x[5] * rstd * g1[1]); o.w = pk2(x[6] * rstd * g1[2], x[7] * rstd * g1[3]);
            *(v4u*)(CAT + (size_t)r * DM + 8 * lane) = o; }
        {
            float s = 0.f; v4u w[2];
#pragma unroll
            for (int hh = 0; hh < 2; ++hh) { w[hh] = *(const v4u*)(Y2 + (size_t)r * 1024 + 512 * hh + 8 * lane);
                s += bflo(w[hh].x) * bflo(w[hh].x) + bfhi(w[hh].x) * bfhi(w[hh].x) + bflo(w[hh].y) * bflo(w[hh].y) + bfhi(w[hh].y) * bfhi(w[hh].y) + bflo(w[hh].z) * bflo(w[hh].z) + bfhi(w[hh].z) * bfhi(w[hh].z) + bflo(w[hh].w) * bflo(w[hh].w) + bfhi(w[hh].w) * bfhi(w[hh].w); }
            const float rstd = fast_rsq(wave_sum(s, F.lane) * (1.0f / 1024.0f) + EPS);
#pragma unroll
            for (int hh = 0; hh < 2; ++hh) { const f32x4 g0 = *(const f32x4*)(gc + 512 * hh + 8 * lane), g1 = *(const f32x4*)(gc + 512 * hh + 8 * lane + 4);
                v4u o; o.x = pk2(bflo(w[hh].x) * rstd * g0[0], bfhi(w[hh].x) * rstd * g0[1]); o.y = pk2(bflo(w[hh].y) * rstd * g0[2], bfhi(w[hh].y) * rstd * g0[3]);
                o.z = pk2(bflo(w[hh].z) * rstd * g1[0], bfhi(w[hh].z) * rstd * g1[1]); o.w = pk2(bflo(w[hh].w) * rstd * g1[2], bfhi(w[hh].w) * rstd * g1[3]);
                *(v4u*)(CAT + (size_t)r * DM + 1024 + 512 * hh + 8 * lane) = o; } }
    }
}

__global__ void __launch_bounds__(NWAVES * 64, 2) enc_fwd(const Args A) {
    extern __shared__ __attribute__((aligned(16))) unsigned char lds[];
    Frame F;
    F.lds = (LAS unsigned char*)lds; F.MISC = (volatile LAS unsigned*)(F.lds + MISC_OFF);
    F.tid = threadIdx.x; F.lane = F.tid & 63; F.wave = __builtin_amdgcn_readfirstlane(F.tid >> 6);
    const int wave0 = F.wave;
    F.G = gridDim.x; F.gw = blockIdx.x * NWAVES + F.wave; F.NGW = F.G * NWAVES; F.bid = blockIdx.x; F.ws = (unsigned char*)A.in[32]; F.X = (float*)A.in[31]; F.zi = 0;

    for (int u = F.tid; u < (LDS_BYTES - LDSCTL_OFF) / 4; u += NWAVES * 64) ((LAS unsigned*)(F.lds + LDSCTL_OFF))[u] = 0u;
    __syncthreads();
    if (!MK_PER_PHASE) (void)xcd_barrier_post((unsigned*)((unsigned char*)A.in[32] + WS_CTL) + CW_BAR, (volatile LAS unsigned*)((LAS unsigned char*)lds + MISC_OFF) + 8);
#define GRID_BAR() do { if (MK_PER_PHASE) { if (F.tid == 0) __hip_atomic_store((gu32*)(F.ws + WS_CTL) + CW_TMO, 0xBADBA0u, RLX_AGENT); } \
    else { unsigned zb_ = 0u; asm volatile("" : "+v"(zb_)); zb_ = (unsigned)__builtin_amdgcn_readfirstlane((int)zb_); unsigned char* wsb_ = (unsigned char*)A.in[32 + (int)zb_]; \
           XcdBarrier b_; b_.bar = (unsigned*)(wsb_ + WS_CTL) + CW_BAR; b_.x = xb_xcc_id(); b_.t0 = (wave0 == 0) && (fresh_lane() == 0); b_.st = (volatile LAS unsigned*)((LAS unsigned char*)lds + MISC_OFF) + 8; xcd_barrier(b_); } } while (0)
#ifndef ONLY
#define ONLY -1
#endif
#define IN(k) ((ONLY < 0 || ((k) - p0) == ONLY) && A.ph_lo <= (k) && (k) < A.ph_hi)
#define SEAM(k) do { if (IN(k) && IN((k) + 1)) GRID_BAR(); } while (0)
#define PHASE_BEGIN() do { int t_ = wave0 * 64 + fresh_lane(); asm volatile("" : "+v"(t_)); F.tid = t_; F.lane = t_ & 63; F.wave = __builtin_amdgcn_readfirstlane(t_ >> 6); \
        int b_ = blockIdx.x; asm volatile("" : "+v"(b_)); b_ = __builtin_amdgcn_readfirstlane(b_); F.bid = b_; F.G = gridDim.x; F.NGW = F.G * NWAVES; F.gw = b_ * NWAVES + F.wave; \
        unsigned z_ = 0u; asm volatile("" : "+v"(z_)); z_ = (unsigned)__builtin_amdgcn_readfirstlane((int)z_); F.zi = (int)z_; F.ws = (unsigned char*)AIN(32); F.X = (float*)AIN(31); } while (0)
    for (int l = 0; l < NL; ++l) {
        const int p0 = l * PH_PER_LAYER;
#define SSP(ll, k) (WSP(u64, WS_SS) + (size_t)(1 + 6 * (ll) + (k)) * MTOK)
        if (IN(p0 + 0)) { PHASE_BEGIN();
            if (F.wave & 1) { s5_ops(F, A, l); conv_layer(F, A, l); } else { conv_layer(F, A, l); s5_ops(F, A, l); }
            if (l == 0) { lb_table(F, A); prep_phase(F, A); }
        }
        SEAM(p0 + 0);
#define HOFF(hf) ((size_t)(hf) * MPROMPT)
#define FFN_UP(hf, WOFF, SA, SB, UB) do { PHASE_BEGIN(); pg8::Gemm g{WSP(bf16, WS_XB) + HOFF(hf) * DM, WSP(bf16, WOFF), MPROMPT, 2 * FF, DM, DM, DM}; pg8::StaticOrder S; S.init(MPROMPT, 2 * FF, F.G, F.bid, WGM_UP); \
            EpiSwiGLU E{WSP(bf16, WS_H) + HOFF(hf) * FF, RowScale{(SA) + HOFF(hf), (SB) + HOFF(hf), UB}}; pg8::gemm_phase<EpiSwiGLU, pg8::StaticOrder, true, true>(F.lds + RING_OFF, g, S, E, F.tid); } while (0)
#define FFN_DN(hf, WOFF, PRE, HASPRE, PREG, SSA, SSB, GB) do { PHASE_BEGIN(); pg8::Gemm g{WSP(bf16, WS_H) + HOFF(hf) * FF, WSP(bf16, WOFF), MPROMPT, DM, FF, FF, FF}; pg8::StaticOrder S; S.init(MPROMPT, DM, F.G, F.bid, WGM_DN); \
            u64* ssb_ = (SSB); EpiResid E{WSP(bf16, WS_XB) + HOFF(hf) * DM, 0.5f, (PRE) + HOFF(hf), HASPRE, PREG, (SSA) + HOFF(hf), ssb_ ? ssb_ + HOFF(hf) : nullptr, GB}; \
            pg8::gemm_phase<EpiResid, pg8::StaticOrder, true, true>(F.lds + RING_OFF, g, S, E, F.tid); } while (0)
        if (IN(p0 + 1)) { FFN_UP(0, WS_WGU1, l ? SSP(l - 1, 2) : WSP(u64, WS_SS), l ? SSP(l - 1, 3) : WSP(u64, WS_SS), l != 0); }
        SEAM(p0 + 1);
        if (IN(p0 + 2)) { FFN_DN(0, WS_WD1, l ? SSP(l - 1, 2) : SSP(l, 0), l != 0, l ? AIN(30) + (l - 1) * DM : nullptr, SSP(l, 0), (u64*)nullptr, nullptr); __syncthreads();
                          FFN_UP(1, WS_WGU1, l ? SSP(l - 1, 2) : WSP(u64, WS_SS), l ? SSP(l - 1, 3) : WSP(u64, WS_SS), l != 0); }
        SEAM(p0 + 2);
        if (IN(p0 + 3)) { FFN_DN(1, WS_WD1, l ? SSP(l - 1, 2) : SSP(l, 0), l != 0, l ? AIN(30) + (l - 1) * DM : nullptr, SSP(l, 0), (u64*)nullptr, nullptr); }
        SEAM(p0 + 3);
        if (IN(p0 + 4)) { PHASE_BEGIN(); pg8::Gemm g{WSP(bf16, WS_XB), WSP(bf16, WS_WIN), MTOK, INC, DM, DM, DM}; pg8::StaticOrder S; S.init(MTOK, INC, F.G, F.bid, WGM_IN);
            EpiWin E{WSP(bf16, WS_Q), WSP(bf16, WS_K), WSP(bf16, WS_V), WSP(bf16, WS_QH), WSP(bf16, WS_VH), WSP(bf16, WS_GH), WSP(bf16, WS_LFF), WSP(bf16, WS_LFB), WSP(bf16, WS_UX),
                     AIN(8) + l * 64, AIN(9) + l * 64, WSP(float, WS_TAB) + l * 1024, RowScale{SSP(l, 0), SSP(l, 0), false}};
            pg8::gemm_phase<EpiWin, pg8::StaticOrder, true, true>(F.lds + RING_OFF, g, S, E, F.tid); }
        SEAM(p0 + 4);
        if (IN(p0 + 5)) { PHASE_BEGIN(); pg8::Gemm g{WSP(bf16, WS_UX), WSP(bf16, WS_S5E), 64 * 2048, 64 * 256, 256, 512, 256}; S5Order S{F.G, F.bid};
            EpiS5E E{WSP(bf16, WS_E)}; pg8::gemm_phase<EpiS5E, S5Order, false, true>(F.lds + RING_OFF, g, S, E, F.tid);
            __syncthreads(); hg_phase_a(F, A);
        }
        SEAM(p0 + 5);
        if (IN(p0 + 6)) { PHASE_BEGIN();
            hg_phase_b(F, A);
            if (F.gw < 1536) s5_carry(F, A, l, F.gw, 1536);
            __syncthreads(); na_phase(F, A, AIN(10) + l * (8 * 15 * 31), AIN(8) + l * 64, AIN(9) + l * 64, SSP(l, 4));
        }
        SEAM(p0 + 6);
        if (IN(p0 + 7)) { PHASE_BEGIN(); pg8::Gemm g{WSP(bf16, WS_UX), WSP(bf16, WS_S5Y), 64 * 2048, 64 * 256, 512, 512, 512}; S5Order S{F.G, F.bid};
            EpiS5Y E{WSP(bf16, WS_YPRE)}; pg8::gemm_phase<EpiS5Y, S5Order, true, true>(F.lds + RING_OFF, g, S, E, F.tid);
            __syncthreads(); hg_phase_c(F, A, AIN(13) + l * 512);
        }
        SEAM(p0 + 7);
        if (IN(p0 + 8)) { PHASE_BEGIN(); pg8::Gemm g{WSP(bf16, WS_YPRE), WSP(bf16, WS_WGLU), MTOK, S5W, S5W, S5W, S5W}; pg8::StaticOrder S; S.init(MTOK, S5W, F.G, F.bid, WGM_DN);
            EpiGLU E{WSP(bf16, WS_YPRE), AIN(23) + l * S5W, WSP(bf16, WS_CAT) + 1024, SSP(l, 5)}; pg8::gemm_phase<EpiGLU, pg8::StaticOrder, true, true>(F.lds + RING_OFF, g, S, E, F.tid); }
        SEAM(p0 + 8);
        if (IN(p0 + 9)) { PHASE_BEGIN(); pg8::Gemm g{WSP(bf16, WS_CAT), WSP(bf16, WS_WOUT), MTOK, DM, DM, DM, DM}; pg8::StaticOrder S; S.init(MTOK, DM, F.G, F.bid, WGM_DN);
            EpiResidW E{WSP(bf16, WS_XB), SSP(l, 4), SSP(l, 5), SSP(l, 1)}; pg8::gemm_phase<EpiResidW, pg8::StaticOrder, true, true>(F.lds + RING_OFF, g, S, E, F.tid); }
        SEAM(p0 + 9);
        if (IN(p0 + 10)) { FFN_UP(0, WS_WGU2, SSP(l, 1), SSP(l, 1), false); }
        SEAM(p0 + 10);
        if (IN(p0 + 11)) { FFN_DN(0, WS_WD2, SSP(l, 2), false, nullptr, SSP(l, 2), SSP(l, 3), AIN(30) + l * DM); __syncthreads();
                           FFN_UP(1, WS_WGU2, SSP(l, 1), SSP(l, 1), false); }
        SEAM(p0 + 11);
        if (IN(p0 + 12)) { FFN_DN(1, WS_WD2, SSP(l, 2), false, nullptr, SSP(l, 2), SSP(l, 3), AIN(30) + l * DM); }
        if (l == NL - 1) SEAM(p0 + 12);
        if (IN(p0 + 13) && l == NL - 1) { PHASE_BEGIN(); out_norm_phase(F, A, SSP(l, 2), AIN(30) + l * DM); }
        SEAM(p0 + 13);
    }
#undef IN
#undef SEAM
}

extern "C" void kernel_launch(void* const* d_in, const int* in_sizes, int n_in, void* d_out, int out_size, void* d_ws, size_t ws_size, hipStream_t stream) {
    static int grid = 0;
    if (grid == 0) {
        if (n_in != 31 || out_size != MTOK * DM || ws_size < WS_END) { fprintf(stderr, "kernel_launch: unexpected shapes: n_in %d out %d ws %zu (need %zu); nothing launched\n", n_in, out_size, ws_size, (size_t)WS_END); grid = -1; return; }
        int dev = 0, cus = 0, per_cu = 0;
        if (hipGetDevice(&dev) != hipSuccess || hipDeviceGetAttribute(&cus, hipDeviceAttributeMultiprocessorCount, dev) != hipSuccess) { grid = -1; return; }
        if (hipFuncSetAttribute((const void*)enc_fwd, hipFuncAttributeMaxDynamicSharedMemorySize, LDS_BYTES) != hipSuccess) { fprintf(stderr, "kernel_launch: hipFuncSetAttribute failed\n"); grid = -1; return; }
        if (hipOccupancyMaxActiveBlocksPerMultiprocessor(&per_cu, (const void*)enc_fwd, NWAVES * 64, LDS_BYTES) != hipSuccess || per_cu < 1)
            fprintf(stderr, "kernel_launch: note: occupancy query reports %d workgroups per CU\n", per_cu);
        (void)hipGetLastError();
        grid = cus;
    }
    if (grid < 0) return;
    static_assert(WS_SS + SS_BYTES == WS_CTL && WS_CTL + CTL_ZERO_BYTES == WS_END, "row sums and control words are one contiguous region");
    if (hipMemsetAsync((char*)d_ws + WS_SS, 0, SS_BYTES + CTL_ZERO_BYTES, stream) != hipSuccess) { fprintf(stderr, "kernel_launch: memset failed\n"); return; }
    Args a{};
    for (int i = 0; i < 31; ++i) a.in[i] = (const float*)d_in[i];
    a.in[31] = (const float*)d_out; a.in[32] = (const float*)d_ws; a.li = 0; a.pad = 0;
#if MK_PER_PHASE
    for (int p = 0; p < N_PHASES; ++p) { a.ph_lo = p; a.ph_hi = p + 1; hipLaunchKernelGGL(enc_fwd, dim3(grid), dim3(NWAVES * 64), LDS_BYTES, stream, a); }
#else
    a.ph_lo = 0; a.ph_hi = N_PHASES; hipLaunchKernelGGL(enc_fwd, dim3(grid), dim3(NWAVES * 64), LDS_BYTES, stream, a);
#endif
    const hipError_t le = hipPeekAtLastError();
    if (le != hipSuccess) fprintf(stderr, "kernel_launch: launch failed: %s\n", hipGetErrorName(le));
}
```

```cpp
#include <hip/hip_runtime.h>
#include <cstdio>
#include <cstdint>
namespace pg8 {
#define PG8_LAS __attribute__((address_space(3)))
typedef unsigned short bf16_t;
typedef short bf16x8 __attribute__((ext_vector_type(8)));
typedef float f32x4 __attribute__((ext_vector_type(4)));
typedef unsigned u32x4 __attribute__((ext_vector_type(4)));
constexpr int BM = 256, BK = 64, HALF = 128, HTB = HALF * BK * 2  , STAGE_BYTES = 8 * HTB, NXCD = 8, WGM = 8;

__host__ __device__ __forceinline__ int lds_byte(int r, int c) { const int st = (r >> 4) * 2 + (c >> 5), rr = r & 15, cc = c & 31, ob = rr * 64 + cc * 2; return st * 1024 + (ob ^ (((ob >> 9) & 1) << 5)); }
__host__ __device__ __forceinline__ void stage_rc(int b, int& R, int& C) { const int st = b / 1024, sb = b % 1024, swz = sb ^ (((sb >> 9) & 1) << 5); R = (st >> 1) * 16 + swz / 64; C = (st & 1) * 32 + (swz % 64) / 2; }
__host__ __device__ __forceinline__ int perm32(int rho) { const int n = rho >> 4, i = rho & 15; return 8 * (i >> 2) + 4 * n + (i & 3); }

struct Unit { int pm, pn; };
struct Gemm { const bf16_t* A; const bf16_t* Bt; int M, N, K, lda, ldb; };

struct StaticOrder {
    int nM, nN, nwg, G, c, wgm;
    __host__ __device__ void init(int M, int N, int G_, int c_, int wgm_ = WGM) { nM = M / BM; nN = N / BM; nwg = nM * nN; G = G_; c = c_; wgm = wgm_; }
    __host__ __device__ bool next(int i, Unit& u) const {
        const long L = (long)i * G + c; if (L >= nwg) return false;
        int wgid = (int)L; { const int q = nwg / NXCD, r = nwg % NXCD, xcd = wgid % NXCD, off = wgid / NXCD; wgid = (xcd < r ? xcd * (q + 1) : r * (q + 1) + (xcd - r) * q) + off; }
        const int nig = wgm * nN, gid = wgid / nig, fm = gid * wgm, gsz = (nM - fm) < wgm ? (nM - fm) : wgm;
        u.pm = fm + ((wgid % nig) % gsz); u.pn = (wgid % nig) / gsz; return true;
    }
    __device__ __forceinline__ void a_ready(const Unit&) const {}
    __device__ __forceinline__ void done(const Unit&) const {}
};

template <class Epi, class Sched, bool ALIGN_EPI = false, bool SP2 = false>
__device__ __forceinline__ void gemm_phase(PG8_LAS unsigned char* lds, const Gemm g, const Sched& S, const Epi& E, int tid_in) {
    int tid_ = tid_in; asm volatile("" : "+v"(tid_));
    const int tid = tid_, wid = __builtin_amdgcn_readfirstlane(tid >> 6), lane = tid & 63, wr = wid >> 2, wc = wid & 3, fr = lane & 15, fq = lane >> 4;
    const int K = g.K, nt = K / BK;
    unsigned voffA[2], voffB[2];
#pragma unroll
    for (int i = 0; i < 2; ++i) { int R, C; stage_rc(tid * 16 + i * 8192, R, C); const int Rb = Epi::PERM ? ((R & ~31) + perm32(R & 31)) : R;
        voffA[i] = (unsigned)(R * g.lda + C) * 2u; voffB[i] = (unsigned)(Rb * g.ldb + C) * 2u; }
    const size_t kstep = (size_t)(BK * 2);
    const size_t hstepA = (size_t)HALF * g.lda * 2, hstepB = (size_t)HALF * g.ldb * 2;
    const size_t tstepA = 2 * hstepA, tstepB = 2 * hstepB;
    const unsigned ldsw = (unsigned)wid * 1024u;
    const int aoff = lds_byte(wr * 64 + fr, fq * 8), boff = lds_byte(wc * 32 + fr, fq * 8);
#define PG8_SA(b, h) (((b) * 2 + (h)) * HTB)
#define PG8_SB(b, h) ((4 + (b) * 2 + (h)) * HTB)
#define PG8_STAGE(bufoff, gbase, voff) do { _Pragma("unroll") for (int _i = 0; _i < 2; ++_i) \
        __builtin_amdgcn_global_load_lds((const unsigned*)((const char*)(gbase) + (voff)[_i]), (PG8_LAS unsigned*)(lds + (bufoff) + ldsw + _i * 8192), 16, 0, 0); } while (0)
#define PG8_LDA(dst, b, h) do { _Pragma("unroll") for (int m = 0; m < 4; ++m) _Pragma("unroll") for (int k = 0; k < 2; ++k) dst[m][k] = *(const PG8_LAS bf16x8*)(lds + PG8_SA(b, h) + aoff + m * 2048 + k * 1024); } while (0)
#define PG8_LDB(dst, b, h) do { _Pragma("unroll") for (int n = 0; n < 2; ++n) _Pragma("unroll") for (int k = 0; k < 2; ++k) dst[n][k] = *(const PG8_LAS bf16x8*)(lds + PG8_SB(b, h) + boff + n * 2048 + k * 1024); } while (0)
#define PG8_MMA(ai, bj, At, Bt) do { __builtin_amdgcn_s_setprio(1); _Pragma("unroll") for (int m = 0; m < 4; ++m) _Pragma("unroll") for (int n = 0; n < 2; ++n) _Pragma("unroll") for (int k = 0; k < 2; ++k) \
        acc[ai][bj][m][n] = __builtin_amdgcn_mfma_f32_16x16x32_bf16(Bt[n][k], At[m][k], acc[ai][bj][m][n], 0, 0, 0); __builtin_amdgcn_s_setprio(0); } while (0)
#define PG8_WAIT_V(n) asm volatile("s_waitcnt vmcnt(" #n ")" ::: "memory")
#define PG8_WAIT_L(n) asm volatile("s_waitcnt lgkmcnt(" #n ")" ::: "memory")
#define PG8_BAR __builtin_amdgcn_s_barrier()
#define PG8_SCHED __builtin_amdgcn_sched_barrier(0)
    Unit cur, nxt; int ui = 0;
    if (!S.next(0, cur)) return;
    f32x4 acc[2][2][4][2];
#pragma unroll
    for (int a = 0; a < 2; ++a)
#pragma unroll
        for (int b = 0; b < 2; ++b)
#pragma unroll
            for (int m = 0; m < 4; ++m)
#pragma unroll
                for (int n = 0; n < 2; ++n) acc[a][b][m][n] = (f32x4){0.f, 0.f, 0.f, 0.f};
    bf16x8 At[4][2], B0[2][2], B1[2][2];
    const char* cA = (const char*)g.A + (size_t)cur.pm * tstepA; const char* cB = (const char*)g.Bt + (size_t)cur.pn * tstepB;
#define PG8_KT(x) ((Epi::KROT != 0 ? (size_t)(((x) + Epi::KROT) & (nt - 1)) : (size_t)(x)) * kstep)
    S.a_ready(cur);
    E.first(cur, lds, tid);
    if constexpr (SP2) {
        PG8_STAGE(PG8_SB(0, 0), cB + PG8_KT(0), voffB); PG8_STAGE(PG8_SB(0, 1), cB + hstepB + PG8_KT(0), voffB); PG8_STAGE(PG8_SA(0, 0), cA + PG8_KT(0), voffA); PG8_STAGE(PG8_SA(0, 1), cA + hstepA + PG8_KT(0), voffA);
        if (wr == 1) PG8_BAR;
        PG8_WAIT_V(2); PG8_BAR;
        PG8_STAGE(PG8_SB(1, 0), cB + PG8_KT(1), voffB); PG8_STAGE(PG8_SA(1, 0), cA + PG8_KT(1), voffA); PG8_STAGE(PG8_SB(1, 1), cB + hstepB + PG8_KT(1), voffB);
        PG8_WAIT_V(6); PG8_BAR;
    } else {
        PG8_STAGE(PG8_SB(0, 0), cB + PG8_KT(0), voffB); PG8_STAGE(PG8_SA(0, 0), cA + PG8_KT(0), voffA); PG8_STAGE(PG8_SB(0, 1), cB + hstepB + PG8_KT(0), voffB); PG8_STAGE(PG8_SA(0, 1), cA + hstepA + PG8_KT(0), voffA);
        if (wr == 1) PG8_BAR;
        PG8_WAIT_V(4); PG8_BAR;
        PG8_STAGE(PG8_SB(1, 0), cB + PG8_KT(1), voffB); PG8_STAGE(PG8_SA(1, 0), cA + PG8_KT(1), voffA); PG8_STAGE(PG8_SB(1, 1), cB + hstepB + PG8_KT(1), voffB);
        PG8_WAIT_V(6); PG8_BAR;
    }
    for (;;) {
        const bool has_next = S.next(ui + 1, nxt);
        const char* nA = has_next ? (const char*)g.A + (size_t)nxt.pm * tstepA : cA; const char* nB = has_next ? (const char*)g.Bt + (size_t)nxt.pn * tstepB : cB;
        for (int t = 0; t < nt; t += 2) {
            const bool last = (t == nt - 2);
            const char* a1 = cA + PG8_KT(t + 1);
            const char* a2 = last ? nA + PG8_KT(0) : cA + PG8_KT(t + 2); const char* b2 = last ? nB + PG8_KT(0) : cB + PG8_KT(t + 2);
            const char* a3 = Epi::KROT != 0 ? (last ? nA + PG8_KT(1) : cA + PG8_KT(t + 3)) : a2 + kstep; const char* b3 = Epi::KROT != 0 ? (last ? nB + PG8_KT(1) : cB + PG8_KT(t + 3)) : b2 + kstep;
            if constexpr (Epi::KROT != 0) { if (t == Epi::HOOK0 || t == Epi::HOOK1) E.khook(acc, t, wr, fr, ui, lds); }
            if (last && has_next) S.a_ready(nxt);
            if constexpr (SP2) {
            PG8_LDB(B0, 0, 0); PG8_LDB(B1, 0, 1); PG8_SCHED; PG8_LDA(At, 0, 0); PG8_STAGE(PG8_SA(1, 1), a1 + hstepA, voffA);
            PG8_WAIT_V(8); PG8_WAIT_L(0); PG8_BAR; PG8_MMA(0, 0, At, B0); PG8_MMA(0, 1, At, B1); PG8_BAR; PG8_SCHED;
            PG8_LDA(At, 0, 1); PG8_STAGE(PG8_SB(0, 0), b2, voffB); PG8_STAGE(PG8_SB(0, 1), b2 + hstepB, voffB); PG8_STAGE(PG8_SA(0, 0), a2, voffA);
            PG8_WAIT_V(8); PG8_WAIT_L(0); PG8_BAR; PG8_MMA(1, 0, At, B0); PG8_MMA(1, 1, At, B1); PG8_BAR; PG8_SCHED;
            PG8_LDB(B0, 1, 0); PG8_LDB(B1, 1, 1); PG8_SCHED; PG8_LDA(At, 1, 0); PG8_STAGE(PG8_SA(0, 1), a2 + hstepA, voffA);
            PG8_WAIT_V(8); PG8_WAIT_L(0); PG8_BAR; PG8_MMA(0, 0, At, B0); PG8_MMA(0, 1, At, B1); PG8_BAR; PG8_SCHED;
            PG8_LDA(At, 1, 1); PG8_STAGE(PG8_SB(1, 0), b3, voffB); PG8_STAGE(PG8_SB(1, 1), b3 + hstepB, voffB); PG8_STAGE(PG8_SA(1, 0), a3, voffA);
            PG8_WAIT_V(8); PG8_WAIT_L(0); PG8_BAR; PG8_MMA(1, 0, At, B0); PG8_MMA(1, 1, At, B1); PG8_BAR; PG8_SCHED;
            } else {
            PG8_LDB(B0, 0, 0); PG8_SCHED; PG8_LDA(At, 0, 0); PG8_STAGE(PG8_SA(1, 1), a1 + hstepA, voffA);
            PG8_WAIT_L(8); PG8_BAR; PG8_WAIT_L(0); PG8_MMA(0, 0, At, B0); PG8_BAR; PG8_SCHED;
            PG8_LDB(B1, 0, 1); PG8_STAGE(PG8_SB(0, 0), b2, voffB);
            PG8_BAR; PG8_WAIT_L(0); PG8_MMA(0, 1, At, B1); PG8_BAR;
            PG8_LDA(At, 0, 1); PG8_STAGE(PG8_SA(0, 0), a2, voffA);
            PG8_BAR; PG8_WAIT_L(0); PG8_MMA(1, 0, At, B0); PG8_BAR; PG8_SCHED;
            PG8_STAGE(PG8_SB(0, 1), b2 + hstepB, voffB);
            PG8_WAIT_V(6); PG8_BAR; PG8_MMA(1, 1, At, B1); PG8_BAR;
            PG8_LDB(B0, 1, 0); PG8_SCHED; PG8_LDA(At, 1, 0); PG8_STAGE(PG8_SA(0, 1), a2 + hstepA, voffA);
            PG8_WAIT_L(8); PG8_BAR; PG8_WAIT_L(0); PG8_MMA(0, 0, At, B0); PG8_BAR; PG8_SCHED;
            PG8_LDB(B1, 1, 1); PG8_STAGE(PG8_SB(1, 0), b3, voffB);
            PG8_BAR; PG8_WAIT_L(0); PG8_MMA(0, 1, At, B1); PG8_BAR;
            PG8_LDA(At, 1, 1); PG8_STAGE(PG8_SA(1, 0), a3, voffA);
            PG8_BAR; PG8_WAIT_L(0); PG8_MMA(1, 0, At, B0); PG8_BAR; PG8_SCHED;
            PG8_STAGE(PG8_SB(1, 1), b3 + hstepB, voffB);
            PG8_WAIT_V(6); PG8_BAR; PG8_MMA(1, 1, At, B1); PG8_BAR;
            }
        }
        if constexpr (ALIGN_EPI) { if (wr == 0) PG8_BAR; }
        if constexpr (!Epi::AFTER_DRAIN) { E(acc, cur, wr, wc, fr, fq, ui, has_next, nxt, lds, tid); S.done(cur); }
        if (!has_next) break;
#pragma unroll
        for (int a = 0; a < 2; ++a)
#pragma unroll
            for (int b = 0; b < 2; ++b)
#pragma unroll
                for (int m = 0; m < 4; ++m)
#pragma unroll
                    for (int n = 0; n < 2; ++n) acc[a][b][m][n] = (f32x4){0.f, 0.f, 0.f, 0.f};
        cur = nxt; cA = nA; cB = nB; ++ui;
        if constexpr (ALIGN_EPI) { if (wr == 1) PG8_BAR; }
    }
    PG8_WAIT_V(0);
    if constexpr (!ALIGN_EPI) { if (wr == 0) PG8_BAR; }
    PG8_BAR;
    if constexpr (Epi::AFTER_DRAIN) { E.fused(acc, cur, wr, wc, fr, fq, lds, wid, lane); S.done(cur); }
#undef PG8_KT
#undef PG8_SA
#undef PG8_SB
#undef PG8_STAGE
#undef PG8_LDA
#undef PG8_LDB
#undef PG8_MMA
#undef PG8_WAIT_V
#undef PG8_WAIT_L
#undef PG8_BAR
#undef PG8_SCHED
}
}

constexpr int NWAVES = 8;
#ifndef WGM_UP
#define WGM_UP 8
#endif
#ifndef WGM_DN
#define WGM_DN 4
#endif
#ifndef WGM_IN
#define WGM_IN 4
#endif
#ifndef MK_PER_PHASE
#define MK_PER_PHASE 0
#endif
constexpr int DM = 2048, FF = 5632, NL = 4, MTOK = 32768, MPROMPT = 16384, TP = 2048, TS = 4096;
constexpr int INC = 5120, NAW = 512, HGW = 512, S5W = 1024;
constexpr float EPS = 1e-6f;
constexpr int PH_PER_LAYER = 14, N_PHASES = NL * PH_PER_LAYER;

constexpr size_t MiB = 1u << 20;
constexpr size_t WS_CTL = 1477 * MiB, CTL_ZERO_BYTES = 1 * MiB;
constexpr size_t WS_TAB = 1 * MiB;
constexpr size_t WS_WGU1 = 2 * MiB, WS_WD1 = 46 * MiB, WS_WIN = 68 * MiB, WS_WGLU = 88 * MiB, WS_WOUT = 90 * MiB, WS_WGU2 = 98 * MiB, WS_WD2 = 142 * MiB;
constexpr size_t WS_XB = 164 * MiB;
constexpr size_t WS_H = 292 * MiB;
constexpr size_t WS_Q = 292 * MiB, WS_K = 324 * MiB, WS_V = 356 * MiB, WS_QH = 388 * MiB, WS_VH = 420 * MiB, WS_GH = 452 * MiB, WS_LFF = 484 * MiB, WS_LFB = 548 * MiB;
constexpr size_t WS_UX = 644 * MiB;
constexpr size_t WS_CAT = 772 * MiB;
constexpr size_t WS_YPRE = 900 * MiB, WS_Y2 = 964 * MiB;
constexpr size_t WS_O = 1028 * MiB;
constexpr size_t WS_OF = 1060 * MiB, WS_OB = 1124 * MiB;
constexpr size_t WS_YF = 1188 * MiB;
constexpr size_t WS_S5E = 1316 * MiB, WS_S5Y = 1324 * MiB;
constexpr size_t WS_E = WS_YF;
constexpr size_t WS_LT = WS_OF;
constexpr size_t WS_SIN = 1340 * MiB;
constexpr size_t WS_HD = 1468 * MiB;
constexpr size_t WS_SS = 1470 * MiB, SS_BYTES = 7 * MiB;
constexpr size_t WS_END = 1478 * MiB;
constexpr int CW_TMO = 0, CW_CODE = 1, CW_BAR = 4096;

constexpr int RING_OFF = 0, RING_BYTES = 131072;
constexpr int LDSCTL_OFF = RING_BYTES, MISC_OFF = LDSCTL_OFF + 320;
constexpr int LDS_BYTES = 147456;

#define GAS __attribute__((address_space(1)))
#define LAS __attribute__((address_space(3)))
typedef unsigned short bf16;
typedef unsigned v4u __attribute__((ext_vector_type(4)));
typedef unsigned v2u __attribute__((ext_vector_type(2)));
typedef float f32x4 __attribute__((ext_vector_type(4)));
typedef short bf16x8 __attribute__((ext_vector_type(8)));
typedef GAS unsigned gu32;
#define RLX_AGENT __ATOMIC_RELAXED, __HIP_MEMORY_SCOPE_AGENT
#define LDS_WAIT() asm volatile("s_waitcnt lgkmcnt(0)" ::: "memory")
#define VM_WAIT() asm volatile("s_waitcnt vmcnt(0)" ::: "memory")
__device__ __forceinline__ unsigned f2bf(float f) { unsigned u = __builtin_bit_cast(unsigned, f); return (u + 0x7fffu + ((u >> 16) & 1u)) >> 16; }
typedef float f32x2_t __attribute__((ext_vector_type(2)));
typedef __bf16 bf16x2_t __attribute__((ext_vector_type(2)));
__device__ __forceinline__ unsigned pk2(float lo, float hi) { const f32x2_t v = {lo, hi}; const bf16x2_t b = __builtin_convertvector(v, bf16x2_t); return __builtin_bit_cast(unsigned, b); }
__device__ __forceinline__ float bflo(unsigned w) { return __builtin_bit_cast(float, w << 16); }
__device__ __forceinline__ float bfhi(unsigned w) { return __builtin_bit_cast(float, w & 0xffff0000u); }
__device__ __forceinline__ float bf2f(bf16 b) { return __builtin_bit_cast(float, ((unsigned)b) << 16); }
__device__ __forceinline__ float fast_rcp(float x) { return __builtin_amdgcn_rcpf(x); }
__device__ __forceinline__ float fast_rsq(float x) { return __builtin_amdgcn_rsqf(x); }
__device__ __forceinline__ void fast_sincos(float x, float& s, float& c) { float r = x * 0.15915494309189535f; r = r - floorf(r); s = __builtin_amdgcn_sinf(r); c = __builtin_amdgcn_cosf(r); }
__device__ __forceinline__ float sigmoidf_(float x) { return fast_rcp(1.0f + __expf(-x)); }
__device__ __forceinline__ float siluf_(float x) { return x * sigmoidf_(x); }
__device__ __forceinline__ float gelu_tanh(float x) {
    const float t = 1.5957691216057308f * (x + 0.044715f * x * x * x);
    return x * sigmoidf_(t);
}
template <int MASK> __device__ __forceinline__ float xshfl(float v, int lane) {
    if (MASK < 32) return __builtin_bit_cast(float, __builtin_amdgcn_ds_swizzle(__builtin_bit_cast(int, v), (MASK << 10) | 0x1f));
    else return __builtin_bit_cast(float, __builtin_amdgcn_ds_bpermute((lane ^ 32) << 2, __builtin_bit_cast(int, v)));
}
__device__ __forceinline__ float lane_bcast(float v, int src) { return __builtin_bit_cast(float, __builtin_amdgcn_ds_bpermute(src << 2, __builtin_bit_cast(int, v))); }
__device__ __forceinline__ float wave_sum(float v, int lane) {
    v += xshfl<1>(v, lane); v += xshfl<2>(v, lane); v += xshfl<4>(v, lane); v += xshfl<8>(v, lane); v += xshfl<16>(v, lane); v += xshfl<32>(v, lane); return v;
}
__device__ __forceinline__ float wave_max(float v, int lane) {
    v = fmaxf(v, xshfl<1>(v, lane)); v = fmaxf(v, xshfl<2>(v, lane)); v = fmaxf(v, xshfl<4>(v, lane)); v = fmaxf(v, xshfl<8>(v, lane)); v = fmaxf(v, xshfl<16>(v, lane)); v = fmaxf(v, xshfl<32>(v, lane)); return v;
}
typedef unsigned long long u64;
__device__ __forceinline__ u64 ss_fix(float s) { return (u64)(s * 1048576.0f + 0.5f); }
__device__ __forceinline__ float ss_val(u64 v) { return (float)v * (1.0f / 1048576.0f); }
constexpr int ROWSC_OFF = RING_BYTES + 1024;
constexpr int NA_BIAS_OFF = RING_BYTES + 4096;
struct RowScale {
    const u64* ssa; const u64* ssb; bool useb;
    __device__ __forceinline__ float conv(u64 a, u64 b2) const { const float rs = fast_rsq(ss_val(a) * (1.0f / DM) + EPS); const float r2 = fast_rsq(rs * rs * ss_val(b2) * (1.0f / DM) + EPS); return useb ? rs * r2 : rs; }
    __device__ __forceinline__ void issue(int pm, int tid, u64& a, u64& b2) const { a = ssa[pm * 256 + (tid & 255)]; b2 = ssb[pm * 256 + (tid & 255)]; }
    __device__ __forceinline__ void commit(LAS unsigned char* lds, int slot, int tid, u64 a, u64 b2) const { ((LAS float*)(lds + ROWSC_OFF))[slot * 256 + (tid & 255)] = conv(a, b2); }
    __device__ __forceinline__ float get(LAS unsigned char* lds, int slot, int idx) const { return ((LAS float*)(lds + ROWSC_OFF))[slot * 256 + idx]; }
};
#define XB_TMO      128
#define XB_XCNT(j)  (256  + 64 * (j))
#define XB_XSUB(j)  (1280 + 64 * (j))
#define XB_XGEN(j)  (2304 + 64 * (j))
#define XB_TOP      3328
#define XB_TOPGEN   3392
#define XCD_BAR_WORDS 3456
#define XB_SPIN_CAP (1u << 18)

__device__ __forceinline__ unsigned xb_ld(unsigned* p)              { return __hip_atomic_load(p, __ATOMIC_RELAXED, __HIP_MEMORY_SCOPE_AGENT); }
__device__ __forceinline__ unsigned xb_add(unsigned* p, unsigned v) { return __hip_atomic_fetch_add(p, v, __ATOMIC_RELAXED, __HIP_MEMORY_SCOPE_AGENT); }
__device__ __forceinline__ unsigned xb_xcc_id() { return (unsigned)__builtin_amdgcn_s_getreg((3 << 11) | 20) & 0xFu; }
#define XB_SPIN(cond, bar) do { unsigned _sp = 0; while (cond) { __builtin_amdgcn_s_sleep(1); \
    if ((++_sp & 255u) == 0u) { if (xb_ld(&(bar)[XB_TMO])) break; if (_sp > XB_SPIN_CAP) { atomicAdd(&(bar)[XB_TMO], 1u); break; } } } } while (0)

struct XcdBarrier {
    unsigned* bar; unsigned x;
    volatile LAS unsigned* st;
    bool t0;
};

__device__ __forceinline__ XcdBarrier xcd_barrier_post(unsigned* bar, volatile LAS unsigned* st) {
    XcdBarrier b; b.bar = bar; b.x = xb_xcc_id(); b.st = st; b.t0 = (threadIdx.x == 0);
    if (threadIdx.x == 0) (void)xb_add(&bar[XB_XCNT(b.x)], 1u);
    return b;
}
__device__ __forceinline__ void xcd_barrier_complete(unsigned* bar, unsigned x, unsigned& nloc, unsigned& nx) {
    const unsigned G = gridDim.x * gridDim.y * gridDim.z;
    unsigned sum, cnt, mine, sp = 0u;
    for (;;) {
        sum = 0u; cnt = 0u; mine = 0u;
#pragma unroll
        for (unsigned j = 0; j < 16; ++j) { const unsigned c = xb_ld(&bar[XB_XCNT(j)]); sum += c; cnt += (c > 0u) ? 1u : 0u; mine = (j == x) ? c : mine; }
        if (sum == G) break;
        __builtin_amdgcn_s_sleep(1);
        if ((++sp & 255u) == 0u) { if (xb_ld(&bar[XB_TMO])) break; if (sp > XB_SPIN_CAP) { atomicAdd(&bar[XB_TMO], 1u); break; } }
    }
    nloc = mine > 0u ? mine : 1u; nx = cnt > 0u ? cnt : 1u;
}

__device__ __forceinline__ void xcd_barrier(const XcdBarrier& b) {
    asm volatile("s_waitcnt vmcnt(0)" ::: "memory");
    __syncthreads();
    if (b.t0) {
        unsigned* bar = b.bar;
        __builtin_amdgcn_s_waitcnt(0);
        unsigned nloc = b.st[0], nx = b.st[1];
        if (nloc == 0u) { xcd_barrier_complete(bar, b.x, nloc, nx); b.st[0] = nloc; b.st[1] = nx; }
        const unsigned old = xb_add(&bar[XB_XSUB(b.x)], 1u);
        const unsigned gen = old / nloc;
        if (old + 1u == (gen + 1u) * nloc) {
            __builtin_amdgcn_fence(__ATOMIC_RELEASE, "agent");
            asm volatile("s_waitcnt vmcnt(0)" ::: "memory");
            const unsigned og = xb_add(&bar[XB_TOP], 1u);
            const unsigned tg = og / nx;
            if (og + 1u == (tg + 1u) * nx) xb_add(&bar[XB_TOPGEN], 1u);
            else XB_SPIN(xb_ld(&bar[XB_TOPGEN]) == tg, bar);
            __builtin_amdgcn_fence(__ATOMIC_ACQUIRE, "agent");
            xb_add(&bar[XB_XGEN(b.x)], 1u);
            asm volatile("s_waitcnt vmcnt(0)" ::: "memory");
        } else {
            XB_SPIN(xb_ld(&bar[XB_XGEN(b.x)]) == gen, bar);
            __builtin_amdgcn_fence(__ATOMIC_ACQUIRE, "agent");
            asm volatile("s_waitcnt vmcnt(0)" ::: "memory");
        }
    }
    __syncthreads();
}

using pg8::Unit;
struct EpiSwiGLU {
    static constexpr bool PERM = true, AFTER_DRAIN = false; static constexpr int KROT = 0;
    __device__ __forceinline__ void first(const Unit& u, LAS unsigned char* lds, int tid) const { u64 a, b2; rsc.issue(u.pm, tid, a, b2); rsc.commit(lds, 0, tid, a, b2); }
    bf16* H; RowScale rsc;
    __device__ __forceinline__ void operator()(const f32x4 (&acc)[2][2][4][2], const Unit& u, int wr, int wc, int fr, int fq, int ui, bool has_next, const Unit& nxt, LAS unsigned char* lds, int tid) const {
        const int row0 = u.pm * 256 + wr * 64 + fr, col0 = u.pn * 128 + wc * 32 + 8 * fq;
        u64 na, nb; rsc.issue(has_next ? nxt.pm : u.pm, tid, na, nb);
#pragma unroll
        for (int ai = 0; ai < 2; ++ai)
#pragma unroll
            for (int m = 0; m < 4; ++m) {
                const int row = row0 + ai * 128 + m * 16;
                const float rs = rsc.get(lds, ui & 1, ai * 128 + wr * 64 + m * 16 + fr);
                bf16* rowp = H + (size_t)row * FF + col0;
                float h[8];
#pragma unroll
                for (int n = 0; n < 2; ++n)
#pragma unroll
                    for (int i = 0; i < 4; ++i) { const float g = acc[ai][0][m][n][i] * rs, uu = acc[ai][1][m][n][i] * rs; h[4 * n + i] = siluf_(g) * uu; }
                v4u w; w.x = pk2(h[0], h[1]); w.y = pk2(h[2], h[3]); w.z = pk2(h[4], h[5]); w.w = pk2(h[6], h[7]);
                *(v4u*)rowp = w;
            }
        rsc.commit(lds, (ui + 1) & 1, tid, na, nb);
    }
};
struct EpiResid {
    static constexpr bool PERM = true, AFTER_DRAIN = false; static constexpr int KROT = 0;
    __device__ __forceinline__ void first(const Unit&, LAS unsigned char*, int) const {}
    bf16* XB; float scale; const u64* pre_ss; bool has_pre; const float* pre_g; u64* ssa; u64* ssb; const float* gb;
    __device__ __forceinline__ void operator()(const f32x4 (&acc)[2][2][4][2], const Unit& u, int wr, int wc, int fr, int fq, int ui, bool has_next, const Unit& nxt, LAS unsigned char* lds, int tid) const {
        const int row0 = u.pm * 256 + wr * 64 + fr, col0 = u.pn * 256 + wc * 32 + 8 * fq;
        f32x4 pg[2][2], g2[2][2];
#pragma unroll
        for (int bj = 0; bj < 2; ++bj)
#pragma unroll
            for (int n = 0; n < 2; ++n) { pg[bj][n] = has_pre ? *(const f32x4*)(pre_g + col0 + bj * 128 + n * 4) : (f32x4){1.f, 1.f, 1.f, 1.f};
                if (ssb) { const f32x4 t = *(const f32x4*)(gb + col0 + bj * 128 + n * 4); g2[bj][n] = t * t; } else g2[bj][n] = (f32x4){0.f, 0.f, 0.f, 0.f}; }
#pragma unroll
        for (int ai = 0; ai < 2; ++ai) {
            v4u xw[4][2]; u64 ps[4];
#pragma unroll
            for (int m = 0; m < 4; ++m) { const int row = row0 + ai * 128 + m * 16; ps[m] = pre_ss[row];
#pragma unroll
                for (int bj = 0; bj < 2; ++bj) xw[m][bj] = *(const v4u*)(XB + (size_t)row * DM + col0 + bj * 128); }
#pragma unroll
            for (int m = 0; m < 4; ++m) {
                const int row = row0 + ai * 128 + m * 16;
                const float r1 = has_pre ? fast_rsq(ss_val(ps[m]) * (1.0f / DM) + EPS) : 1.0f;
                float sa = 0.f, sb = 0.f;
#pragma unroll
                for (int bj = 0; bj < 2; ++bj) { const v4u w0 = xw[m][bj]; f32x4 xn[2];
                    const f32x4 xo[2] = {(f32x4){bflo(w0.x), bfhi(w0.x), bflo(w0.y), bfhi(w0.y)}, (f32x4){bflo(w0.z), bfhi(w0.z), bflo(w0.w), bfhi(w0.w)}};
#pragma unroll
                    for (int n = 0; n < 2; ++n) { xn[n] = xo[n] * (pg[bj][n] * r1) + acc[ai][bj][m][n] * scale;
                        const f32x4 sq = xn[n] * xn[n]; sa += (sq[0] + sq[1]) + (sq[2] + sq[3]);
                        if (ssb) { const f32x4 sg = sq * g2[bj][n]; sb += (sg[0] + sg[1]) + (sg[2] + sg[3]); } }
                    v4u w; w.x = pk2(xn[0][0], xn[0][1]); w.y = pk2(xn[0][2], xn[0][3]); w.z = pk2(xn[1][0], xn[1][1]); w.w = pk2(xn[1][2], xn[1][3]);
                    *(v4u*)(XB + (size_t)row * DM + col0 + bj * 128) = w; }
                sa += xshfl<16>(sa, 16 * fq + fr); sa += xshfl<32>(sa, 16 * fq + fr);
                if (ssb) { sb += xshfl<16>(sb, 16 * fq + fr); sb += xshfl<32>(sb, 16 * fq + fr); }
                if (fq == 0) { atomicAdd(ssa + row, ss_fix(sa)); if (ssb) atomicAdd(ssb + row, ss_fix(sb)); }
            }
        }
    }
};
struct EpiResidW {
    static constexpr bool PERM = true, AFTER_DRAIN = false; static constexpr int KROT = 16, HOOK0 = 16, HOOK1 = 24;
    bf16* XB; const u64* ssA; const u64* ssC; u64* ssa;
    typedef float f32x2w __attribute__((ext_vector_type(2)));
    __device__ __forceinline__ f32x2w conv(u64 a, u64 cc) const { const float ra = fast_rsq(ss_val(a) * (1.0f / 512.0f) + EPS), rc = fast_rsq(ss_val(cc) * (1.0f / 1024.0f) + EPS); return (f32x2w){ra, rc / ra}; }
    __device__ __forceinline__ void first(const Unit& u, LAS unsigned char* lds, int tid) const { const u64 a = ssA[u.pm * 256 + (tid & 255)], cc = ssC[u.pm * 256 + (tid & 255)]; ((LAS f32x2w*)(lds + ROWSC_OFF))[tid & 255] = conv(a, cc); }
    __device__ __forceinline__ void khook(f32x4 (&acc)[2][2][4][2], int t, int wr, int fr, int ui, LAS unsigned char* lds) const {
        const LAS f32x2w* sl = (const LAS f32x2w*)(lds + ROWSC_OFF) + (ui & 1) * 256;
#pragma unroll
        for (int ai = 0; ai < 2; ++ai)
#pragma unroll
            for (int m = 0; m < 4; ++m) { const f32x2w sc = sl[ai * 128 + wr * 64 + m * 16 + fr]; const float f = (t == HOOK0) ? sc.y : sc.x;
#pragma unroll
                for (int bj = 0; bj < 2; ++bj)
#pragma unroll
                    for (int n = 0; n < 2; ++n) acc[ai][bj][m][n] = acc[ai][bj][m][n] * f; }
    }
    __device__ __forceinline__ void operator()(const f32x4 (&acc)[2][2][4][2], const Unit& u, int wr, int wc, int fr, int fq, int ui, bool has_next, const Unit& nxt, LAS unsigned char* lds, int tid) const {
        const int row0 = u.pm * 256 + wr * 64 + fr, col0 = u.pn * 256 + wc * 32 + 8 * fq;
        const int pmn = has_next ? nxt.pm : u.pm; const u64 na = ssA[pmn * 256 + (tid & 255)], nc = ssC[pmn * 256 + (tid & 255)];
#pragma unroll
        for (int ai = 0; ai < 2; ++ai) {
            v4u xw[4][2];
#pragma unroll
            for (int m = 0; m < 4; ++m)
#pragma unroll
                for (int bj = 0; bj < 2; ++bj) xw[m][bj] = *(const v4u*)(XB + (size_t)(row0 + ai * 128 + m * 16) * DM + col0 + bj * 128);
#pragma unroll
            for (int m = 0; m < 4; ++m) {
                const int row = row0 + ai * 128 + m * 16; float sa = 0.f;
#pragma unroll
                for (int bj = 0; bj < 2; ++bj) { const v4u w0 = xw[m][bj]; f32x4 xn[2];
                    const f32x4 xo[2] = {(f32x4){bflo(w0.x), bfhi(w0.x), bflo(w0.y), bfhi(w0.y)}, (f32x4){bflo(w0.z), bfhi(w0.z), bflo(w0.w), bfhi(w0.w)}};
#pragma unroll
                    for (int n = 0; n < 2; ++n) { xn[n] = xo[n] + acc[ai][bj][m][n]; const f32x4 sq = xn[n] * xn[n]; sa += (sq[0] + sq[1]) + (sq[2] + sq[3]); }
                    v4u w; w.x = pk2(xn[0][0], xn[0][1]); w.y = pk2(xn[0][2], xn[0][3]); w.z = pk2(xn[1][0], xn[1][1]); w.w = pk2(xn[1][2], xn[1][3]);
                    *(v4u*)(XB + (size_t)row * DM + col0 + bj * 128) = w; }
                sa += xshfl<16>(sa, 16 * fq + fr); sa += xshfl<32>(sa, 16 * fq + fr);
                if (fq == 0) atomicAdd(ssa + row, ss_fix(sa));
            }
        }
        ((LAS f32x2w*)(lds + ROWSC_OFF))[((ui + 1) & 1) * 256 + (tid & 255)] = conv(na, nc);
    }
};
struct EpiWin {
    static constexpr bool PERM = true, AFTER_DRAIN = false; static constexpr int KROT = 0;
    __device__ __forceinline__ void first(const Unit& u, LAS unsigned char* lds, int tid) const { u64 a, b2; rsc.issue(u.pm, tid, a, b2); rsc.commit(lds, 0, tid, a, b2); }
    bf16 *Q, *K, *V, *QH, *VH, *GH, *LFF, *LFB; bf16* UX; const float *qn, *kn, *lb; RowScale rsc;
    __device__ __forceinline__ void operator()(const f32x4 (&acc_)[2][2][4][2], const Unit& u, int wr, int wc, int fr, int fq, int ui, bool has_next, const Unit& nxt, LAS unsigned char* lds, int tid) const {
        const int row0 = u.pm * 256 + wr * 64 + fr, pn = u.pn, seg = pn >> 1;
        u64 na, nb; rsc.issue(has_next ? nxt.pm : u.pm, tid, na, nb);
        f32x4 acc[2][2][4][2];
#pragma unroll
        for (int ai = 0; ai < 2; ++ai)
#pragma unroll
            for (int m = 0; m < 4; ++m) { const float rs = rsc.get(lds, ui & 1, ai * 128 + wr * 64 + m * 16 + fr);
#pragma unroll
                for (int bj = 0; bj < 2; ++bj)
#pragma unroll
                    for (int n = 0; n < 2; ++n) acc[ai][bj][m][n] = acc_[ai][bj][m][n] * rs; }
        const int cbase = (pn & 1) * 256 + 64 * wc + 8 * fq;
        if (seg <= 1) {
            const float* gn = seg == 0 ? qn : kn; bf16* dst = seg == 0 ? Q : K;
            float gv[2][8];
#pragma unroll
            for (int bj = 0; bj < 2; ++bj) { const f32x4 a = *(const f32x4*)(gn + 32 * bj + 8 * fq), b = *(const f32x4*)(gn + 32 * bj + 8 * fq + 4);
                gv[bj][0] = a[0]; gv[bj][1] = a[1]; gv[bj][2] = a[2]; gv[bj][3] = a[3]; gv[bj][4] = b[0]; gv[bj][5] = b[1]; gv[bj][6] = b[2]; gv[bj][7] = b[3]; }
#pragma unroll
            for (int ai = 0; ai < 2; ++ai)
#pragma unroll
                for (int m = 0; m < 4; ++m) {
                    float ss = 0.f;
#pragma unroll
                    for (int bj = 0; bj < 2; ++bj)
#pragma unroll
                        for (int n = 0; n < 2; ++n) { const f32x4 x = acc[ai][bj][m][n]; ss += (x[0] * x[0] + x[1] * x[1]) + (x[2] * x[2] + x[3] * x[3]); }
                    ss += xshfl<16>(ss, 16 * fq + fr); ss += xshfl<32>(ss, 16 * fq + fr);
                    const float rstd = fast_rsq(ss * (1.0f / 64.0f) + EPS);
                    bf16* rowp = dst + (size_t)(row0 + ai * 128 + m * 16) * 512 + cbase;
#pragma unroll
                    for (int bj = 0; bj < 2; ++bj) { const f32x4 x0 = acc[ai][bj][m][0] * rstd, x1 = acc[ai][bj][m][1] * rstd; v4u w;
                        w.x = pk2(x0[0] * gv[bj][0], x0[1] * gv[bj][1]); w.y = pk2(x0[2] * gv[bj][2], x0[3] * gv[bj][3]); w.z = pk2(x1[0] * gv[bj][4], x1[1] * gv[bj][5]); w.w = pk2(x1[2] * gv[bj][6], x1[3] * gv[bj][7]);
                        *(v4u*)(rowp + 32 * bj) = w; }
                }
        } else if (seg == 2 || seg == 3 || seg == 6 || seg == 7) {
            bf16* dst = seg == 2 ? V : (seg == 3 ? QH : (seg == 6 ? VH : GH)); const bool act = (seg == 3 || seg == 7);
#pragma unroll
            for (int ai = 0; ai < 2; ++ai)
#pragma unroll
                for (int m = 0; m < 4; ++m) {
                    bf16* rowp = dst + (size_t)(row0 + ai * 128 + m * 16) * 512 + cbase;
#pragma unroll
                    for (int bj = 0; bj < 2; ++bj) { f32x4 x0 = acc[ai][bj][m][0], x1 = acc[ai][bj][m][1];
                        if (act) {
#pragma unroll
                            for (int i = 0; i < 4; ++i) { x0[i] = siluf_(x0[i]); x1[i] = siluf_(x1[i]); } }
                        v4u w; w.x = pk2(x0[0], x0[1]); w.y = pk2(x0[2], x0[3]); w.z = pk2(x1[0], x1[1]); w.w = pk2(x1[2], x1[3]);
                        *(v4u*)(rowp + 32 * bj) = w; }
                }
        } else if (seg == 4 || seg == 5) {
            bf16* dst = seg == 4 ? LFF : LFB; const float* lbp = lb + (seg - 4) * 512 + cbase;
            f32x4 lbv[2][2];
#pragma unroll
            for (int bj = 0; bj < 2; ++bj) { lbv[bj][0] = *(const f32x4*)(lbp + 32 * bj); lbv[bj][1] = *(const f32x4*)(lbp + 32 * bj + 4); }
#pragma unroll
            for (int ai = 0; ai < 2; ++ai)
#pragma unroll
                for (int m = 0; m < 4; ++m) {
                    bf16* rowp = dst + (size_t)(row0 + ai * 128 + m * 16) * 512 + cbase;
#pragma unroll
                    for (int bj = 0; bj < 2; ++bj) { float o[8];
#pragma unroll
                        for (int n = 0; n < 2; ++n)
#pragma unroll
                            for (int i = 0; i < 4; ++i) { const float l = lbv[bj][n][i]; o[4 * n + i] = 0.69314718056f * __builtin_amdgcn_logf(l + (1.0f - l) * sigmoidf_(acc[ai][bj][m][n][i])); }
                        v4u w; w.x = pk2(o[0], o[1]); w.y = pk2(o[2], o[3]); w.z = pk2(o[4], o[5]); w.w = pk2(o[6], o[7]);
                        *(v4u*)(rowp + 32 * bj) = w; }
                }
        } else {
#pragma unroll
            for (int ai = 0; ai < 2; ++ai)
#pragma unroll
                for (int m = 0; m < 4; ++m) {
                    const int row = row0 + ai * 128 + m * 16;
#pragma unroll
                    for (int bj = 0; bj < 2; ++bj) { const int g = (pn - 16) * 16 + 4 * wc + 2 * bj + (fq >> 1);
                        bf16* p = UX + ((size_t)g * 2048 + (row >> 4)) * 512 + (row & 15) * 16 + 8 * (fq & 1);
                        const f32x4 x0 = acc[ai][bj][m][0], x1 = acc[ai][bj][m][1];
                        v4u w; w.x = pk2(x0[0], x0[1]); w.y = pk2(x0[2], x0[3]); w.z = pk2(x1[0], x1[1]); w.w = pk2(x1[2], x1[3]);
                        *(v4u*)p = w; }
                }
        }
        rsc.commit(lds, (ui + 1) & 1, tid, na, nb);
    }
};
struct EpiGLU {
    static constexpr bool PERM = true, AFTER_DRAIN = false; static constexpr int KROT = 0;
    __device__ __forceinline__ void first(const Unit&, LAS unsigned char*, int) const {}
    const bf16* YPRE; const float* bias; bf16* CATC; u64* ssc;
    __device__ __forceinline__ void operator()(const f32x4 (&acc)[2][2][4][2], const Unit& u, int wr, int wc, int fr, int fq, int ui, bool has_next, const Unit& nxt, LAS unsigned char* lds, int tid) const {
        const int row0 = u.pm * 256 + wr * 64 + fr, col0 = u.pn * 256 + wc * 32 + 8 * fq;
        f32x4 bv[2][2];
#pragma unroll
        for (int bj = 0; bj < 2; ++bj) { bv[bj][0] = *(const f32x4*)(bias + col0 + bj * 128); bv[bj][1] = *(const f32x4*)(bias + col0 + bj * 128 + 4); }
#pragma unroll
        for (int ai = 0; ai < 2; ++ai) {
            v4u ypv[4][2];
#pragma unroll
            for (int m = 0; m < 4; ++m)
#pragma unroll
                for (int bj = 0; bj < 2; ++bj) ypv[m][bj] = *(const v4u*)(YPRE + (size_t)(row0 + ai * 128 + m * 16) * S5W + col0 + bj * 128);
#pragma unroll
            for (int m = 0; m < 4; ++m) {
                const int row = row0 + ai * 128 + m * 16; const size_t off = (size_t)row * DM + col0; float ss = 0.f;
#pragma unroll
                for (int bj = 0; bj < 2; ++bj) { const v4u yp = ypv[m][bj];
                    const f32x4 z0 = acc[ai][bj][m][0] + bv[bj][0], z1 = acc[ai][bj][m][1] + bv[bj][1];
                    const float y[8] = {bflo(yp.x) * sigmoidf_(z0[0]), bfhi(yp.x) * sigmoidf_(z0[1]), bflo(yp.y) * sigmoidf_(z0[2]), bfhi(yp.y) * sigmoidf_(z0[3]),
                                        bflo(yp.z) * sigmoidf_(z1[0]), bfhi(yp.z) * sigmoidf_(z1[1]), bflo(yp.w) * sigmoidf_(z1[2]), bfhi(yp.w) * sigmoidf_(z1[3])};
#pragma unroll
                    for (int e = 0; e < 8; ++e) ss += y[e] * y[e];
                    v4u w; w.x = pk2(y[0], y[1]); w.y = pk2(y[2], y[3]); w.z = pk2(y[4], y[5]); w.w = pk2(y[6], y[7]);
                    *(v4u*)(CATC + off + bj * 128) = w; }
                ss += xshfl<16>(ss, 16 * fq + fr); ss += xshfl<32>(ss, 16 * fq + fr);
                if (fq == 0) atomicAdd(ssc + row, ss_fix(ss));
            }
        }
    }
};

struct S5Order {
    int G, c;
    __device__ __forceinline__ bool next(int i, Unit& u) const {
        int g, rt;
        if (G == 256) { if (i >= 2) return false; const int x = c & 7, s = c >> 3; g = 32 * i + x * 4 + (s >> 3); rt = s & 7; }
        else { const int id = i * G + c; if (id >= 512) return false; g = id >> 3; rt = id & 7; }
        u.pm = g * 8 + rt; u.pn = g; return true;
    }
    __device__ __forceinline__ void a_ready(const Unit&) const {}
    __device__ __forceinline__ void done(const Unit&) const {}
};
struct EpiS5E {
    static constexpr bool PERM = false, AFTER_DRAIN = false; static constexpr int KROT = 0;
    __device__ __forceinline__ void first(const Unit&, LAS unsigned char*, int) const {}
    bf16* E;
    __device__ __forceinline__ void operator()(const f32x4 (&acc)[2][2][4][2], const Unit& u, int wr, int wc, int fr, int fq, int ui, bool has_next, const Unit& nxt, LAS unsigned char* lds, int tid) const {
        const int row0 = u.pm * 256 + wr * 64 + fr, col0 = wc * 32 + 4 * fq;
#pragma unroll
        for (int ai = 0; ai < 2; ++ai)
#pragma unroll
            for (int m = 0; m < 4; ++m) { bf16* rowp = E + (size_t)(row0 + ai * 128 + m * 16) * 256 + col0;
#pragma unroll
                for (int bj = 0; bj < 2; ++bj)
#pragma unroll
                    for (int n = 0; n < 2; ++n) { const f32x4 x = acc[ai][bj][m][n]; v2u w; w.x = pk2(x[0], x[1]); w.y = pk2(x[2], x[3]); *(v2u*)(rowp + bj * 128 + n * 16) = w; } }
    }
};
struct EpiS5Y {
    static constexpr bool PERM = true, AFTER_DRAIN = false; static constexpr int KROT = 0;
    __device__ __forceinline__ void first(const Unit&, LAS unsigned char*, int) const {}
    bf16* YPRE;
    __device__ __forceinline__ void operator()(const f32x4 (&acc)[2][2][4][2], const Unit& u, int wr, int wc, int fr, int fq, int ui, bool has_next, const Unit& nxt, LAS unsigned char* lds, int tid) const {
        const int g = u.pn, chunk0 = (u.pm & 7) * 256 + wr * 64 + fr;
#pragma unroll
        for (int ai = 0; ai < 2; ++ai)
#pragma unroll
            for (int m = 0; m < 4; ++m) { const int chunk = chunk0 + ai * 128 + m * 16;
#pragma unroll
                for (int bj = 0; bj < 2; ++bj) { const int tok = chunk * 16 + 8 * bj + 2 * wc + (fq >> 1);
                    const f32x4 x0 = acc[ai][bj][m][0], x1 = acc[ai][bj][m][1];
                    v4u w; w.x = pk2(gelu_tanh(x0[0]), gelu_tanh(x0[1])); w.y = pk2(gelu_tanh(x0[2]), gelu_tanh(x0[3])); w.z = pk2(gelu_tanh(x1[0]), gelu_tanh(x1[1])); w.w = pk2(gelu_tanh(x1[2]), gelu_tanh(x1[3]));
                    *(v4u*)(YPRE + (size_t)tok * S5W + g * 16 + 8 * (fq & 1)) = w; } }
    }
};

struct Frame {
    LAS unsigned char* lds;
    volatile LAS unsigned* MISC;
    int tid, lane, wave, G, gw, NGW, bid, zi;
    unsigned char* ws; float* X;
};
struct Args { const float* in[33]; int ph_lo, ph_hi, li, pad; };
#define WSP(T, off) ((T*)(F.ws + (off)))
__device__ __forceinline__ int fresh_lane() { unsigned z = 0u; asm volatile("" : "+v"(z)); return (int)__builtin_amdgcn_mbcnt_hi(~0u, __builtin_amdgcn_mbcnt_lo(~0u, z)); }
template <class T> __device__ __forceinline__ T* opaque_ptr(T* p) {
    unsigned long long w = (unsigned long long)p; unsigned lo = (unsigned)w, hi = (unsigned)(w >> 32);
    asm volatile("" : "+v"(lo), "+v"(hi));
    lo = (unsigned)__builtin_amdgcn_readfirstlane((int)lo); hi = (unsigned)__builtin_amdgcn_readfirstlane((int)hi);
    return (T*)(((unsigned long long)hi << 32) | lo);
}
#define FA Frame& F, const Args& A
#define AIN(k) (A.in[(k) + F.zi])

__device__ __forceinline__ void conv_item(const float* W, int Nsrc, int K, int src_col0, bf16* WT, int dst_row0, int k0, LAS float* scr, int lane, const float* ga = nullptr, const float* gb = nullptr) {
    float wv[32];
#pragma unroll
    for (int i = 0; i < 32; ++i) { const int kk = 2 * i + (lane >> 5); wv[i] = __builtin_nontemporal_load(W + (size_t)(k0 + kk) * Nsrc + src_col0 + (lane & 31)); }
    const int c = lane & 7;
    f32x4 g0 = (f32x4){1.f, 1.f, 1.f, 1.f}, g1 = g0;
    if (ga) { g0 = *(const f32x4*)(ga + k0 + 8 * c); g1 = *(const f32x4*)(ga + k0 + 8 * c + 4); if (gb) { g0 = g0 * *(const f32x4*)(gb + k0 + 8 * c); g1 = g1 * *(const f32x4*)(gb + k0 + 8 * c + 4); } }
#pragma unroll
    for (int i = 0; i < 32; ++i) { const int kk = 2 * i + (lane >> 5); scr[kk * 33 + (lane & 31)] = wv[i]; }
    LDS_WAIT(); asm volatile("" ::: "memory");
#pragma unroll
    for (int j = 0; j < 4; ++j) { const int n = (lane >> 3) + 8 * j; const LAS float* s = scr + (8 * c) * 33 + n;
        v4u o; o.x = pk2(s[0 * 33] * g0[0], s[1 * 33] * g0[1]); o.y = pk2(s[2 * 33] * g0[2], s[3 * 33] * g0[3]); o.z = pk2(s[4 * 33] * g1[0], s[5 * 33] * g1[1]); o.w = pk2(s[6 * 33] * g1[2], s[7 * 33] * g1[3]);
        *(GAS v4u*)(WT + (size_t)(dst_row0 + n) * K + k0 + 8 * c) = o; }
    LDS_WAIT(); asm volatile("" ::: "memory");
}
__device__ __forceinline__ void conv_layer(FA, int l) {
    LAS float* scr = (LAS float*)(F.lds + RING_OFF + F.wave * 16384);
    constexpr int I_GU = 32 * 352, I_D = 88 * 64, I_IN = 32 * 160, I_GLU = 16 * 32, I_OUT = 32 * 64;
    constexpr int NITEMS = 2 * I_GU + 2 * I_D + I_IN + I_GLU + I_OUT;
    const size_t wff = (size_t)DM * FF;
    for (int it = F.gw; it < NITEMS; it += F.NGW) {
        int r = it;
        if (r < 2 * I_GU) { const int second = r >= I_GU; if (second) r -= I_GU;
            const int kb = r / 352, nbd = r % 352, tile = nbd >> 3, pb = nbd & 7, bj = pb >> 2, sub = pb & 3;
            const float* W = AIN(second ? (bj ? 28 : 27) : (bj ? 4 : 3)) + (size_t)l * wff;
            conv_item(W, FF, DM, 128 * tile + 32 * sub, WSP(bf16, second ? WS_WGU2 : WS_WGU1), 32 * nbd, 64 * kb, scr, F.lane, AIN(second ? 26 : 2) + l * DM, (!second && l > 0) ? AIN(30) + (l - 1) * DM : nullptr); continue; }
        r -= 2 * I_GU;
        if (r < 2 * I_D) { const int second = r >= I_D; if (second) r -= I_D;
            const int kb = r / 64, nbd = r % 64;
            conv_item(AIN(second ? 29 : 5) + (size_t)l * wff, DM, FF, 32 * nbd, WSP(bf16, second ? WS_WD2 : WS_WD1), 32 * nbd, 64 * kb, scr, F.lane); continue; }
        r -= 2 * I_D;
        if (r < I_IN) { const int kb = r / 160, nbd = r % 160, tile = nbd >> 3, pb = nbd & 7, bj = pb >> 2, wc = pb & 3;
            conv_item(AIN(7) + (size_t)l * DM * INC, INC, DM, 256 * tile + 32 * (2 * wc + bj), WSP(bf16, WS_WIN), 32 * nbd, 64 * kb, scr, F.lane, AIN(6) + l * DM); continue; }
        r -= I_IN;
        if (r < I_GLU) { const int kb = r / 32, nbd = r % 32;
            conv_item(AIN(22) + (size_t)l * S5W * S5W, S5W, S5W, 32 * nbd, WSP(bf16, WS_WGLU), 32 * nbd, 64 * kb, scr, F.lane); continue; }
        r -= I_GLU;
        { const int kb = r / 64, nbd = r % 64;
            const int k0 = 64 * kb;
            conv_item(AIN(25) + (size_t)l * DM * DM, DM, DM, 32 * nbd, WSP(bf16, WS_WOUT), 32 * nbd, k0, scr, F.lane, k0 < 512 ? AIN(11) + l * 512 : (k0 < 1024 ? nullptr : AIN(24) + l * 1024 - 1024)); }
    }
}
__device__ __forceinline__ void lb_table(FA) {
    float* LB = WSP(float, WS_TAB); const float* lg = AIN(12);
    for (int i = blockIdx.x * 512 + F.tid; i < 1024; i += F.G * 512) {
        float v[NL], mx = -1e30f;
#pragma unroll
        for (int l = 0; l < NL; ++l) { v[l] = lg[l * 1024 + i]; mx = fmaxf(mx, v[l]); }
        float s = 0.f;
#pragma unroll
        for (int l = 0; l < NL; ++l) { v[l] = expf(v[l] - mx); s += v[l]; }
        float c = 0.f;
#pragma unroll
        for (int l = 0; l < NL; ++l) { if (l > 0) c += v[l] / s; LB[l * 1024 + i] = c; }
    }
}
__device__ __forceinline__ const float* in_row(FA, int r) { return r < MPROMPT ? AIN(0) + (size_t)r * DM : AIN(1) + (size_t)(r - MPROMPT) * DM; }
__device__ __forceinline__ void prep_phase(FA) {
    bf16* XB = WSP(bf16, WS_XB); u64* SS0 = WSP(u64, WS_SS);
    for (int r = F.gw; r < MTOK; r += F.NGW) {
        const f32x4* xr = (const f32x4*)in_row(F, A, r) + F.lane; f32x4 v[8]; float s = 0.f;
#pragma unroll
        for (int j = 0; j < 8; ++j) { v[j] = __builtin_nontemporal_load(xr + 64 * j); s += (v[j][0] * v[j][0] + v[j][1] * v[j][1]) + (v[j][2] * v[j][2] + v[j][3] * v[j][3]); }
        s = wave_sum(s, F.lane); if (F.lane == 0) SS0[r] = ss_fix(s);
        v2u* o = (v2u*)(XB + (size_t)r * DM) + F.lane;
#pragma unroll
        for (int j = 0; j < 8; ++j) { v2u w; w.x = pk2(v[j][0], v[j][1]); w.y = pk2(v[j][2], v[j][3]); o[64 * j] = w; }
    }
}
__device__ __forceinline__ void out_norm_phase(FA, const u64* ss, const float* g) {
    const bf16* XB = WSP(bf16, WS_XB);
    for (int r = F.gw; r < MTOK; r += F.NGW) {
        f32x4* xr = (f32x4*)(F.X + (size_t)r * DM) + F.lane; const f32x4* gp = (const f32x4*)g + F.lane; const v2u* xb = (const v2u*)(XB + (size_t)r * DM) + F.lane;
        const float rstd = fast_rsq(ss_val(ss[r]) * (1.0f / DM) + EPS);
        v2u w[8];
#pragma unroll
        for (int j = 0; j < 8; ++j) w[j] = xb[64 * j];
#pragma unroll
        for (int j = 0; j < 8; ++j) __builtin_nontemporal_store((f32x4){bflo(w[j].x), bfhi(w[j].x), bflo(w[j].y), bfhi(w[j].y)} * rstd * gp[64 * j], xr + 64 * j);
    }
}
__device__ __forceinline__ void seq_of_row(int r, int& base, int& t, int& rows) {
    if (r < MPROMPT) { base = r & ~(TP - 1); t = r & (TP - 1); rows = TP / 64; } else { const int q = r - MPROMPT; base = MPROMPT + (q & ~(TS - 1)); t = q & (TS - 1); rows = TS / 64; }
}
__device__ __forceinline__ void seq_of_index(int s, int& base, int& T) { if (s < 8) { base = s * TP; T = TP; } else { base = MPROMPT + (s - 8) * TS; T = TS; } }

struct S5Par { float dre, ang, fre, fim; };
__device__ __forceinline__ S5Par s5_par(FA, int l, int dir, int g, int p) {
    const int pi = ((l * 2 + dir) * 64 + g) * 64 + p;
    const float are = AIN(14)[pi], aim = AIN(15)[pi], dt = expf(AIN(16)[(l * 2 + dir) * 64 + g]);
    const float mag = __expf(dt * are), ang = dt * aim; float sn_, cs_; fast_sincos(ang, sn_, cs_); const float abr = mag * cs_, abi = mag * sn_;
    const float den = are * are + aim * aim, nr = abr - 1.0f;
    S5Par r; r.dre = dt * are; r.ang = ang; r.fre = (nr * are + abi * aim) / den; r.fim = (abi * are - nr * aim) / den; return r;
}
__device__ __forceinline__ void s5_pow(const S5Par& q, float e, float& pr, float& pim) { const float m = __expf(e * q.dre); float s, c; fast_sincos(e * q.ang, s, c); pr = m * c; pim = m * s; }
__device__ __forceinline__ void s5_ops(FA, int l) {
    bf16* BE = WSP(bf16, WS_S5E); bf16* BY = WSP(bf16, WS_S5Y); const int lane = F.lane;
    for (int task = F.gw; task < 64 * 16 * 2; task += F.NGW) {
        const int chalf = task & 1, g = task >> 5, tau = (task >> 1) & 15; float kf[4] = {0.f, 0.f, 0.f, 0.f}, kb[4] = {0.f, 0.f, 0.f, 0.f};
#pragma unroll 1
        for (int dir = 0; dir < 2; ++dir) {
            const S5Par q = s5_par(F, A, l, dir, g, lane); float pr, pim; s5_pow(q, (float)tau, pr, pim);
            const size_t pi = (size_t)(((l * 2 + dir) * 64 + g) * 64 + lane);
            float wr_[16], wi_[16];
#pragma unroll
            for (int c = 0; c < 16; ++c) { const float br = AIN(17)[pi * 16 + c], bi = AIN(18)[pi * 16 + c]; const float bbr = q.fre * br - q.fim * bi, bbi = q.fre * bi + q.fim * br;
                wr_[c] = pr * bbr - pim * bbi; wi_[c] = pr * bbi + pim * bbr; }
#pragma unroll 1
            for (int c = 8 * chalf; c < 8 * chalf + 8; ++c) { const size_t ci = ((size_t)((l * 2 + dir) * 64 + g) * 16 + c) * 64 + lane; const float cr = AIN(19)[ci], cim = AIN(20)[ci];
#pragma unroll
                for (int cp = 0; cp < 16; ++cp) { const float v = wave_sum(cr * wr_[cp] - cim * wi_[cp], lane);
                    if (lane == c * 4 + (cp >> 2)) { if (dir == 0) kf[cp & 3] = v; else kb[cp & 3] = v; } } }
        }
        const int c = lane >> 2, cp0 = 4 * (lane & 3);
        if ((c >> 3) != chalf) continue;
        if (tau == 0) {
            float v[4];
#pragma unroll
            for (int j = 0; j < 4; ++j) v[j] = kf[j] + kb[j] + ((cp0 + j == c) ? AIN(21)[l * 1024 + g * 16 + c] : 0.f);
            for (int i = 0; i < 16; ++i) { v2u w; w.x = pk2(v[0], v[1]); w.y = pk2(v[2], v[3]); *(v2u*)(BY + ((size_t)g * 256 + i * 16 + c) * 512 + i * 16 + cp0) = w; }
        } else {
            v2u wf, wb; wf.x = pk2(kf[0], kf[1]); wf.y = pk2(kf[2], kf[3]); wb.x = pk2(kb[0], kb[1]); wb.y = pk2(kb[2], kb[3]);
            for (int s = 0; s + tau < 16; ++s) { const int i = s + tau;
                *(v2u*)(BY + ((size_t)g * 256 + i * 16 + c) * 512 + s * 16 + cp0) = wf;
                *(v2u*)(BY + ((size_t)g * 256 + s * 16 + c) * 512 + i * 16 + cp0) = wb; }
        }
    }
    const int gt = F.bid * 512 + F.tid, ngt = F.G * 512;
    for (int t = gt; t < 64 * 16 * 16 * 2 * 8; t += ngt) {
        const int po = t & 7, dir = (t >> 3) & 1, c = (t >> 4) & 15, i = (t >> 8) & 15, g = t >> 12; const float e = dir ? (float)(16 - i) : (float)(i + 1);
        float re[8], im[8];
#pragma unroll
        for (int j = 0; j < 8; ++j) { const int p = po * 8 + j; const S5Par q = s5_par(F, A, l, dir, g, p); float pr, pim; s5_pow(q, e, pr, pim);
            const size_t ci = ((size_t)((l * 2 + dir) * 64 + g) * 16 + c) * 64 + p; const float cr = AIN(19)[ci], cim = AIN(20)[ci];
            re[j] = cr * pr - cim * pim; im[j] = -(cr * pim + cim * pr); }
        bf16* row = BY + ((size_t)g * 256 + i * 16 + c) * 512 + 256 + dir * 128 + po * 8;
        v4u w; w.x = pk2(re[0], re[1]); w.y = pk2(re[2], re[3]); w.z = pk2(re[4], re[5]); w.w = pk2(re[6], re[7]); *(v4u*)row = w;
        w.x = pk2(im[0], im[1]); w.y = pk2(im[2], im[3]); w.z = pk2(im[4], im[5]); w.w = pk2(im[6], im[7]); *(v4u*)(row + 64) = w;
    }
    for (int t = gt; t < 64 * 2 * 64 * 16; t += ngt) {
        const int s = t & 15, p = (t >> 4) & 63, dir = (t >> 10) & 1, g = t >> 11; const float e = dir ? (float)s : (float)(15 - s);
        const S5Par q = s5_par(F, A, l, dir, g, p); float pr, pim; s5_pow(q, e, pr, pim);
        const size_t pi = (size_t)(((l * 2 + dir) * 64 + g) * 64 + p); float re[16], im[16];
#pragma unroll
        for (int c = 0; c < 16; ++c) { const float br = AIN(17)[pi * 16 + c], bi = AIN(18)[pi * 16 + c]; const float bbr = q.fre * br - q.fim * bi, bbi = q.fre * bi + q.fim * br;
            re[c] = pr * bbr - pim * bbi; im[c] = pr * bbi + pim * bbr; }
        bf16* rr = BE + ((size_t)g * 256 + dir * 128 + p) * 256 + s * 16; bf16* ri = rr + 64 * 256;
        v4u w; w.x = pk2(re[0], re[1]); w.y = pk2(re[2], re[3]); w.z = pk2(re[4], re[5]); w.w = pk2(re[6], re[7]); *(v4u*)rr = w;
        w.x = pk2(re[8], re[9]); w.y = pk2(re[10], re[11]); w.z = pk2(re[12], re[13]); w.w = pk2(re[14], re[15]); *(v4u*)(rr + 8) = w;
        w.x = pk2(im[0], im[1]); w.y = pk2(im[2], im[3]); w.z = pk2(im[4], im[5]); w.w = pk2(im[6], im[7]); *(v4u*)ri = w;
        w.x = pk2(im[8], im[9]); w.y = pk2(im[10], im[11]); w.z = pk2(im[12], im[13]); w.w = pk2(im[14], im[15]); *(v4u*)(ri + 8) = w;
    }
}
__device__ __forceinline__ void s5_carry(FA, int l, int w0, int nw) {
    const bf16* E = WSP(bf16, WS_E); bf16* UX = WSP(bf16, WS_UX); const int lane = F.lane, lg = lane >> 4, lp = lane & 15;
    LAS unsigned char* buf = F.lds + RING_OFF + F.wave * 16384;
    for (int task = w0; task < 12 * 64 * 2; task += nw) {
        const int dir = task & 1, g = (task >> 1) & 63, s = task >> 7; int base, T; seq_of_index(s, base, T);
        const int c0 = base >> 4, nch = T >> 4, nb = nch >> 6;
        const S5Par q = s5_par(F, A, l, dir, g, lane); float ar, ai; s5_pow(q, 16.0f, ar, ai);
        const bf16* Eb = E + ((size_t)g * 2048 + c0) * 256 + dir * 128; bf16* Ub = UX + ((size_t)g * 2048 + c0) * 512 + 256 + dir * 128;
        float xr = 0.f, xi = 0.f;
        v4u ld[16];
#pragma unroll
        for (int i = 0; i < 16; ++i) { const int n = 4 * i + lg, cn = dir ? nch - 1 - n : n; ld[i] = *(const v4u*)(Eb + (unsigned)(cn * 256 + 8 * lp)); }
#pragma unroll 1
        for (int b = 0; b < nb; ++b) {
#pragma unroll
            for (int i = 0; i < 16; ++i) *(LAS v4u*)(buf + (4 * i + lg) * 256 + 16 * lp) = ld[i];
            asm volatile("" ::: "memory");
            { const int bn = b + 1 < nb ? b + 1 : b;
#pragma unroll
                for (int i = 0; i < 16; ++i) { const int n = 64 * bn + 4 * i + lg, cn = dir ? nch - 1 - n : n; ld[i] = *(const v4u*)(Eb + (unsigned)(cn * 256 + 8 * lp)); } }
#pragma unroll 1
            for (int j0 = 0; j0 < 64; j0 += 8) {
                LAS unsigned short* row = (LAS unsigned short*)(buf + j0 * 256) + lane; unsigned short rr[8], ri[8];
#pragma unroll
                for (int j = 0; j < 8; ++j) { rr[j] = row[j * 128]; ri[j] = row[j * 128 + 64]; }
#pragma unroll
                for (int j = 0; j < 8; ++j) { const unsigned xo = pk2(xr, xi); row[j * 128] = (unsigned short)xo; row[j * 128 + 64] = (unsigned short)(xo >> 16);
                    const float er = bf2f(rr[j]), ei = bf2f(ri[j]); const float nr = ar * xr - ai * xi + er, ni = ar * xi + ai * xr + ei; xr = nr; xi = ni; }
            }
            asm volatile("" ::: "memory");
            v4u xo[16];
#pragma unroll
            for (int i = 0; i < 16; ++i) xo[i] = *(const LAS v4u*)(buf + (4 * i + lg) * 256 + 16 * lp);
#pragma unroll
            for (int i = 0; i < 16; ++i) { const int n = 64 * b + 4 * i + lg, cn = dir ? nch - 1 - n : n; *(v4u*)(Ub + (unsigned)(cn * 512 + 8 * lp)) = xo[i]; }
        }
    }
}
typedef short s16x4 __attribute__((ext_vector_type(4)));
__device__ __forceinline__ unsigned hoff(unsigned row, unsigned ch) { return 256u * row + 16u * (ch ^ (((row & 3u) << 2) | ((row >> 2) & 3u))); }
__device__ __forceinline__ s16x4 tr_read(const LAS unsigned char* p) { return __builtin_bit_cast(s16x4, __builtin_amdgcn_ds_read_tr16_b64_v4i16((LAS s16x4*)p)); }
__device__ __forceinline__ bf16x8 tr_frag(const LAS unsigned char* tile, int lane, int c, int rowbase0, int rowbase1) {
    const unsigned g = lane >> 4, q = (lane & 15) >> 2, p = lane & 3;
    const s16x4 a = tr_read(tile + hoff(rowbase0 + 4 * g + q, 2 * c + (p >> 1)) + 8 * (p & 1)), b = tr_read(tile + hoff(rowbase1 + 4 * g + q, 2 * c + (p >> 1)) + 8 * (p & 1));
    bf16x8 r; r[0] = a[0]; r[1] = a[1]; r[2] = a[2]; r[3] = a[3]; r[4] = b[0]; r[5] = b[1]; r[6] = b[2]; r[7] = b[3]; return r;
}
__device__ __forceinline__ void lds8(const LAS float* p, float (&v)[8]) { const f32x4 a = *(const LAS f32x4*)p, b = *(const LAS f32x4*)(p + 4); v[0] = a[0]; v[1] = a[1]; v[2] = a[2]; v[3] = a[3]; v[4] = b[0]; v[5] = b[1]; v[6] = b[2]; v[7] = b[3]; }
constexpr int HG_BST = 136;
constexpr int HG_BF_OFF = 0, HG_BB_OFF = 64 * HG_BST * 4, HG_V_OFF = 2 * 64 * HG_BST * 4, HG_Q_OFF = HG_V_OFF + 16384, HG_K2_OFF = HG_Q_OFF;
constexpr int HG_OST = 132;
static_assert(2 * 64 * HG_OST * 4 <= HG_V_OFF && HG_K2_OFF + 2 * 16384 <= RING_BYTES, "HGRN2 LDS map");
struct HgTiles { v4u lw[4]; v4u tv[2], tq[2]; };
__device__ __forceinline__ void hg_issue(Frame& F, HgTiles& T, const bf16* LFF, const bf16* LFB, const bf16* VH, const bf16* QH, int cu) {
    const int head = cu & 3, cg = cu >> 2;
    const unsigned lt = (unsigned)((F.tid >> 4) * 512 + 8 * (F.tid & 15));
#pragma unroll
    for (int i = 0; i < 2; ++i) { const size_t go = (size_t)(64 * cg + 32 * i) * 512 + head * 128;
        T.lw[i] = *(const v4u*)(LFF + go + lt); T.lw[2 + i] = *(const v4u*)(LFB + go + lt);
        T.tv[i] = *(const v4u*)(VH + go + lt); if (QH) T.tq[i] = *(const v4u*)(QH + go + lt); }
}
__device__ __forceinline__ void hg_commit_scan(Frame& F, const HgTiles& T, bool hasq) {
#pragma unroll
    for (int i = 0; i < 2; ++i) { const int idx = F.tid + 512 * i, p = idx >> 4, ch = idx & 15;
#pragma unroll
        for (int dir = 0; dir < 2; ++dir) { const v4u w = T.lw[2 * dir + i]; LAS float* bp = (LAS float*)(F.lds + (dir ? HG_BB_OFF : HG_BF_OFF)) + p * HG_BST + 8 * ch;
            *(LAS f32x4*)bp = (f32x4){bflo(w.x), bfhi(w.x), bflo(w.y), bfhi(w.y)}; *(LAS f32x4*)(bp + 4) = (f32x4){bflo(w.z), bfhi(w.z), bflo(w.w), bfhi(w.w)}; }
        *(LAS v4u*)(F.lds + HG_V_OFF + hoff(p, ch)) = T.tv[i]; if (hasq) *(LAS v4u*)(F.lds + HG_Q_OFF + hoff(p, ch)) = T.tq[i]; }
    __syncthreads();
    if (F.tid < 128) { LAS float* bt = (LAS float*)(F.lds + HG_BF_OFF) + F.tid; float a = 0.f;
#pragma unroll 1
        for (int j0 = 0; j0 < 64; j0 += 8) { float v[8];
#pragma unroll
            for (int k = 0; k < 8; ++k) v[k] = bt[(j0 + k) * HG_BST];
#pragma unroll
            for (int k = 0; k < 8; ++k) { a += v[k]; bt[(j0 + k) * HG_BST] = a; } } }
    else if (F.tid < 256) { LAS float* bt = (LAS float*)(F.lds + HG_BB_OFF) + (F.tid - 128); float a = 0.f;
#pragma unroll 1
        for (int j0 = 0; j0 < 64; j0 += 8) { float v[8];
#pragma unroll
            for (int k = 0; k < 8; ++k) v[k] = bt[(63 - j0 - k) * HG_BST];
#pragma unroll
            for (int k = 0; k < 8; ++k) { a += v[k]; bt[(63 - j0 - k) * HG_BST] = a; } } }
    __syncthreads();
}
__device__ __forceinline__ void hg_phase_a(FA) {
    const bf16* LFF = WSP(bf16, WS_LFF); const bf16* LFB = WSP(bf16, WS_LFB); const bf16* VH = WSP(bf16, WS_VH); bf16* LT = WSP(bf16, WS_LT); float* HD = WSP(float, WS_HD);
    const int lane = F.lane, w = F.wave, g = lane >> 4, wdir = w >> 2, wq = w & 3;
    HgTiles T; if (F.bid < 2048) hg_issue(F, T, LFF, LFB, VH, nullptr, F.bid);
    for (int cu = F.bid; cu < 2048; cu += F.G) {
        hg_commit_scan(F, T, false);
        if (cu + F.G < 2048) hg_issue(F, T, LFF, LFB, VH, nullptr, cu + F.G);
#pragma unroll
        for (int i = 0; i < 4; ++i) { const int idx = F.tid + 512 * i, dir = idx >> 10, p = (idx >> 4) & 63, ch = idx & 15;
            const LAS float* bt = (const LAS float*)(F.lds + (dir ? HG_BB_OFF : HG_BF_OFF)); const LAS float* bj = bt + p * HG_BST + 8 * ch; const LAS float* bl = bt + (dir ? 0 : 63) * HG_BST + 8 * ch;
            const bool edge = dir ? (p == 63) : (p == 0); const int pst = edge ? 0 : (dir ? HG_BST : -HG_BST);
            float kt[8], vb[8], vp[8], vl[8]; lds8(bj, vb); lds8(bj + pst, vp); lds8(bl, vl);
#pragma unroll
            for (int e = 0; e < 8; ++e) { const float bb = vb[e], bp = edge ? 0.f : vp[e]; kt[e] = (1.0f - __expf(bb - bp)) * __expf(vl[e] - bb); }
            v4u o; o.x = pk2(kt[0], kt[1]); o.y = pk2(kt[2], kt[3]); o.z = pk2(kt[4], kt[5]); o.w = pk2(kt[6], kt[7]);
            *(LAS v4u*)(F.lds + HG_K2_OFF + dir * 16384 + hoff(p, ch)) = o; }
        if (F.tid < 256) { const int dir = F.tid >> 7, d = F.tid & 127; HD[(size_t)((cu * 2) + dir) * 128 + d] = __expf(((const LAS float*)(F.lds + (dir ? HG_BB_OFF : HG_BF_OFF)))[(dir ? 0 : 63) * HG_BST + d]); }
        __syncthreads();
        f32x4 acc[2][8];
#pragma unroll
        for (int mb = 0; mb < 2; ++mb)
#pragma unroll
            for (int c = 0; c < 8; ++c) acc[mb][c] = (f32x4){0.f, 0.f, 0.f, 0.f};
#pragma unroll
        for (int ks = 0; ks < 2; ++ks) {
            bf16x8 a[2];
#pragma unroll
            for (int mb = 0; mb < 2; ++mb) a[mb] = tr_frag(F.lds + HG_K2_OFF + wdir * 16384, lane, 2 * wq + mb, 32 * ks, 32 * ks + 16);
#pragma unroll
            for (int c = 0; c < 8; ++c) { const bf16x8 bv = tr_frag(F.lds + HG_V_OFF, lane, c, 32 * ks, 32 * ks + 16);
#pragma unroll
                for (int mb = 0; mb < 2; ++mb) acc[mb][c] = __builtin_amdgcn_mfma_f32_16x16x32_bf16(a[mb], bv, acc[mb][c], 0, 0, 0); } }
        bf16* lt = LT + (size_t)(cu * 2 + wdir) * 16384;
#pragma unroll
        for (int mb = 0; mb < 2; ++mb)
#pragma unroll
            for (int c = 0; c < 8; ++c) { v2u o; o.x = pk2(acc[mb][c][0], acc[mb][c][1]); o.y = pk2(acc[mb][c][2], acc[mb][c][3]);
                { const int mbg = 2 * wq + mb, ksq = mbg >> 1, gp = 2 * (mbg & 1) + (g >> 1); *(v2u*)(lt + (size_t)((c * 4 + ksq) * 64 + gp * 16 + (lane & 15)) * 8 + 4 * (g & 1)) = o; } }
        __syncthreads();
    }
}
__device__ __forceinline__ void hg_phase_b(FA) {
    const bf16* LT = WSP(bf16, WS_LT); const float* HD = WSP(float, WS_HD); bf16* SIN = WSP(bf16, WS_SIN); const int lane = F.lane;
    for (int tk = F.gw; tk < 3072; tk += F.NGW) {
        int idx, smp; if (tk < 1024) { idx = tk; smp = 0; } else if (tk < 2048) { idx = tk - 1024; smp = 1; } else { idx = tk - 1024; smp = 0; }
        const int eg = idx & 31, dir = (idx >> 5) & 1, head = (idx >> 6) & 3, sq = idx >> 8;
        const int c0 = smp ? (MPROMPT / 64) + sq * (TS / 64) : sq * (TP / 64), nch = smp ? TS / 64 : TP / 64;
        const int e0 = eg * 512 + lane * 8, d0 = 32 * (eg & 3) + 8 * (lane >> 4);
        float S[8];
#pragma unroll
        for (int e = 0; e < 8; ++e) S[e] = 0.f;
        v4u l4[4]; f32x4 da[4], db[4];
#pragma unroll
        for (int i = 0; i < 4; ++i) { const int cg = c0 + (dir ? nch - 1 - i : i); const size_t u = (size_t)((cg * 4 + head) * 2 + dir);
            l4[i] = *(const v4u*)(LT + u * 16384 + e0); da[i] = *(const f32x4*)(HD + u * 128 + d0); db[i] = *(const f32x4*)(HD + u * 128 + d0 + 4); }
        for (int n0 = 0; n0 < nch; n0 += 4) {
            v4u m4[4]; f32x4 ea[4], eb[4]; const int n1 = n0 + 4 < nch ? n0 + 4 : n0;
#pragma unroll
            for (int i = 0; i < 4; ++i) { const int cg = c0 + (dir ? nch - 1 - (n1 + i) : n1 + i); const size_t u = (size_t)((cg * 4 + head) * 2 + dir);
                m4[i] = *(const v4u*)(LT + u * 16384 + e0); ea[i] = *(const f32x4*)(HD + u * 128 + d0); eb[i] = *(const f32x4*)(HD + u * 128 + d0 + 4); }
#pragma unroll
            for (int i = 0; i < 4; ++i) { const int cg = c0 + (dir ? nch - 1 - (n0 + i) : n0 + i); const size_t u = (size_t)((cg * 4 + head) * 2 + dir);
                v4u o; o.x = pk2(S[0], S[1]); o.y = pk2(S[2], S[3]); o.z = pk2(S[4], S[5]); o.w = pk2(S[6], S[7]); *(v4u*)(SIN + u * 16384 + e0) = o;
                S[0] = da[i][0] * S[0] + bflo(l4[i].x); S[1] = da[i][1] * S[1] + bfhi(l4[i].x); S[2] = da[i][2] * S[2] + bflo(l4[i].y); S[3] = da[i][3] * S[3] + bfhi(l4[i].y);
                S[4] = db[i][0] * S[4] + bflo(l4[i].z); S[5] = db[i][1] * S[5] + bfhi(l4[i].z); S[6] = db[i][2] * S[6] + bflo(l4[i].w); S[7] = db[i][3] * S[7] + bfhi(l4[i].w); }
#pragma unroll
            for (int i = 0; i < 4; ++i) { l4[i] = m4[i]; da[i] = ea[i]; db[i] = eb[i]; }
        }
    }
}
__device__ __forceinline__ void hg_phase_c(FA, const float* gnorm) {
    const bf16* LFF = WSP(bf16, WS_LFF); const bf16* LFB = WSP(bf16, WS_LFB); const bf16* VH = WSP(bf16, WS_VH); const bf16* QH = WSP(bf16, WS_QH); const bf16* SIN = WSP(bf16, WS_SIN);
    const bf16* GH = WSP(bf16, WS_GH); bf16* CAT = WSP(bf16, WS_CAT);
    const int lane = F.lane, w = F.wave, g = lane >> 4, tl = lane & 15, dir = w >> 2, PI = w & 3;
    const LAS float* bt = (const LAS float*)(F.lds + (dir ? HG_BB_OFF : HG_BF_OFF));
    const int pst = dir ? HG_BST : -HG_BST;
    const bool hasref = dir ? (PI < 3) : (PI > 0); const int refrow = hasref ? (dir ? 16 * PI + 16 : 16 * PI - 1) : 0;
    HgTiles T; if (F.bid < 2048) hg_issue(F, T, LFF, LFB, VH, QH, F.bid);
    for (int cu = F.bid; cu < 2048; cu += F.G) {
        const int head = cu & 3, cg = cu >> 2;
        const bf16* st = SIN + (size_t)(cu * 2 + dir) * 16384;
        bf16x8 sb[2][4];
#pragma unroll
        for (int c = 0; c < 2; ++c)
#pragma unroll
            for (int ks = 0; ks < 4; ++ks) sb[c][ks] = *(const bf16x8*)(st + (size_t)((c * 4 + ks) * 64 + lane) * 8);
        hg_commit_scan(F, T, true);
        const int p = 16 * PI + tl;
        bf16x8 qt[4], qh[4]; f32x4 acc[8];
#pragma unroll
        for (int c = 0; c < 8; ++c) acc[c] = (f32x4){0.f, 0.f, 0.f, 0.f};
#pragma unroll
        for (int ks = 0; ks < 4; ++ks) { const int d0 = 32 * ks + 8 * g; const LAS float* bj = bt + p * HG_BST + d0; const LAS float* br = bt + refrow * HG_BST + d0;
            const v4u q4 = *(const LAS v4u*)(F.lds + HG_Q_OFF + hoff(p, 4 * ks + g)); const float qv[8] = {bflo(q4.x), bfhi(q4.x), bflo(q4.y), bfhi(q4.y), bflo(q4.z), bfhi(q4.z), bflo(q4.w), bfhi(q4.w)};
            float a[8], h[8], vb[8], vr[8]; lds8(bj, vb); lds8(br, vr);
#pragma unroll
            for (int e = 0; e < 8; ++e) { const float bb = vb[e], rr = hasref ? vr[e] : 0.f; a[e] = qv[e] * __expf(bb); h[e] = qv[e] * __expf(bb - rr); }
            v4u o; o.x = pk2(a[0], a[1]); o.y = pk2(a[2], a[3]); o.z = pk2(a[4], a[5]); o.w = pk2(a[6], a[7]); qt[ks] = __builtin_bit_cast(bf16x8, o);
            o.x = pk2(h[0], h[1]); o.y = pk2(h[2], h[3]); o.z = pk2(h[4], h[5]); o.w = pk2(h[6], h[7]); qh[ks] = __builtin_bit_cast(bf16x8, o); }
#pragma unroll
        for (int cb = 0; cb < 4; ++cb) {
            bf16x8 sn[2][4];
            if (cb < 3) {
#pragma unroll
                for (int c = 0; c < 2; ++c)
#pragma unroll
                    for (int ks = 0; ks < 4; ++ks) sn[c][ks] = *(const bf16x8*)(st + (size_t)(((2 * cb + 2 + c) * 4 + ks) * 64 + lane) * 8); }
#pragma unroll
            for (int c = 0; c < 2; ++c)
#pragma unroll
                for (int ks = 0; ks < 4; ++ks) acc[2 * cb + c] = __builtin_amdgcn_mfma_f32_16x16x32_bf16(qt[ks], sb[c][ks], acc[2 * cb + c], 0, 0, 0);
            if (cb < 3) {
#pragma unroll
                for (int c = 0; c < 2; ++c)
#pragma unroll
                    for (int ks = 0; ks < 4; ++ks) sb[c][ks] = sn[c][ks]; }
        }
        if (cu + F.G < 2048) hg_issue(F, T, LFF, LFB, VH, QH, cu + F.G);
#pragma unroll 1
        for (int jp = 0; jp < 2; ++jp) {
            if (dir ? (2 * jp + 1 < PI) : (2 * jp > PI)) continue;
            f32x4 pt[2];
#pragma unroll
            for (int jj = 0; jj < 2; ++jj) { const int PJ = 2 * jp + jj; pt[jj] = (f32x4){0.f, 0.f, 0.f, 0.f};
                if (dir ? (PJ >= PI) : (PJ <= PI)) { const int s = 16 * PJ + tl; const bool edge = dir ? (s == 63) : (s == 0);
#pragma unroll
                    for (int ks = 0; ks < 4; ++ks) { const int d0 = 32 * ks + 8 * g; const LAS float* bs = bt + s * HG_BST + d0; const LAS float* br = bt + refrow * HG_BST + d0;
                        float kh[8], vb[8], vp[8], vr[8]; lds8(bs, vb); lds8(bs + (edge ? 0 : pst), vp); lds8(br, vr);
#pragma unroll
                        for (int e = 0; e < 8; ++e) { const float bb = vb[e], bp = edge ? 0.f : vp[e], rr = hasref ? vr[e] : 0.f; kh[e] = (1.0f - __expf(bb - bp)) * __expf(rr - bb); }
                        v4u o; o.x = pk2(kh[0], kh[1]); o.y = pk2(kh[2], kh[3]); o.z = pk2(kh[4], kh[5]); o.w = pk2(kh[6], kh[7]);
                        pt[jj] = __builtin_amdgcn_mfma_f32_16x16x32_bf16(__builtin_bit_cast(bf16x8, o), qh[ks], pt[jj], 0, 0, 0); }
                    if (PJ == PI) {
#pragma unroll
                        for (int r = 0; r < 4; ++r) if (dir ? (4 * g + r < tl) : (4 * g + r > tl)) pt[jj][r] = 0.f; }
                } }
            v4u pa; pa.x = pk2(pt[0][0], pt[0][1]); pa.y = pk2(pt[0][2], pt[0][3]); pa.z = pk2(pt[1][0], pt[1][1]); pa.w = pk2(pt[1][2], pt[1][3]);
#pragma unroll
            for (int cq = 0; cq < 2; ++cq) { bf16x8 bv[4];
#pragma unroll
                for (int c = 0; c < 4; ++c) bv[c] = tr_frag(F.lds + HG_V_OFF, lane, 4 * cq + c, 32 * jp, 32 * jp + 16);
#pragma unroll
                for (int c = 0; c < 4; ++c) acc[4 * cq + c] = __builtin_amdgcn_mfma_f32_16x16x32_bf16(__builtin_bit_cast(bf16x8, pa), bv[c], acc[4 * cq + c], 0, 0, 0); }
        }
        __syncthreads();
        const int fpos = 8 * w + (lane >> 3), fvc = lane & 7; const size_t ftok = (size_t)(64 * cg + fpos);
        v4u ghv[2]; f32x4 gnv[4];
#pragma unroll
        for (int hh = 0; hh < 2; ++hh) { ghv[hh] = *(const v4u*)(GH + ftok * 512 + head * 128 + 16 * fvc + 8 * hh); gnv[2 * hh] = *(const f32x4*)(gnorm + head * 128 + 16 * fvc + 8 * hh); gnv[2 * hh + 1] = *(const f32x4*)(gnorm + head * 128 + 16 * fvc + 8 * hh + 4); }
        { LAS float* ob = (LAS float*)F.lds + dir * 64 * HG_OST;
#pragma unroll
            for (int r = 0; r < 4; ++r)
#pragma unroll
                for (int c = 0; c < 8; ++c) ob[(16 * PI + 4 * g + r) * HG_OST + 16 * c + tl] = acc[c][r]; }
        __syncthreads();
        { const int pos = 8 * w + (lane >> 3), vc = lane & 7; const LAS float* o0 = (const LAS float*)F.lds + pos * HG_OST + 16 * vc; const LAS float* o1 = o0 + 64 * HG_OST;
            float x[16]; float ss = 0.f;
#pragma unroll
            for (int i = 0; i < 4; ++i) { const f32x4 a = *(const LAS f32x4*)(o0 + 4 * i), b2 = *(const LAS f32x4*)(o1 + 4 * i);
#pragma unroll
                for (int e = 0; e < 4; ++e) { const float v = a[e] + b2[e]; x[4 * i + e] = v; ss += v * v; } }
            ss += xshfl<1>(ss, lane); ss += xshfl<2>(ss, lane); ss += xshfl<4>(ss, lane);
            const float rstd = fast_rsq(ss * (1.0f / 128.0f) + EPS);
            bf16* op = CAT + ftok * DM + 512 + head * 128 + 16 * vc;
#pragma unroll
            for (int hh = 0; hh < 2; ++hh) { const v4u gh = ghv[hh]; const f32x4 g0 = gnv[2 * hh], g1 = gnv[2 * hh + 1]; const float* xx = x + 8 * hh;
                v4u o; o.x = pk2(xx[0] * rstd * g0[0] * bflo(gh.x), xx[1] * rstd * g0[1] * bfhi(gh.x)); o.y = pk2(xx[2] * rstd * g0[2] * bflo(gh.y), xx[3] * rstd * g0[3] * bfhi(gh.y));
                o.z = pk2(xx[4] * rstd * g1[0] * bflo(gh.z), xx[5] * rstd * g1[1] * bfhi(gh.z)); o.w = pk2(xx[6] * rstd * g1[2] * bflo(gh.w), xx[7] * rstd * g1[3] * bfhi(gh.w));
                *(v4u*)(op + 8 * hh) = o; } }
        __syncthreads();
    }
}

__device__ __forceinline__ void na_phase(FA, const float* relb, const float* qng, const float* kng, u64* ssA) {
    const bf16* Q = WSP(bf16, WS_Q); const bf16* K = WSP(bf16, WS_K); const bf16* V = WSP(bf16, WS_V); bf16* CAT = WSP(bf16, WS_CAT);
    const int lane = F.lane, w = F.wave, g = lane >> 4, tl = lane & 15, qb = w & 3, hh = w >> 2;
    const int kb_lo = qb >= 2 ? qb - 1 : 0, kb_hi = qb <= 1 ? qb + 1 : 3;
    LAS float* btab = (LAS float*)(F.lds + NA_BIAS_OFF); int hp_loaded = -1;
    float Bnd; { const float qv = qng[lane], kv = kng[lane]; float bvv[8], mb = 0.f;
#pragma unroll
        for (int j = 0; j < 8; ++j) bvv[j] = relb[min(F.tid + 512 * j, 8 * 15 * 31 - 1)];
#pragma unroll
        for (int j = 0; j < 8; ++j) mb = fmaxf(mb, fabsf(bvv[j]));
        const float mq = wave_max(fabsf(qv), lane), mk = wave_max(fabsf(kv), lane); mb = wave_max(mb, lane);
        LAS float* red = (LAS float*)(F.lds + NA_BIAS_OFF + 3840);
        if (lane == 0) red[w] = mb;
        __syncthreads();
        Bnd = 8.0f * mq * mk + wave_max(red[lane & 7], lane); }
    constexpr int NA_V_OFF = RING_OFF, NA_K_OFF = RING_OFF + 65536;
    const unsigned vlt = (unsigned)((F.tid >> 4) * 512 + 8 * (F.tid & 15)), vlds = hoff(F.tid >> 4, F.tid & 15);
    const unsigned klt = (unsigned)(tl * 512 + 8 * g);
    v4u vv[8], kk[8];
#define NA_ISSUE(uu, ss) do { const int hp_ = (uu) & 3, R_ = (uu) >> 2; int Rb_, gr_, rows_; \
        if (R_ < MPROMPT / 64) { Rb_ = R_ & ~31; gr_ = R_ & 31; rows_ = 32; } else { Rb_ = 256 + ((R_ - 256) & ~63); gr_ = (R_ - 256) & 63; rows_ = 64; } \
        const size_t go_ = (size_t)((Rb_ + min(max(gr_ - 4, 0), rows_ - 8)) * 64 + 256 * (ss)) * 512 + hp_ * 128; \
        _Pragma("unroll") for (int i = 0; i < 8; ++i) { vv[i] = *(const v4u*)(V + go_ + (size_t)(32 * i) * 512 + vlt); kk[i] = *(const v4u*)(K + go_ + (size_t)(32 * i) * 512 + vlt); } } while (0)
    if (F.bid < 512 * 4) NA_ISSUE(F.bid, 0);
    for (int u = F.bid; u < 512 * 4; u += F.G) {
        const int hp = u & 3, R = u >> 2; int Rb, gr, rows;
        if (R < MPROMPT / 64) { Rb = R & ~31; gr = R & 31; rows = 32; } else { Rb = 256 + ((R - 256) & ~63); gr = (R - 256) & 63; rows = 64; }
        const int rs = min(max(gr - 4, 0), rows - 8), head = 2 * hp + hh;
        const int gc = 16 * qb + tl, cs = min(max(gc - 8, 0), 48), qrow = R * 64 + gc;
        bf16x8 qf[2];
#pragma unroll
        for (int ks = 0; ks < 2; ++ks) qf[ks] = *(const bf16x8*)(Q + (size_t)(R * 64 + 16 * qb) * 512 + head * 64 + 32 * ks + klt);
        if (hp != hp_loaded) { const float b0 = relb[hp * 2 * 15 * 31 + F.tid], b1 = relb[hp * 2 * 15 * 31 + min(F.tid + 512, 2 * 15 * 31 - 1)];
            btab[F.tid] = b0 - Bnd; if (F.tid + 512 < 2 * 15 * 31) btab[F.tid + 512] = b1 - Bnd; hp_loaded = hp; }
        f32x4 acc[4];
#pragma unroll
        for (int db = 0; db < 4; ++db) acc[db] = (f32x4){0.f, 0.f, 0.f, 0.f};
        float lrun = 0.f;
#pragma unroll 1
        for (int sg = 0; sg < 2; ++sg) {
#pragma unroll
            for (int i = 0; i < 8; ++i) { *(LAS v4u*)(F.lds + NA_V_OFF + vlds + 8192 * i) = vv[i]; *(LAS v4u*)(F.lds + NA_K_OFF + vlds + 8192 * i) = kk[i]; }
            __syncthreads();
            __builtin_amdgcn_s_waitcnt(0x0F70);
            if (sg == 0) NA_ISSUE(u, 1); else if (u + F.G < 512 * 4) NA_ISSUE(u + F.G, 0);
#pragma unroll 1
            for (int al = 0; al < 4; ++al) {
                const int dr = rs + 4 * sg + al - gr; const LAS float* brow = btab + (hh * 15 + dr + 7) * 31 + 15 - gc;
                f32x4 st[4];
#pragma unroll
                for (int kb = 0; kb < 4; ++kb) { st[kb] = (f32x4){0.f, 0.f, 0.f, 0.f};
                    if (kb >= kb_lo && kb <= kb_hi) {
#pragma unroll
                        for (int ks = 0; ks < 2; ++ks) st[kb] = __builtin_amdgcn_mfma_f32_16x16x32_bf16(*(const LAS bf16x8*)(F.lds + NA_K_OFF + hoff(64 * al + 16 * kb + tl, 8 * hh + 4 * ks + g)), qf[ks], st[kb], 0, 0, 0); } }
#pragma unroll
                for (int kb = 0; kb < 4; ++kb) {
                    if (kb < kb_lo || kb > kb_hi) continue;
                    float bv[4], ev[4];
#pragma unroll
                    for (int r = 0; r < 4; ++r) { const int kc = 16 * kb + 4 * g + r; bv[r] = brow[min(max(kc, cs), cs + 15)]; }
#pragma unroll
                    for (int r = 0; r < 4; ++r) ev[r] = __expf(st[kb][r] * 0.125f + bv[r]);
#pragma unroll
                    for (int r = 0; r < 4; ++r) { const int kc = 16 * kb + 4 * g + r; const float p = (kc >= cs && kc < cs + 16) ? ev[r] : 0.f; st[kb][r] = p; lrun += p; } }
#pragma unroll
                for (int kp2 = 0; kp2 < 2; ++kp2) {
                    if (2 * kp2 + 1 < kb_lo || 2 * kp2 > kb_hi) continue;
                    v4u pb; pb.x = pk2(st[2 * kp2][0], st[2 * kp2][1]); pb.y = pk2(st[2 * kp2][2], st[2 * kp2][3]); pb.z = pk2(st[2 * kp2 + 1][0], st[2 * kp2 + 1][1]); pb.w = pk2(st[2 * kp2 + 1][2], st[2 * kp2 + 1][3]);
                    bf16x8 va[4];
#pragma unroll
                    for (int db = 0; db < 4; ++db) va[db] = tr_frag(F.lds + NA_V_OFF, lane, 4 * hh + db, 64 * al + 32 * kp2, 64 * al + 32 * kp2 + 16);
#pragma unroll
                    for (int db = 0; db < 4; ++db) acc[db] = __builtin_amdgcn_mfma_f32_16x16x32_bf16(va[db], __builtin_bit_cast(bf16x8, pb), acc[db], 0, 0, 0);
                }
            }
            __syncthreads();
        }
        lrun += xshfl<16>(lrun, lane); lrun += xshfl<32>(lrun, lane);
        const float inv = 1.0f / lrun;
        bf16* op = CAT + (size_t)qrow * DM + head * 64 + 4 * g; float ssq = 0.f;
#pragma unroll
        for (int db = 0; db < 4; ++db) { const f32x4 ov = acc[db] * inv; ssq += (ov[0] * ov[0] + ov[1] * ov[1]) + (ov[2] * ov[2] + ov[3] * ov[3]);
            v2u o; o.x = pk2(ov[0], ov[1]); o.y = pk2(ov[2], ov[3]); *(v2u*)(op + 16 * db) = o; }
        ssq += xshfl<16>(ssq, lane); ssq += xshfl<32>(ssq, lane);
        if (g == 0) atomicAdd(ssA + qrow, ss_fix(ssq));
    }
#undef NA_ISSUE
}

__device__ __forceinline__ void post_phase(FA, int l) {
    const bf16* O = WSP(bf16, WS_O); const bf16* Y2 = WSP(bf16, WS_Y2); bf16* CAT = WSP(bf16, WS_CAT);
    const float* ga = AIN(11) + l * 512; const float* gc = AIN(24) + l * 1024; const int lane = F.lane;
    for (int r = F.gw; r < MTOK; r += F.NGW) {
        {
            const v4u w = *(const v4u*)(O + (size_t)r * 512 + 8 * lane); float x[8] = {bflo(w.x), bfhi(w.x), bflo(w.y), bfhi(w.y), bflo(w.z), bfhi(w.z), bflo(w.w), bfhi(w.w)}; float s = 0.f;
#pragma unroll
            for (int i = 0; i < 8; ++i) s += x[i] * x[i];
            const float rstd = fast_rsq(wave_sum(s, F.lane) * (1.0f / 512.0f) + EPS); const f32x4 g0 = *(const f32x4*)(ga + 8 * lane), g1 = *(const f32x4*)(ga + 8 * lane + 4);
            v4u o; o.x = pk2(x[0] * rstd * g0[0], x[1] * rstd * g0[1]); o.y = pk2(x[2] * rstd * g0[2], x[3] * rstd * g0[3]); o.z = pk2(x[4] * rstd * g1[0], x[5] * rstd * g1[1]); o.w = pk2(x[6] * rstd * g1[2], x[7] * rstd * g1[3]);
            *(v4u*)(CAT + (size_t)r * DM + 8 * lane) = o; }
        {
            float s = 0.f; v4u w[2];
#pragma unroll
            for (int hh = 0; hh < 2; ++hh) { w[hh] = *(const v4u*)(Y2 + (size_t)r * 1024 + 512 * hh + 8 * lane);
                s += bflo(w[hh].x) * bflo(w[hh].x) + bfhi(w[hh].x) * bfhi(w[hh].x) + bflo(w[hh].y) * bflo(w[hh].y) + bfhi(w[hh].y) * bfhi(w[hh].y) + bflo(w[hh].z) * bflo(w[hh].z) + bfhi(w[hh].z) * bfhi(w[hh].z) + bflo(w[hh].w) * bflo(w[hh].w) + bfhi(w[hh].w) * bfhi(w[hh].w); }
            const float rstd = fast_rsq(wave_sum(s, F.lane) * (1.0f / 1024.0f) + EPS);
#pragma unroll
            for (int hh = 0; hh < 2; ++hh) { const f32x4 g0 = *(const f32x4*)(gc + 512 * hh + 8 * lane), g1 = *(const f32x4*)(gc + 512 * hh + 8 * lane + 4);
                v4u o; o.x = pk2(bflo(w[hh].x) * rstd * g0[0], bfhi(w[hh].x) * rstd * g0[1]); o.y = pk2(bflo(w[hh].y) * rstd * g0[2], bfhi(w[hh].y) * rstd * g0[3]);
                o.z = pk2(bflo(w[hh].z) * rstd * g1[0], bfhi(w[hh].z) * rstd * g1[1]); o.w = pk2(bflo(w[hh].w) * rstd * g1[2], bfhi(w[hh].w) * rstd * g1[3]);
                *(v4u*)(CAT + (size_t)r * DM + 1024 + 512 * hh + 8 * lane) = o; } }
    }
}

__global__ void __launch_bounds__(NWAVES * 64, 2) enc_fwd(const Args A) {
    extern __shared__ __attribute__((aligned(16))) unsigned char lds[];
    Frame F;
    F.lds = (LAS unsigned char*)lds; F.MISC = (volatile LAS unsigned*)(F.lds + MISC_OFF);
    F.tid = threadIdx.x; F.lane = F.tid & 63; F.wave = __builtin_amdgcn_readfirstlane(F.tid >> 6);
    const int wave0 = F.wave;
    F.G = gridDim.x; F.gw = blockIdx.x * NWAVES + F.wave; F.NGW = F.G * NWAVES; F.bid = blockIdx.x; F.ws = (unsigned char*)A.in[32]; F.X = (float*)A.in[31]; F.zi = 0;

    for (int u = F.tid; u < (LDS_BYTES - LDSCTL_OFF) / 4; u += NWAVES * 64) ((LAS unsigned*)(F.lds + LDSCTL_OFF))[u] = 0u;
    __syncthreads();
    if (!MK_PER_PHASE) (void)xcd_barrier_post((unsigned*)((unsigned char*)A.in[32] + WS_CTL) + CW_BAR, (volatile LAS unsigned*)((LAS unsigned char*)lds + MISC_OFF) + 8);
#define GRID_BAR() do { if (MK_PER_PHASE) { if (F.tid == 0) __hip_atomic_store((gu32*)(F.ws + WS_CTL) + CW_TMO, 0xBADBA0u, RLX_AGENT); } \
    else { unsigned zb_ = 0u; asm volatile("" : "+v"(zb_)); zb_ = (unsigned)__builtin_amdgcn_readfirstlane((int)zb_); unsigned char* wsb_ = (unsigned char*)A.in[32 + (int)zb_]; \
           XcdBarrier b_; b_.bar = (unsigned*)(wsb_ + WS_CTL) + CW_BAR; b_.x = xb_xcc_id(); b_.t0 = (wave0 == 0) && (fresh_lane() == 0); b_.st = (volatile LAS unsigned*)((LAS unsigned char*)lds + MISC_OFF) + 8; xcd_barrier(b_); } } while (0)
#ifndef ONLY
#define ONLY -1
#endif
#define IN(k) ((ONLY < 0 || ((k) - p0) == ONLY) && A.ph_lo <= (k) && (k) < A.ph_hi)
#define SEAM(k) do { if (IN(k) && IN((k) + 1)) GRID_BAR(); } while (0)
#define PHASE_BEGIN() do { int t_ = wave0 * 64 + fresh_lane(); asm volatile("" : "+v"(t_)); F.tid = t_; F.lane = t_ & 63; F.wave = __builtin_amdgcn_readfirstlane(t_ >> 6); \
        int b_ = blockIdx.x; asm volatile("" : "+v"(b_)); b_ = __builtin_amdgcn_readfirstlane(b_); F.bid = b_; F.G = gridDim.x; F.NGW = F.G * NWAVES; F.gw = b_ * NWAVES + F.wave; \
        unsigned z_ = 0u; asm volatile("" : "+v"(z_)); z_ = (unsigned)__builtin_amdgcn_readfirstlane((int)z_); F.zi = (int)z_; F.ws = (unsigned char*)AIN(32); F.X = (float*)AIN(31); } while (0)
    for (int l = 0; l < NL; ++l) {
        const int p0 = l * PH_PER_LAYER;
#define SSP(ll, k) (WSP(u64, WS_SS) + (size_t)(1 + 6 * (ll) + (k)) * MTOK)
        if (IN(p0 + 0)) { PHASE_BEGIN();
            if (F.wave & 1) { s5_ops(F, A, l); conv_layer(F, A, l); } else { conv_layer(F, A, l); s5_ops(F, A, l); }
            if (l == 0) { lb_table(F, A); prep_phase(F, A); }
        }
        SEAM(p0 + 0);
#define HOFF(hf) ((size_t)(hf) * MPROMPT)
#define FFN_UP(hf, WOFF, SA, SB, UB) do { PHASE_BEGIN(); pg8::Gemm g{WSP(bf16, WS_XB) + HOFF(hf) * DM, WSP(bf16, WOFF), MPROMPT, 2 * FF, DM, DM, DM}; pg8::StaticOrder S; S.init(MPROMPT, 2 * FF, F.G, F.bid, WGM_UP); \
            EpiSwiGLU E{WSP(bf16, WS_H) + HOFF(hf) * FF, RowScale{(SA) + HOFF(hf), (SB) + HOFF(hf), UB}}; pg8::gemm_phase<EpiSwiGLU, pg8::StaticOrder, true, true>(F.lds + RING_OFF, g, S, E, F.tid); } while (0)
#define FFN_DN(hf, WOFF, PRE, HASPRE, PREG, SSA, SSB, GB) do { PHASE_BEGIN(); pg8::Gemm g{WSP(bf16, WS_H) + HOFF(hf) * FF, WSP(bf16, WOFF), MPROMPT, DM, FF, FF, FF}; pg8::StaticOrder S; S.init(MPROMPT, DM, F.G, F.bid, WGM_DN); \
            u64* ssb_ = (SSB); EpiResid E{WSP(bf16, WS_XB) + HOFF(hf) * DM, 0.5f, (PRE) + HOFF(hf), HASPRE, PREG, (SSA) + HOFF(hf), ssb_ ? ssb_ + HOFF(hf) : nullptr, GB}; \
            pg8::gemm_phase<EpiResid, pg8::StaticOrder, true, true>(F.lds + RING_OFF, g, S, E, F.tid); } while (0)
        if (IN(p0 + 1)) { FFN_UP(0, WS_WGU1, l ? SSP(l - 1, 2) : WSP(u64, WS_SS), l ? SSP(l - 1, 3) : WSP(u64, WS_SS), l != 0); }
        SEAM(p0 + 1);
        if (IN(p0 + 2)) { FFN_DN(0, WS_WD1, l ? SSP(l - 1, 2) : SSP(l, 0), l != 0, l ? AIN(30) + (l - 1) * DM : nullptr, SSP(l, 0), (u64*)nullptr, nullptr); __syncthreads();
                          FFN_UP(1, WS_WGU1, l ? SSP(l - 1, 2) : WSP(u64, WS_SS), l ? SSP(l - 1, 3) : WSP(u64, WS_SS), l != 0); }
        SEAM(p0 + 2);
        if (IN(p0 + 3)) { FFN_DN(1, WS_WD1, l ? SSP(l - 1, 2) : SSP(l, 0), l != 0, l ? AIN(30) + (l - 1) * DM : nullptr, SSP(l, 0), (u64*)nullptr, nullptr); }
        SEAM(p0 + 3);
        if (IN(p0 + 4)) { PHASE_BEGIN(); pg8::Gemm g{WSP(bf16, WS_XB), WSP(bf16, WS_WIN), MTOK, INC, DM, DM, DM}; pg8::StaticOrder S; S.init(MTOK, INC, F.G, F.bid, WGM_IN);
            EpiWin E{WSP(bf16, WS_Q), WSP(bf16, WS_K), WSP(bf16, WS_V), WSP(bf16, WS_QH), WSP(bf16, WS_VH), WSP(bf16, WS_GH), WSP(bf16, WS_LFF), WSP(bf16, WS_LFB), WSP(bf16, WS_UX),
                     AIN(8) + l * 64, AIN(9) + l * 64, WSP(float, WS_TAB) + l * 1024, RowScale{SSP(l, 0), SSP(l, 0), false}};
            pg8::gemm_phase<EpiWin, pg8::StaticOrder, true, true>(F.lds + RING_OFF, g, S, E, F.tid); }
        SEAM(p0 + 4);
        if (IN(p0 + 5)) { PHASE_BEGIN(); pg8::Gemm g{WSP(bf16, WS_UX), WSP(bf16, WS_S5E), 64 * 2048, 64 * 256, 256, 512, 256}; S5Order S{F.G, F.bid};
            EpiS5E E{WSP(bf16, WS_E)}; pg8::gemm_phase<EpiS5E, S5Order, false, true>(F.lds + RING_OFF, g, S, E, F.tid);
            __syncthreads(); hg_phase_a(F, A);
        }
        SEAM(p0 + 5);
        if (IN(p0 + 6)) { PHASE_BEGIN();
            hg_phase_b(F, A);
            if (F.gw < 1536) s5_carry(F, A, l, F.gw, 1536);
            __syncthreads(); na_phase(F, A, AIN(10) + l * (8 * 15 * 31), AIN(8) + l * 64, AIN(9) + l * 64, SSP(l, 4));
        }
        SEAM(p0 + 6);
        if (IN(p0 + 7)) { PHASE_BEGIN(); pg8::Gemm g{WSP(bf16, WS_UX), WSP(bf16, WS_S5Y), 64 * 2048, 64 * 256, 512, 512, 512}; S5Order S{F.G, F.bid};
            EpiS5Y E{WSP(bf16, WS_YPRE)}; pg8::gemm_phase<EpiS5Y, S5Order, true, true>(F.lds + RING_OFF, g, S, E, F.tid);
            __syncthreads(); hg_phase_c(F, A, AIN(13) + l * 512);
        }
        SEAM(p0 + 7);
        if (IN(p0 + 8)) { PHASE_BEGIN(); pg8::Gemm g{WSP(bf16, WS_YPRE), WSP(bf16, WS_WGLU), MTOK, S5W, S5W, S5W, S5W}; pg8::StaticOrder S; S.init(MTOK, S5W, F.G, F.bid, WGM_DN);
            EpiGLU E{WSP(bf16, WS_YPRE), AIN(23) + l * S5W, WSP(bf16, WS_CAT) + 1024, SSP(l, 5)}; pg8::gemm_phase<EpiGLU, pg8::StaticOrder, true, true>(F.lds + RING_OFF, g, S, E, F.tid); }
        SEAM(p0 + 8);
        if (IN(p0 + 9)) { PHASE_BEGIN(); pg8::Gemm g{WSP(bf16, WS_CAT), WSP(bf16, WS_WOUT), MTOK, DM, DM, DM, DM}; pg8::StaticOrder S; S.init(MTOK, DM, F.G, F.bid, WGM_DN);
            EpiResidW E{WSP(bf16, WS_XB), SSP(l, 4), SSP(l, 5), SSP(l, 1)}; pg8::gemm_phase<EpiResidW, pg8::StaticOrder, true, true>(F.lds + RING_OFF, g, S, E, F.tid); }
        SEAM(p0 + 9);
        if (IN(p0 + 10)) { FFN_UP(0, WS_WGU2, SSP(l, 1), SSP(l, 1), false); }
        SEAM(p0 + 10);
        if (IN(p0 + 11)) { FFN_DN(0, WS_WD2, SSP(l, 2), false, nullptr, SSP(l, 2), SSP(l, 3), AIN(30) + l * DM); __syncthreads();
                           FFN_UP(1, WS_WGU2, SSP(l, 1), SSP(l, 1), false); }
        SEAM(p0 + 11);
        if (IN(p0 + 12)) { FFN_DN(1, WS_WD2, SSP(l, 2), false, nullptr, SSP(l, 2), SSP(l, 3), AIN(30) + l * DM); }
        if (l == NL - 1) SEAM(p0 + 12);
        if (IN(p0 + 13) && l == NL - 1) { PHASE_BEGIN(); out_norm_phase(F, A, SSP(l, 2), AIN(30) + l * DM); }
        SEAM(p0 + 13);
    }
#undef IN
#undef SEAM
}

extern "C" void kernel_launch(void* const* d_in, const int* in_sizes, int n_in, void* d_out, int out_size, void* d_ws, size_t ws_size, hipStream_t stream) {
    static int grid = 0;
    if (grid == 0) {
        if (n_in != 31 || out_size != MTOK * DM || ws_size < WS_END) { fprintf(stderr, "kernel_launch: unexpected shapes: n_in %d out %d ws %zu (need %zu); nothing launched\n", n_in, out_size, ws_size, (size_t)WS_END); grid = -1; return; }
        int dev = 0, cus = 0, per_cu = 0;
        if (hipGetDevice(&dev) != hipSuccess || hipDeviceGetAttribute(&cus, hipDeviceAttributeMultiprocessorCount, dev) != hipSuccess) { grid = -1; return; }
        if (hipFuncSetAttribute((const void*)enc_fwd, hipFuncAttributeMaxDynamicSharedMemorySize, LDS_BYTES) != hipSuccess) { fprintf(stderr, "kernel_launch: hipFuncSetAttribute failed\n"); grid = -1; return; }
        if (hipOccupancyMaxActiveBlocksPerMultiprocessor(&per_cu, (const void*)enc_fwd, NWAVES * 64, LDS_BYTES) != hipSuccess || per_cu < 1)
            fprintf(stderr, "kernel_launch: note: occupancy query reports %d workgroups per CU\n", per_cu);
        (void)hipGetLastError();
        grid = cus;
    }
    if (grid < 0) return;
    static_assert(WS_SS + SS_BYTES == WS_CTL && WS_CTL + CTL_ZERO_BYTES == WS_END, "row sums and control words are one contiguous region");
    if (hipMemsetAsync((char*)d_ws + WS_SS, 0, SS_BYTES + CTL_ZERO_BYTES, stream) != hipSuccess) { fprintf(stderr, "kernel_launch: memset failed\n"); return; }
    Args a{};
    for (int i = 0; i < 31; ++i) a.in[i] = (const float*)d_in[i];
    a.in[31] = (const float*)d_out; a.in[32] = (const float*)d_ws; a.li = 0; a.pad = 0;
#if MK_PER_PHASE
    for (int p = 0; p < N_PHASES; ++p) { a.ph_lo = p; a.ph_hi = p + 1; hipLaunchKernelGGL(enc_fwd, dim3(grid), dim3(NWAVES * 64), LDS_BYTES, stream, a); }
#else
    a.ph_lo = 0; a.ph_hi = N_PHASES; hipLaunchKernelGGL(enc_fwd, dim3(grid), dim3(NWAVES * 64), LDS_BYTES, stream, a);
#endif
    const hipError_t le = hipPeekAtLastError();
    if (le != hipSuccess) fprintf(stderr, "kernel_launch: launch failed: %s\n", hipGetErrorName(le));
}
```

```cpp
#include <hip/hip_runtime.h>
#include <cstdio>
#include <cstdint>
namespace pg8 {
#define PG8_LAS __attribute__((address_space(3)))
typedef unsigned short bf16_t;
typedef short bf16x8 __attribute__((ext_vector_type(8)));
typedef float f32x4 __attribute__((ext_vector_type(4)));
typedef unsigned u32x4 __attribute__((ext_vector_type(4)));
constexpr int BM = 256, BK = 64, HALF = 128, HTB = HALF * BK * 2  , STAGE_BYTES = 8 * HTB, NXCD = 8, WGM = 8;

__host__ __device__ __forceinline__ int lds_byte(int r, int c) { const int st = (r >> 4) * 2 + (c >> 5), rr = r & 15, cc = c & 31, ob = rr * 64 + cc * 2; return st * 1024 + (ob ^ (((ob >> 9) & 1) << 5)); }
__host__ __device__ __forceinline__ void stage_rc(int b, int& R, int& C) { const int st = b / 1024, sb = b % 1024, swz = sb ^ (((sb >> 9) & 1) << 5); R = (st >> 1) * 16 + swz / 64; C = (st & 1) * 32 + (swz % 64) / 2; }
__host__ __device__ __forceinline__ int perm32(int rho) { const int n = rho >> 4, i = rho & 15; return 8 * (i >> 2) + 4 * n + (i & 3); }

struct Unit { int pm, pn; };
struct Gemm { const bf16_t* A; const bf16_t* Bt; int M, N, K, lda, ldb; };

struct StaticOrder {
    int nM, nN, nwg, G, c, wgm;
    __host__ __device__ void init(int M, int N, int G_, int c_, int wgm_ = WGM) { nM = M / BM; nN = N / BM; nwg = nM * nN; G = G_; c = c_; wgm = wgm_; }
    __host__ __device__ bool next(int i, Unit& u) const {
        const long L = (long)i * G + c; if (L >= nwg) return false;
        int wgid = (int)L; { const int q = nwg / NXCD, r = nwg % NXCD, xcd = wgid % NXCD, off = wgid / NXCD; wgid = (xcd < r ? xcd * (q + 1) : r * (q + 1) + (xcd - r) * q) + off; }
        const int nig = wgm * nN, gid = wgid / nig, fm = gid * wgm, gsz = (nM - fm) < wgm ? (nM - fm) : wgm;
        u.pm = fm + ((wgid % nig) % gsz); u.pn = (wgid % nig) / gsz; return true;
    }
    __device__ __forceinline__ void a_ready(const Unit&) const {}
    __device__ __forceinline__ void done(const Unit&) const {}
};

template <class Epi, class Sched, bool ALIGN_EPI = false, bool SP2 = false>
__device__ __forceinline__ void gemm_phase(PG8_LAS unsigned char* lds, const Gemm g, const Sched& S, const Epi& E, int tid_in) {
    int tid_ = tid_in; asm volatile("" : "+v"(tid_));
    const int tid = tid_, wid = __builtin_amdgcn_readfirstlane(tid >> 6), lane = tid & 63, wr = wid >> 2, wc = wid & 3, fr = lane & 15, fq = lane >> 4;
    const int K = g.K, nt = K / BK;
    unsigned voffA[2], voffB[2];
#pragma unroll
    for (int i = 0; i < 2; ++i) { int R, C; stage_rc(tid * 16 + i * 8192, R, C); const int Rb = Epi::PERM ? ((R & ~31) + perm32(R & 31)) : R;
        voffA[i] = (unsigned)(R * g.lda + C) * 2u; voffB[i] = (unsigned)(Rb * g.ldb + C) * 2u; }
    const size_t kstep = (size_t)(BK * 2);
    const size_t hstepA = (size_t)HALF * g.lda * 2, hstepB = (size_t)HALF * g.ldb * 2;
    const size_t tstepA = 2 * hstepA, tstepB = 2 * hstepB;
    const unsigned ldsw = (unsigned)wid * 1024u;
    const int aoff = lds_byte(wr * 64 + fr, fq * 8), boff = lds_byte(wc * 32 + fr, fq * 8);
#define PG8_SA(b, h) (((b) * 2 + (h)) * HTB)
#define PG8_SB(b, h) ((4 + (b) * 2 + (h)) * HTB)
#define PG8_STAGE(bufoff, gbase, voff) do { _Pragma("unroll") for (int _i = 0; _i < 2; ++_i) \
        __builtin_amdgcn_global_load_lds((const unsigned*)((const char*)(gbase) + (voff)[_i]), (PG8_LAS unsigned*)(lds + (bufoff) + ldsw + _i * 8192), 16, 0, 0); } while (0)
#define PG8_LDA(dst, b, h) do { _Pragma("unroll") for (int m = 0; m < 4; ++m) _Pragma("unroll") for (int k = 0; k < 2; ++k) dst[m][k] = *(const PG8_LAS bf16x8*)(lds + PG8_SA(b, h) + aoff + m * 2048 + k * 1024); } while (0)
#define PG8_LDB(dst, b, h) do { _Pragma("unroll") for (int n = 0; n < 2; ++n) _Pragma("unroll") for (int k = 0; k < 2; ++k) dst[n][k] = *(const PG8_LAS bf16x8*)(lds + PG8_SB(b, h) + boff + n * 2048 + k * 1024); } while (0)
#define PG8_MMA(ai, bj, At, Bt) do { __builtin_amdgcn_s_setprio(1); _Pragma("unroll") for (int m = 0; m < 4; ++m) _Pragma("unroll") for (int n = 0; n < 2; ++n) _Pragma("unroll") for (int k = 0; k < 2; ++k) \
        acc[ai][bj][m][n] = __builtin_amdgcn_mfma_f32_16x16x32_bf16(Bt[n][k], At[m][k], acc[ai][bj][m][n], 0, 0, 0); __builtin_amdgcn_s_setprio(0); } while (0)
#define PG8_WAIT_V(n) asm volatile("s_waitcnt vmcnt(" #n ")" ::: "memory")
#define PG8_WAIT_L(n) asm volatile("s_waitcnt lgkmcnt(" #n ")" ::: "memory")
#define PG8_BAR __builtin_amdgcn_s_barrier()
#define PG8_SCHED __builtin_amdgcn_sched_barrier(0)
    Unit cur, nxt; int ui = 0;
    if (!S.next(0, cur)) return;
    f32x4 acc[2][2][4][2];
#pragma unroll
    for (int a = 0; a < 2; ++a)
#pragma unroll
        for (int b = 0; b < 2; ++b)
#pragma unroll
            for (int m = 0; m < 4; ++m)
#pragma unroll
                for (int n = 0; n < 2; ++n) acc[a][b][m][n] = (f32x4){0.f, 0.f, 0.f, 0.f};
    bf16x8 At[4][2], B0[2][2], B1[2][2];
    const char* cA = (const char*)g.A + (size_t)cur.pm * tstepA; const char* cB = (const char*)g.Bt + (size_t)cur.pn * tstepB;
#define PG8_KT(x) ((Epi::KROT != 0 ? (size_t)(((x) + Epi::KROT) & (nt - 1)) : (size_t)(x)) * kstep)
    S.a_ready(cur);
    E.first(cur, lds, tid);
    if constexpr (SP2) {
        PG8_STAGE(PG8_SB(0, 0), cB + PG8_KT(0), voffB); PG8_STAGE(PG8_SB(0, 1), cB + hstepB + PG8_KT(0), voffB); PG8_STAGE(PG8_SA(0, 0), cA + PG8_KT(0), voffA); PG8_STAGE(PG8_SA(0, 1), cA + hstepA + PG8_KT(0), voffA);
        if (wr == 1) PG8_BAR;
        PG8_WAIT_V(2); PG8_BAR;
        PG8_STAGE(PG8_SB(1, 0), cB + PG8_KT(1), voffB); PG8_STAGE(PG8_SA(1, 0), cA + PG8_KT(1), voffA); PG8_STAGE(PG8_SB(1, 1), cB + hstepB + PG8_KT(1), voffB);
        PG8_WAIT_V(6); PG8_BAR;
    } else {
        PG8_STAGE(PG8_SB(0, 0), cB + PG8_KT(0), voffB); PG8_STAGE(PG8_SA(0, 0), cA + PG8_KT(0), voffA); PG8_STAGE(PG8_SB(0, 1), cB + hstepB + PG8_KT(0), voffB); PG8_STAGE(PG8_SA(0, 1), cA + hstepA + PG8_KT(0), voffA);
        if (wr == 1) PG8_BAR;
        PG8_WAIT_V(4); PG8_BAR;
        PG8_STAGE(PG8_SB(1, 0), cB + PG8_KT(1), voffB); PG8_STAGE(PG8_SA(1, 0), cA + PG8_KT(1), voffA); PG8_STAGE(PG8_SB(1, 1), cB + hstepB + PG8_KT(1), voffB);
        PG8_WAIT_V(6); PG8_BAR;
    }
    for (;;) {
        const bool has_next = S.next(ui + 1, nxt);
        const char* nA = has_next ? (const char*)g.A + (size_t)nxt.pm * tstepA : cA; const char* nB = has_next ? (const char*)g.Bt + (size_t)nxt.pn * tstepB : cB;
        for (int t = 0; t < nt; t += 2) {
            const bool last = (t == nt - 2);
            const char* a1 = cA + PG8_KT(t + 1);
            const char* a2 = last ? nA + PG8_KT(0) : cA + PG8_KT(t + 2); const char* b2 = last ? nB + PG8_KT(0) : cB + PG8_KT(t + 2);
            const char* a3 = Epi::KROT != 0 ? (last ? nA + PG8_KT(1) : cA + PG8_KT(t + 3)) : a2 + kstep; const char* b3 = Epi::KROT != 0 ? (last ? nB + PG8_KT(1) : cB + PG8_KT(t + 3)) : b2 + kstep;
            if constexpr (Epi::KROT != 0) { if (t == Epi::HOOK0 || t == Epi::HOOK1) E.khook(acc, t, wr, fr, ui, lds); }
            if (last && has_next) S.a_ready(nxt);
            if constexpr (SP2) {
            PG8_LDB(B0, 0, 0); PG8_LDB(B1, 0, 1); PG8_SCHED; PG8_LDA(At, 0, 0); PG8_STAGE(PG8_SA(1, 1), a1 + hstepA, voffA);
            PG8_WAIT_V(8); PG8_WAIT_L(0); PG8_BAR; PG8_MMA(0, 0, At, B0); PG8_MMA(0, 1, At, B1); PG8_BAR; PG8_SCHED;
            PG8_LDA(At, 0, 1); PG8_STAGE(PG8_SB(0, 0), b2, voffB); PG8_STAGE(PG8_SB(0, 1), b2 + hstepB, voffB); PG8_STAGE(PG8_SA(0, 0), a2, voffA);
            PG8_WAIT_V(8); PG8_WAIT_L(0); PG8_BAR; PG8_MMA(1, 0, At, B0); PG8_MMA(1, 1, At, B1); PG8_BAR; PG8_SCHED;
            PG8_LDB(B0, 1, 0); PG8_LDB(B1, 1, 1); PG8_SCHED; PG8_LDA(At, 1, 0); PG8_STAGE(PG8_SA(0, 1), a2 + hstepA, voffA);
            PG8_WAIT_V(8); PG8_WAIT_L(0); PG8_BAR; PG8_MMA(0, 0, At, B0); PG8_MMA(0, 1, At, B1); PG8_BAR; PG8_SCHED;
            PG8_LDA(At, 1, 1); PG8_STAGE(PG8_SB(1, 0), b3, voffB); PG8_STAGE(PG8_SB(1, 1), b3 + hstepB, voffB); PG8_STAGE(PG8_SA(1, 0), a3, voffA);
            PG8_WAIT_V(8); PG8_WAIT_L(0); PG8_BAR; PG8_MMA(1, 0, At, B0); PG8_MMA(1, 1, At, B1); PG8_BAR; PG8_SCHED;
            } else {
            PG8_LDB(B0, 0, 0); PG8_SCHED; PG8_LDA(At, 0, 0); PG8_STAGE(PG8_SA(1, 1), a1 + hstepA, voffA);
            PG8_WAIT_L(8); PG8_BAR; PG8_WAIT_L(0); PG8_MMA(0, 0, At, B0); PG8_BAR; PG8_SCHED;
            PG8_LDB(B1, 0, 1); PG8_STAGE(PG8_SB(0, 0), b2, voffB);
            PG8_BAR; PG8_WAIT_L(0); PG8_MMA(0, 1, At, B1); PG8_BAR;
            PG8_LDA(At, 0, 1); PG8_STAGE(PG8_SA(0, 0), a2, voffA);
            PG8_BAR; PG8_WAIT_L(0); PG8_MMA(1, 0, At, B0); PG8_BAR; PG8_SCHED;
            PG8_STAGE(PG8_SB(0, 1), b2 + hstepB, voffB);
            PG8_WAIT_V(6); PG8_BAR; PG8_MMA(1, 1, At, B1); PG8_BAR;
            PG8_LDB(B0, 1, 0); PG8_SCHED; PG8_LDA(At, 1, 0); PG8_STAGE(PG8_SA(0, 1), a2 + hstepA, voffA);
            PG8_WAIT_L(8); PG8_BAR; PG8_WAIT_L(0); PG8_MMA(0, 0, At, B0); PG8_BAR; PG8_SCHED;
            PG8_LDB(B1, 1, 1); PG8_STAGE(PG8_SB(1, 0), b3, voffB);
            PG8_BAR; PG8_WAIT_L(0); PG8_MMA(0, 1, At, B1); PG8_BAR;
            PG8_LDA(At, 1, 1); PG8_STAGE(PG8_SA(1, 0), a3, voffA);
            PG8_BAR; PG8_WAIT_L(0); PG8_MMA(1, 0, At, B0); PG8_BAR; PG8_SCHED;
            PG8_STAGE(PG8_SB(1, 1), b3 + hstepB, voffB);
            PG8_WAIT_V(6); PG8_BAR; PG8_MMA(1, 1, At, B1); PG8_BAR;
            }
        }
        if constexpr (ALIGN_EPI) { if (wr == 0) PG8_BAR; }
        if constexpr (!Epi::AFTER_DRAIN) { E(acc, cur, wr, wc, fr, fq, ui, has_next, nxt, lds, tid); S.done(cur); }
        if (!has_next) break;
#pragma unroll
        for (int a = 0; a < 2; ++a)
#pragma unroll
            for (int b = 0; b < 2; ++b)
#pragma unroll
                for (int m = 0; m < 4; ++m)
#pragma unroll
                    for (int n = 0; n < 2; ++n) acc[a][b][m][n] = (f32x4){0.f, 0.f, 0.f, 0.f};
        cur = nxt; cA = nA; cB = nB; ++ui;
        if constexpr (ALIGN_EPI) { if (wr == 1) PG8_BAR; }
    }
    PG8_WAIT_V(0);
    if constexpr (!ALIGN_EPI) { if (wr == 0) PG8_BAR; }
    PG8_BAR;
    if constexpr (Epi::AFTER_DRAIN) { E.fused(acc, cur, wr, wc, fr, fq, lds, wid, lane); S.done(cur); }
#undef PG8_KT
#undef PG8_SA
#undef PG8_SB
#undef PG8_STAGE
#undef PG8_LDA
#undef PG8_LDB
#undef PG8_MMA
#undef PG8_WAIT_V
#undef PG8_WAIT_L
#undef PG8_BAR
#undef PG8_SCHED
}
}

constexpr int NWAVES = 8;
#ifndef WGM_UP
#define WGM_UP 8
#endif
#ifndef WGM_DN
#define WGM_DN 4
#endif
#ifndef WGM_IN
#define WGM_IN 4
#endif
#ifndef MK_PER_PHASE
#define MK_PER_PHASE 0
#endif
constexpr int DM = 2048, FF = 5632, NL = 4, MTOK = 32768, MPROMPT = 16384, TP = 2048, TS = 4096;
constexpr int INC = 5120, NAW = 512, HGW = 512, S5W = 1024;
constexpr float EPS = 1e-6f;
constexpr int PH_PER_LAYER = 14, N_PHASES = NL * PH_PER_LAYER;

constexpr size_t MiB = 1u << 20;
constexpr size_t WS_CTL = 1477 * MiB, CTL_ZERO_BYTES = 1 * MiB;
constexpr size_t WS_TAB = 1 * MiB;
constexpr size_t WS_WGU1 = 2 * MiB, WS_WD1 = 46 * MiB, WS_WIN = 68 * MiB, WS_WGLU = 88 * MiB, WS_WOUT = 90 * MiB, WS_WGU2 = 98 * MiB, WS_WD2 = 142 * MiB;
constexpr size_t WS_XB = 164 * MiB;
constexpr size_t WS_H = 292 * MiB;
constexpr size_t WS_Q = 292 * MiB, WS_K = 324 * MiB, WS_V = 356 * MiB, WS_QH = 388 * MiB, WS_VH = 420 * MiB, WS_GH = 452 * MiB, WS_LFF = 484 * MiB, WS_LFB = 548 * MiB;
constexpr size_t WS_UX = 644 * MiB;
constexpr size_t WS_CAT = 772 * MiB;
constexpr size_t WS_YPRE = 900 * MiB, WS_Y2 = 964 * MiB;
constexpr size_t WS_O = 1028 * MiB;
constexpr size_t WS_OF = 1060 * MiB, WS_OB = 1124 * MiB;
constexpr size_t WS_YF = 1188 * MiB;
constexpr size_t WS_S5E = 1316 * MiB, WS_S5Y = 1324 * MiB;
constexpr size_t WS_E = WS_YF;
constexpr size_t WS_LT = WS_OF;
constexpr size_t WS_SIN = 1340 * MiB;
constexpr size_t WS_HD = 1468 * MiB;
constexpr size_t WS_SS = 1470 * MiB, SS_BYTES = 7 * MiB;
constexpr size_t WS_END = 1478 * MiB;
constexpr int CW_TMO = 0, CW_CODE = 1, CW_BAR = 4096;

constexpr int RING_OFF = 0, RING_BYTES = 131072;
constexpr int LDSCTL_OFF = RING_BYTES, MISC_OFF = LDSCTL_OFF + 320;
constexpr int LDS_BYTES = 147456;

#define GAS __attribute__((address_space(1)))
#define LAS __attribute__((address_space(3)))
typedef unsigned short bf16;
typedef unsigned v4u __attribute__((ext_vector_type(4)));
typedef unsigned v2u __attribute__((ext_vector_type(2)));
typedef float f32x4 __attribute__((ext_vector_type(4)));
typedef short bf16x8 __attribute__((ext_vector_type(8)));
typedef GAS unsigned gu32;
#define RLX_AGENT __ATOMIC_RELAXED, __HIP_MEMORY_SCOPE_AGENT
#define LDS_WAIT() asm volatile("s_waitcnt lgkmcnt(0)" ::: "memory")
#define VM_WAIT() asm volatile("s_waitcnt vmcnt(0)" ::: "memory")
__device__ __forceinline__ unsigned f2bf(float f) { unsigned u = __builtin_bit_cast(unsigned, f); return (u + 0x7fffu + ((u >> 16) & 1u)) >> 16; }
typedef float f32x2_t __attribute__((ext_vector_type(2)));
typedef __bf16 bf16x2_t __attribute__((ext_vector_type(2)));
__device__ __forceinline__ unsigned pk2(float lo, float hi) { const f32x2_t v = {lo, hi}; const bf16x2_t b = __builtin_convertvector(v, bf16x2_t); return __builtin_bit_cast(unsigned, b); }
__device__ __forceinline__ float bflo(unsigned w) { return __builtin_bit_cast(float, w << 16); }
__device__ __forceinline__ float bfhi(unsigned w) { return __builtin_bit_cast(float, w & 0xffff0000u); }
__device__ __forceinline__ float bf2f(bf16 b) { return __builtin_bit_cast(float, ((unsigned)b) << 16); }
__device__ __forceinline__ float fast_rcp(float x) { return __builtin_amdgcn_rcpf(x); }
__device__ __forceinline__ float fast_rsq(float x) { return __builtin_amdgcn_rsqf(x); }
__device__ __forceinline__ void fast_sincos(float x, float& s, float& c) { float r = x * 0.15915494309189535f; r = r - floorf(r); s = __builtin_amdgcn_sinf(r); c = __builtin_amdgcn_cosf(r); }
__device__ __forceinline__ float sigmoidf_(float x) { return fast_rcp(1.0f + __expf(-x)); }
__device__ __forceinline__ float siluf_(float x) { return x * sigmoidf_(x); }
__device__ __forceinline__ float gelu_tanh(float x) {
    const float t = 1.5957691216057308f * (x + 0.044715f * x * x * x);
    return x * sigmoidf_(t);
}
template <int MASK> __device__ __forceinline__ float xshfl(float v, int lane) {
    if (MASK < 32) return __builtin_bit_cast(float, __builtin_amdgcn_ds_swizzle(__builtin_bit_cast(int, v), (MASK << 10) | 0x1f));
    else return __builtin_bit_cast(float, __builtin_amdgcn_ds_bpermute((lane ^ 32) << 2, __builtin_bit_cast(int, v)));
}
__device__ __forceinline__ float lane_bcast(float v, int src) { return __builtin_bit_cast(float, __builtin_amdgcn_ds_bpermute(src << 2, __builtin_bit_cast(int, v))); }
__device__ __forceinline__ float wave_sum(float v, int lane) {
    v += xshfl<1>(v, lane); v += xshfl<2>(v, lane); v += xshfl<4>(v, lane); v += xshfl<8>(v, lane); v += xshfl<16>(v, lane); v += xshfl<32>(v, lane); return v;
}
__device__ __forceinline__ float wave_max(float v, int lane) {
    v = fmaxf(v, xshfl<1>(v, lane)); v = fmaxf(v, xshfl<2>(v, lane)); v = fmaxf(v, xshfl<4>(v, lane)); v = fmaxf(v, xshfl<8>(v, lane)); v = fmaxf(v, xshfl<16>(v, lane)); v = fmaxf(v, xshfl<32>(v, lane)); return v;
}
typedef unsigned long long u64;
__device__ __forceinline__ u64 ss_fix(float s) { return (u64)(s * 1048576.0f + 0.5f); }
__device__ __forceinline__ float ss_val(u64 v) { return (float)v * (1.0f / 1048576.0f); }
constexpr int ROWSC_OFF = RING_BYTES + 1024;
constexpr int NA_BIAS_OFF = RING_BYTES + 4096;
struct RowScale {
    const u64* ssa; const u64* ssb; bool useb;
    __device__ __forceinline__ float conv(u64 a, u64 b2) const { const float rs = fast_rsq(ss_val(a) * (1.0f / DM) + EPS); const float r2 = fast_rsq(rs * rs * ss_val(b2) * (1.0f / DM) + EPS); return useb ? rs * r2 : rs; }
    __device__ __forceinline__ void issue(int pm, int tid, u64& a, u64& b2) const { a = ssa[pm * 256 + (tid & 255)]; b2 = ssb[pm * 256 + (tid & 255)]; }
    __device__ __forceinline__ void commit(LAS unsigned char* lds, int slot, int tid, u64 a, u64 b2) const { ((LAS float*)(lds + ROWSC_OFF))[slot * 256 + (tid & 255)] = conv(a, b2); }
    __device__ __forceinline__ float get(LAS unsigned char* lds, int slot, int idx) const { return ((LAS float*)(lds + ROWSC_OFF))[slot * 256 + idx]; }
};
#define XB_TMO      128
#define XB_XCNT(j)  (256  + 64 * (j))
#define XB_XSUB(j)  (1280 + 64 * (j))
#define XB_XGEN(j)  (2304 + 64 * (j))
#define XB_TOP      3328
#define XB_TOPGEN   3392
#define XCD_BAR_WORDS 3456
#define XB_SPIN_CAP (1u << 18)

__device__ __forceinline__ unsigned xb_ld(unsigned* p)              { return __hip_atomic_load(p, __ATOMIC_RELAXED, __HIP_MEMORY_SCOPE_AGENT); }
__device__ __forceinline__ unsigned xb_add(unsigned* p, unsigned v) { return __hip_atomic_fetch_add(p, v, __ATOMIC_RELAXED, __HIP_MEMORY_SCOPE_AGENT); }
__device__ __forceinline__ unsigned xb_xcc_id() { return (unsigned)__builtin_amdgcn_s_getreg((3 << 11) | 20) & 0xFu; }
#define XB_SPIN(cond, bar) do { unsigned _sp = 0; while (cond) { __builtin_amdgcn_s_sleep(1); \
    if ((++_sp & 255u) == 0u) { if (xb_ld(&(bar)[XB_TMO])) break; if (_sp > XB_SPIN_CAP) { atomicAdd(&(bar)[XB_TMO], 1u); break; } } } } while (0)

struct XcdBarrier {
    unsigned* bar; unsigned x;
    volatile LAS unsigned* st;
    bool t0;
};

__device__ __forceinline__ XcdBarrier xcd_barrier_post(unsigned* bar, volatile LAS unsigned* st) {
    XcdBarrier b; b.bar = bar; b.x = xb_xcc_id(); b.st = st; b.t0 = (threadIdx.x == 0);
    if (threadIdx.x == 0) (void)xb_add(&bar[XB_XCNT(b.x)], 1u);
    return b;
}
__device__ __forceinline__ void xcd_barrier_complete(unsigned* bar, unsigned x, unsigned& nloc, unsigned& nx) {
    const unsigned G = gridDim.x * gridDim.y * gridDim.z;
    unsigned sum, cnt, mine, sp = 0u;
    for (;;) {
        sum = 0u; cnt = 0u; mine = 0u;
#pragma unroll
        for (unsigned j = 0; j < 16; ++j) { const unsigned c = xb_ld(&bar[XB_XCNT(j)]); sum += c; cnt += (c > 0u) ? 1u : 0u; mine = (j == x) ? c : mine; }
        if (sum == G) break;
        __builtin_amdgcn_s_sleep(1);
        if ((++sp & 255u) == 0u) { if (xb_ld(&bar[XB_TMO])) break; if (sp > XB_SPIN_CAP) { atomicAdd(&bar[XB_TMO], 1u); break; } }
    }
    nloc = mine > 0u ? mine : 1u; nx = cnt > 0u ? cnt : 1u;
}

__device__ __forceinline__ void xcd_barrier(const XcdBarrier& b) {
    asm volatile("s_waitcnt vmcnt(0)" ::: "memory");
    __syncthreads();
    if (b.t0) {
        unsigned* bar = b.bar;
        __builtin_amdgcn_s_waitcnt(0);
        unsigned nloc = b.st[0], nx = b.st[1];
        if (nloc == 0u) { xcd_barrier_complete(bar, b.x, nloc, nx); b.st[0] = nloc; b.st[1] = nx; }
        const unsigned old = xb_add(&bar[XB_XSUB(b.x)], 1u);
        const unsigned gen = old / nloc;
        if (old + 1u == (gen + 1u) * nloc) {
            __builtin_amdgcn_fence(__ATOMIC_RELEASE, "agent");
            asm volatile("s_waitcnt vmcnt(0)" ::: "memory");
            const unsigned og = xb_add(&bar[XB_TOP], 1u);
            const unsigned tg = og / nx;
            if (og + 1u == (tg + 1u) * nx) xb_add(&bar[XB_TOPGEN], 1u);
            else XB_SPIN(xb_ld(&bar[XB_TOPGEN]) == tg, bar);
            __builtin_amdgcn_fence(__ATOMIC_ACQUIRE, "agent");
            xb_add(&bar[XB_XGEN(b.x)], 1u);
            asm volatile("s_waitcnt vmcnt(0)" ::: "memory");
        } else {
            XB_SPIN(xb_ld(&bar[XB_XGEN(b.x)]) == gen, bar);
            __builtin_amdgcn_fence(__ATOMIC_ACQUIRE, "agent");
            asm volatile("s_waitcnt vmcnt(0)" ::: "memory");
        }
    }
    __syncthreads();
}

using pg8::Unit;
struct EpiSwiGLU {
    static constexpr bool PERM = true, AFTER_DRAIN = false; static constexpr int KROT = 0;
    __device__ __forceinline__ void first(const Unit& u, LAS unsigned char* lds, int tid) const { u64 a, b2; rsc.issue(u.pm, tid, a, b2); rsc.commit(lds, 0, tid, a, b2); }
    bf16* H; RowScale rsc;
    __device__ __forceinline__ void operator()(const f32x4 (&acc)[2][2][4][2], const Unit& u, int wr, int wc, int fr, int fq, int ui, bool has_next, const Unit& nxt, LAS unsigned char* lds, int tid) const {
        const int row0 = u.pm * 256 + wr * 64 + fr, col0 = u.pn * 128 + wc * 32 + 8 * fq;
        u64 na, nb; rsc.issue(has_next ? nxt.pm : u.pm, tid, na, nb);
#pragma unroll
        for (int ai = 0; ai < 2; ++ai)
#pragma unroll
            for (int m = 0; m < 4; ++m) {
                const int row = row0 + ai * 128 + m * 16;
                const float rs = rsc.get(lds, ui & 1, ai * 128 + wr * 64 + m * 16 + fr);
                bf16* rowp = H + (size_t)row * FF + col0;
                float h[8];
#pragma unroll
                for (int n = 0; n < 2; ++n)
#pragma unroll
                    for (int i = 0; i < 4; ++i) { const float g = acc[ai][0][m][n][i] * rs, uu = acc[ai][1][m][n][i] * rs; h[4 * n + i] = siluf_(g) * uu; }
                v4u w; w.x = pk2(h[0], h[1]); w.y = pk2(h[2], h[3]); w.z = pk2(h[4], h[5]); w.w = pk2(h[6], h[7]);
                *(v4u*)rowp = w;
            }
        rsc.commit(lds, (ui + 1) & 1, tid, na, nb);
    }
};
struct EpiResid {
    static constexpr bool PERM = true, AFTER_DRAIN = false; static constexpr int KROT = 0;
    __device__ __forceinline__ void first(const Unit&, LAS unsigned char*, int) const {}
    bf16* XB; float scale; const u64* pre_ss; bool has_pre; const float* pre_g; u64* ssa; u64* ssb; const float* gb;
    __device__ __forceinline__ void operator()(const f32x4 (&acc)[2][2][4][2], const Unit& u, int wr, int wc, int fr, int fq, int ui, bool has_next, const Unit& nxt, LAS unsigned char* lds, int tid) const {
        const int row0 = u.pm * 256 + wr * 64 + fr, col0 = u.pn * 256 + wc * 32 + 8 * fq;
        f32x4 pg[2][2], g2[2][2];
#pragma unroll
        for (int bj = 0; bj < 2; ++bj)
#pragma unroll
            for (int n = 0; n < 2; ++n) { pg[bj][n] = has_pre ? *(const f32x4*)(pre_g + col0 + bj * 128 + n * 4) : (f32x4){1.f, 1.f, 1.f, 1.f};
                if (ssb) { const f32x4 t = *(const f32x4*)(gb + col0 + bj * 128 + n * 4); g2[bj][n] = t * t; } else g2[bj][n] = (f32x4){0.f, 0.f, 0.f, 0.f}; }
#pragma unroll
        for (int ai = 0; ai < 2; ++ai) {
            v4u xw[4][2]; u64 ps[4];
#pragma unroll
            for (int m = 0; m < 4; ++m) { const int row = row0 + ai * 128 + m * 16; ps[m] = pre_ss[row];
#pragma unroll
                for (int bj = 0; bj < 2; ++bj) xw[m][bj] = *(const v4u*)(XB + (size_t)row * DM + col0 + bj * 128); }
#pragma unroll
            for (int m = 0; m < 4; ++m) {
                const int row = row0 + ai * 128 + m * 16;
                const float r1 = has_pre ? fast_rsq(ss_val(ps[m]) * (1.0f / DM) + EPS) : 1.0f;
                float sa = 0.f, sb = 0.f;
#pragma unroll
                for (int bj = 0; bj < 2; ++bj) { const v4u w0 = xw[m][bj]; f32x4 xn[2];
                    const f32x4 xo[2] = {(f32x4){bflo(w0.x), bfhi(w0.x), bflo(w0.y), bfhi(w0.y)}, (f32x4){bflo(w0.z), bfhi(w0.z), bflo(w0.w), bfhi(w0.w)}};
#pragma unroll
                    for (int n = 0; n < 2; ++n) { xn[n] = xo[n] * (pg[bj][n] * r1) + acc[ai][bj][m][n] * scale;
                        const f32x4 sq = xn[n] * xn[n]; sa += (sq[0] + sq[1]) + (sq[2] + sq[3]);
                        if (ssb) { const f32x4 sg = sq * g2[bj][n]; sb += (sg[0] + sg[1]) + (sg[2] + sg[3]); } }
                    v4u w; w.x = pk2(xn[0][0], xn[0][1]); w.y = pk2(xn[0][2], xn[0][3]); w.z = pk2(xn[1][0], xn[1][1]); w.w = pk2(xn[1][2], xn[1][3]);
                    *(v4u*)(XB + (size_t)row * DM + col0 + bj * 128) = w; }
                sa += xshfl<16>(sa, 16 * fq + fr); sa += xshfl<32>(sa, 16 * fq + fr);
                if (ssb) { sb += xshfl<16>(sb, 16 * fq + fr); sb += xshfl<32>(sb, 16 * fq + fr); }
                if (fq == 0) { atomicAdd(ssa + row, ss_fix(sa)); if (ssb) atomicAdd(ssb + row, ss_fix(sb)); }
            }
        }
    }
};
struct EpiResidW {
    static constexpr bool PERM = true, AFTER_DRAIN = false; static constexpr int KROT = 16, HOOK0 = 16, HOOK1 = 24;
    bf16* XB; const u64* ssA; const u64* ssC; u64* ssa;
    typedef float f32x2w __attribute__((ext_vector_type(2)));
    __device__ __forceinline__ f32x2w conv(u64 a, u64 cc) const { const float ra = fast_rsq(ss_val(a) * (1.0f / 512.0f) + EPS), rc = fast_rsq(ss_val(cc) * (1.0f / 1024.0f) + EPS); return (f32x2w){ra, rc / ra}; }
    __device__ __forceinline__ void first(const Unit& u, LAS unsigned char* lds, int tid) const { const u64 a = ssA[u.pm * 256 + (tid & 255)], cc = ssC[u.pm * 256 + (tid & 255)]; ((LAS f32x2w*)(lds + ROWSC_OFF))[tid & 255] = conv(a, cc); }
    __device__ __forceinline__ void khook(f32x4 (&acc)[2][2][4][2], int t, int wr, int fr, int ui, LAS unsigned char* lds) const {
        const LAS f32x2w* sl = (const LAS f32x2w*)(lds + ROWSC_OFF) + (ui & 1) * 256;
#pragma unroll
        for (int ai = 0; ai < 2; ++ai)
#pragma unroll
            for (int m = 0; m < 4; ++m) { const f32x2w sc = sl[ai * 128 + wr * 64 + m * 16 + fr]; const float f = (t == HOOK0) ? sc.y : sc.x;
#pragma unroll
                for (int bj = 0; bj < 2; ++bj)
#pragma unroll
                    for (int n = 0; n < 2; ++n) acc[ai][bj][m][n] = acc[ai][bj][m][n] * f; }
    }
    __device__ __forceinline__ void operator()(const f32x4 (&acc)[2][2][4][2], const Unit& u, int wr, int wc, int fr, int fq, int ui, bool has_next, const Unit& nxt, LAS unsigned char* lds, int tid) const {
        const int row0 = u.pm * 256 + wr * 64 + fr, col0 = u.pn * 256 + wc * 32 + 8 * fq;
        const int pmn = has_next ? nxt.pm : u.pm; const u64 na = ssA[pmn * 256 + (tid & 255)], nc = ssC[pmn * 256 + (tid & 255)];
#pragma unroll
        for (int ai = 0; ai < 2; ++ai) {
            v4u xw[4][2];
#pragma unroll
            for (int m = 0; m < 4; ++m)
#pragma unroll
                for (int bj = 0; bj < 2; ++bj) xw[m][bj] = *(const v4u*)(XB + (size_t)(row0 + ai * 128 + m * 16) * DM + col0 + bj * 128);
#pragma unroll
            for (int m = 0; m < 4; ++m) {
                const int row = row0 + ai * 128 + m * 16; float sa = 0.f;
#pragma unroll
                for (int bj = 0; bj < 2; ++bj) { const v4u w0 = xw[m][bj]; f32x4 xn[2];
                    const f32x4 xo[2] = {(f32x4){bflo(w0.x), bfhi(w0.x), bflo(w0.y), bfhi(w0.y)}, (f32x4){bflo(w0.z), bfhi(w0.z), bflo(w0.w), bfhi(w0.w)}};
#pragma unroll
                    for (int n = 0; n < 2; ++n) { xn[n] = xo[n] + acc[ai][bj][m][n]; const f32x4 sq = xn[n] * xn[n]; sa += (sq[0] + sq[1]) + (sq[2] + sq[3]); }
                    v4u w; w.x = pk2(xn[0][0], xn[0][1]); w.y = pk2(xn[0][2], xn[0][3]); w.z = pk2(xn[1][0], xn[1][1]); w.w = pk2(xn[1][2], xn[1][3]);
                    *(v4u*)(XB + (size_t)row * DM + col0 + bj * 128) = w; }
                sa += xshfl<16>(sa, 16 * fq + fr); sa += xshfl<32>(sa, 16 * fq + fr);
                if (fq == 0) atomicAdd(ssa + row, ss_fix(sa));
            }
        }
        ((LAS f32x2w*)(lds + ROWSC_OFF))[((ui + 1) & 1) * 256 + (tid & 255)] = conv(na, nc);
    }
};
struct EpiWin {
    static constexpr bool PERM = true, AFTER_DRAIN = false; static constexpr int KROT = 0;
    __device__ __forceinline__ void first(const Unit& u, LAS unsigned char* lds, int tid) const { u64 a, b2; rsc.issue(u.pm, tid, a, b2); rsc.commit(lds, 0, tid, a, b2); }
    bf16 *Q, *K, *V, *QH, *VH, *GH, *LFF, *LFB; bf16* UX; const float *qn, *kn, *lb; RowScale rsc;
    __device__ __forceinline__ void operator()(const f32x4 (&acc_)[2][2][4][2], const Unit& u, int wr, int wc, int fr, int fq, int ui, bool has_next, const Unit& nxt, LAS unsigned char* lds, int tid) const {
        const int row0 = u.pm * 256 + wr * 64 + fr, pn = u.pn, seg = pn >> 1;
        u64 na, nb; rsc.issue(has_next ? nxt.pm : u.pm, tid, na, nb);
        f32x4 acc[2][2][4][2];
#pragma unroll
        for (int ai = 0; ai < 2; ++ai)
#pragma unroll
            for (int m = 0; m < 4; ++m) { const float rs = rsc.get(lds, ui & 1, ai * 128 + wr * 64 + m * 16 + fr);
#pragma unroll
                for (int bj = 0; bj < 2; ++bj)
#pragma unroll
                    for (int n = 0; n < 2; ++n) acc[ai][bj][m][n] = acc_[ai][bj][m][n] * rs; }
        const int cbase = (pn & 1) * 256 + 64 * wc + 8 * fq;
        if (seg <= 1) {
            const float* gn = seg == 0 ? qn : kn; bf16* dst = seg == 0 ? Q : K;
            float gv[2][8];
#pragma unroll
            for (int bj = 0; bj < 2; ++bj) { const f32x4 a = *(const f32x4*)(gn + 32 * bj + 8 * fq), b = *(const f32x4*)(gn + 32 * bj + 8 * fq + 4);
                gv[bj][0] = a[0]; gv[bj][1] = a[1]; gv[bj][2] = a[2]; gv[bj][3] = a[3]; gv[bj][4] = b[0]; gv[bj][5] = b[1]; gv[bj][6] = b[2]; gv[bj][7] = b[3]; }
#pragma unroll
            for (int ai = 0; ai < 2; ++ai)
#pragma unroll
                for (int m = 0; m < 4; ++m) {
                    float ss = 0.f;
#pragma unroll
                    for (int bj = 0; bj < 2; ++bj)
#pragma unroll
                        for (int n = 0; n < 2; ++n) { const f32x4 x = acc[ai][bj][m][n]; ss += (x[0] * x[0] + x[1] * x[1]) + (x[2] * x[2] + x[3] * x[3]); }
                    ss += xshfl<16>(ss, 16 * fq + fr); ss += xshfl<32>(ss, 16 * fq + fr);
                    const float rstd = fast_rsq(ss * (1.0f / 64.0f) + EPS);
                    bf16* rowp = dst + (size_t)(row0 + ai * 128 + m * 16) * 512 + cbase;
#pragma unroll
                    for (int bj = 0; bj < 2; ++bj) { const f32x4 x0 = acc[ai][bj][m][0] * rstd, x1 = acc[ai][bj][m][1] * rstd; v4u w;
                        w.x = pk2(x0[0] * gv[bj][0], x0[1] * gv[bj][1]); w.y = pk2(x0[2] * gv[bj][2], x0[3] * gv[bj][3]); w.z = pk2(x1[0] * gv[bj][4], x1[1] * gv[bj][5]); w.w = pk2(x1[2] * gv[bj][6], x1[3] * gv[bj][7]);
                        *(v4u*)(rowp + 32 * bj) = w; }
                }
        } else if (seg == 2 || seg == 3 || seg == 6 || seg == 7) {
            bf16* dst = seg == 2 ? V : (seg == 3 ? QH : (seg == 6 ? VH : GH)); const bool act = (seg == 3 || seg == 7);
#pragma unroll
            for (int ai = 0; ai < 2; ++ai)
#pragma unroll
                for (int m = 0; m < 4; ++m) {
                    bf16* rowp = dst + (size_t)(row0 + ai * 128 + m * 16) * 512 + cbase;
#pragma unroll
                    for (int bj = 0; bj < 2; ++bj) { f32x4 x0 = acc[ai][bj][m][0], x1 = acc[ai][bj][m][1];
                        if (act) {
#pragma unroll
                            for (int i = 0; i < 4; ++i) { x0[i] = siluf_(x0[i]); x1[i] = siluf_(x1[i]); } }
                        v4u w; w.x = pk2(x0[0], x0[1]); w.y = pk2(x0[2], x0[3]); w.z = pk2(x1[0], x1[1]); w.w = pk2(x1[2], x1[3]);
                        *(v4u*)(rowp + 32 * bj) = w; }
                }
        } else if (seg == 4 || seg == 5) {
            bf16* dst = seg == 4 ? LFF : LFB; const float* lbp = lb + (seg - 4) * 512 + cbase;
            f32x4 lbv[2][2];
#pragma unroll
            for (int bj = 0; bj < 2; ++bj) { lbv[bj][0] = *(const f32x4*)(lbp + 32 * bj); lbv[bj][1] = *(const f32x4*)(lbp + 32 * bj + 4); }
#pragma unroll
            for (int ai = 0; ai < 2; ++ai)
#pragma unroll
                for (int m = 0; m < 4; ++m) {
                    bf16* rowp = dst + (size_t)(row0 + ai * 128 + m * 16) * 512 + cbase;
#pragma unroll
                    for (int bj = 0; bj < 2; ++bj) { float o[8];
#pragma unroll
                        for (int n = 0; n < 2; ++n)
#pragma unroll
                            for (int i = 0; i < 4; ++i) { const float l = lbv[bj][n][i]; o[4 * n + i] = 0.69314718056f * __builtin_amdgcn_logf(l + (1.0f - l) * sigmoidf_(acc[ai][bj][m][n][i])); }
                        v4u w; w.x = pk2(o[0], o[1]); w.y = pk2(o[2], o[3]); w.z = pk2(o[4], o[5]); w.w = pk2(o[6], o[7]);
                        *(v4u*)(rowp + 32 * bj) = w; }
                }
        } else {
#pragma unroll
            for (int ai = 0; ai < 2; ++ai)
#pragma unroll
                for (int m = 0; m < 4; ++m) {
                    const int row = row0 + ai * 128 + m * 16;
#pragma unroll
                    for (int bj = 0; bj < 2; ++bj) { const int g = (pn - 16) * 16 + 4 * wc + 2 * bj + (fq >> 1);
                        bf16* p = UX + ((size_t)g * 2048 + (row >> 4)) * 512 + (row & 15) * 16 + 8 * (fq & 1);
                        const f32x4 x0 = acc[ai][bj][m][0], x1 = acc[ai][bj][m][1];
                        v4u w; w.x = pk2(x0[0], x0[1]); w.y = pk2(x0[2], x0[3]); w.z = pk2(x1[0], x1[1]); w.w = pk2(x1[2], x1[3]);
                        *(v4u*)p = w; }
                }
        }
        rsc.commit(lds, (ui + 1) & 1, tid, na, nb);
    }
};
struct EpiGLU {
    static constexpr bool PERM = true, AFTER_DRAIN = false; static constexpr int KROT = 0;
    __device__ __forceinline__ void first(const Unit&, LAS unsigned char*, int) const {}
    const bf16* YPRE; const float* bias; bf16* CATC; u64* ssc;
    __device__ __forceinline__ void operator()(const f32x4 (&acc)[2][2][4][2], const Unit& u, int wr, int wc, int fr, int fq, int ui, bool has_next, const Unit& nxt, LAS unsigned char* lds, int tid) const {
        const int row0 = u.pm * 256 + wr * 64 + fr, col0 = u.pn * 256 + wc * 32 + 8 * fq;
        f32x4 bv[2][2];
#pragma unroll
        for (int bj = 0; bj < 2; ++bj) { bv[bj][0] = *(const f32x4*)(bias + col0 + bj * 128); bv[bj][1] = *(const f32x4*)(bias + col0 + bj * 128 + 4); }
#pragma unroll
        for (int ai = 0; ai < 2; ++ai) {
            v4u ypv[4][2];
#pragma unroll
            for (int m = 0; m < 4; ++m)
#pragma unroll
                for (int bj = 0; bj < 2; ++bj) ypv[m][bj] = *(const v4u*)(YPRE + (size_t)(row0 + ai * 128 + m * 16) * S5W + col0 + bj * 128);
#pragma unroll
            for (int m = 0; m < 4; ++m) {
                const int row = row0 + ai * 128 + m * 16; const size_t off = (size_t)row * DM + col0; float ss = 0.f;
#pragma unroll
                for (int bj = 0; bj < 2; ++bj) { const v4u yp = ypv[m][bj];
                    const f32x4 z0 = acc[ai][bj][m][0] + bv[bj][0], z1 = acc[ai][bj][m][1] + bv[bj][1];
                    const float y[8] = {bflo(yp.x) * sigmoidf_(z0[0]), bfhi(yp.x) * sigmoidf_(z0[1]), bflo(yp.y) * sigmoidf_(z0[2]), bfhi(yp.y) * sigmoidf_(z0[3]),
                                        bflo(yp.z) * sigmoidf_(z1[0]), bfhi(yp.z) * sigmoidf_(z1[1]), bflo(yp.w) * sigmoidf_(z1[2]), bfhi(yp.w) * sigmoidf_(z1[3])};
#pragma unroll
                    for (int e = 0; e < 8; ++e) ss += y[e] * y[e];
                    v4u w; w.x = pk2(y[0], y[1]); w.y = pk2(y[2], y[3]); w.z = pk2(y[4], y[5]); w.w = pk2(y[6], y[7]);
                    *(v4u*)(CATC + off + bj * 128) = w; }
                ss += xshfl<16>(ss, 16 * fq + fr); ss += xshfl<32>(ss, 16 * fq + fr);
                if (fq == 0) atomicAdd(ssc + row, ss_fix(ss));
            }
        }
    }
};

struct S5Order {
    int G, c;
    __device__ __forceinline__ bool next(int i, Unit& u) const {
        int g, rt;
        if (G == 256) { if (i >= 2) return false; const int x = c & 7, s = c >> 3; g = 32 * i + x * 4 + (s >> 3); rt = s & 7; }
        else { const int id = i * G + c; if (id >= 512) return false; g = id >> 3; rt = id & 7; }
        u.pm = g * 8 + rt; u.pn = g; return true;
    }
    __device__ __forceinline__ void a_ready(const Unit&) const {}
    __device__ __forceinline__ void done(const Unit&) const {}
};
struct EpiS5E {
    static constexpr bool PERM = false, AFTER_DRAIN = false; static constexpr int KROT = 0;
    __device__ __forceinline__ void first(const Unit&, LAS unsigned char*, int) const {}
    bf16* E;
    __device__ __forceinline__ void operator()(const f32x4 (&acc)[2][2][4][2], const Unit& u, int wr, int wc, int fr, int fq, int ui, bool has_next, const Unit& nxt, LAS unsigned char* lds, int tid) const {
        const int row0 = u.pm * 256 + wr * 64 + fr, col0 = wc * 32 + 4 * fq;
#pragma unroll
        for (int ai = 0; ai < 2; ++ai)
#pragma unroll
            for (int m = 0; m < 4; ++m) { bf16* rowp = E + (size_t)(row0 + ai * 128 + m * 16) * 256 + col0;
#pragma unroll
                for (int bj = 0; bj < 2; ++bj)
#pragma unroll
                    for (int n = 0; n < 2; ++n) { const f32x4 x = acc[ai][bj][m][n]; v2u w; w.x = pk2(x[0], x[1]); w.y = pk2(x[2], x[3]); *(v2u*)(rowp + bj * 128 + n * 16) = w; } }
    }
};
struct EpiS5Y {
    static constexpr bool PERM = true, AFTER_DRAIN = false; static constexpr int KROT = 0;
    __device__ __forceinline__ void first(const Unit&, LAS unsigned char*, int) const {}
    bf16* YPRE;
    __device__ __forceinline__ void operator()(const f32x4 (&acc)[2][2][4][2], const Unit& u, int wr, int wc, int fr, int fq, int ui, bool has_next, const Unit& nxt, LAS unsigned char* lds, int tid) const {
        const int g = u.pn, chunk0 = (u.pm & 7) * 256 + wr * 64 + fr;
#pragma unroll
        for (int ai = 0; ai < 2; ++ai)
#pragma unroll
            for (int m = 0; m < 4; ++m) { const int chunk = chunk0 + ai * 128 + m * 16;
#pragma unroll
                for (int bj = 0; bj < 2; ++bj) { const int tok = chunk * 16 + 8 * bj + 2 * wc + (fq >> 1);
                    const f32x4 x0 = acc[ai][bj][m][0], x1 = acc[ai][bj][m][1];
                    v4u w; w.x = pk2(gelu_tanh(x0[0]), gelu_tanh(x0[1])); w.y = pk2(gelu_tanh(x0[2]), gelu_tanh(x0[3])); w.z = pk2(gelu_tanh(x1[0]), gelu_tanh(x1[1])); w.w = pk2(gelu_tanh(x1[2]), gelu_tanh(x1[3]));
                    *(v4u*)(YPRE + (size_t)tok * S5W + g * 16 + 8 * (fq & 1)) = w; } }
    }
};

struct Frame {
    LAS unsigned char* lds;
    volatile LAS unsigned* MISC;
    int tid, lane, wave, G, gw, NGW, bid, zi;
    unsigned char* ws; float* X;
};
struct Args { const float* in[33]; int ph_lo, ph_hi, li, pad; };
#define WSP(T, off) ((T*)(F.ws + (off)))
__device__ __forceinline__ int fresh_lane() { unsigned z = 0u; asm volatile("" : "+v"(z)); return (int)__builtin_amdgcn_mbcnt_hi(~0u, __builtin_amdgcn_mbcnt_lo(~0u, z)); }
template <class T> __device__ __forceinline__ T* opaque_ptr(T* p) {
    unsigned long long w = (unsigned long long)p; unsigned lo = (unsigned)w, hi = (unsigned)(w >> 32);
    asm volatile("" : "+v"(lo), "+v"(hi));
    lo = (unsigned)__builtin_amdgcn_readfirstlane((int)lo); hi = (unsigned)__builtin_amdgcn_readfirstlane((int)hi);
    return (T*)(((unsigned long long)hi << 32) | lo);
}
#define FA Frame& F, const Args& A
#define AIN(k) (A.in[(k) + F.zi])

__device__ __forceinline__ void conv_item(const float* W, int Nsrc, int K, int src_col0, bf16* WT, int dst_row0, int k0, LAS float* scr, int lane, const float* ga = nullptr, const float* gb = nullptr) {
    float wv[32];
#pragma unroll
    for (int i = 0; i < 32; ++i) { const int kk = 2 * i + (lane >> 5); wv[i] = __builtin_nontemporal_load(W + (size_t)(k0 + kk) * Nsrc + src_col0 + (lane & 31)); }
    const int c = lane & 7;
    f32x4 g0 = (f32x4){1.f, 1.f, 1.f, 1.f}, g1 = g0;
    if (ga) { g0 = *(const f32x4*)(ga + k0 + 8 * c); g1 = *(const f32x4*)(ga + k0 + 8 * c + 4); if (gb) { g0 = g0 * *(const f32x4*)(gb + k0 + 8 * c); g1 = g1 * *(const f32x4*)(gb + k0 + 8 * c + 4); } }
#pragma unroll
    for (int i = 0; i < 32; ++i) { const int kk = 2 * i + (lane >> 5); scr[kk * 33 + (lane & 31)] = wv[i]; }
    LDS_WAIT(); asm volatile("" ::: "memory");
#pragma unroll
    for (int j = 0; j < 4; ++j) { const int n = (lane >> 3) + 8 * j; const LAS float* s = scr + (8 * c) * 33 + n;
        v4u o; o.x = pk2(s[0 * 33] * g0[0], s[1 * 33] * g0[1]); o.y = pk2(s[2 * 33] * g0[2], s[3 * 33] * g0[3]); o.z = pk2(s[4 * 33] * g1[0], s[5 * 33] * g1[1]); o.w = pk2(s[6 * 33] * g1[2], s[7 * 33] * g1[3]);
        *(GAS v4u*)(WT + (size_t)(dst_row0 + n) * K + k0 + 8 * c) = o; }
    LDS_WAIT(); asm volatile("" ::: "memory");
}
__device__ __forceinline__ void conv_layer(FA, int l) {
    LAS float* scr = (LAS float*)(F.lds + RING_OFF + F.wave * 16384);
    constexpr int I_GU = 32 * 352, I_D = 88 * 64, I_IN = 32 * 160, I_GLU = 16 * 32, I_OUT = 32 * 64;
    constexpr int NITEMS = 2 * I_GU + 2 * I_D + I_IN + I_GLU + I_OUT;
    const size_t wff = (size_t)DM * FF;
    for (int it = F.gw; it < NITEMS; it += F.NGW) {
        int r = it;
        if (r < 2 * I_GU) { const int second = r >= I_GU; if (second) r -= I_GU;
            const int kb = r / 352, nbd = r % 352, tile = nbd >> 3, pb = nbd & 7, bj = pb >> 2, sub = pb & 3;
            const float* W = AIN(second ? (bj ? 28 : 27) : (bj ? 4 : 3)) + (size_t)l * wff;
            conv_item(W, FF, DM, 128 * tile + 32 * sub, WSP(bf16, second ? WS_WGU2 : WS_WGU1), 32 * nbd, 64 * kb, scr, F.lane, AIN(second ? 26 : 2) + l * DM, (!second && l > 0) ? AIN(30) + (l - 1) * DM : nullptr); continue; }
        r -= 2 * I_GU;
        if (r < 2 * I_D) { const int second = r >= I_D; if (second) r -= I_D;
            const int kb = r / 64, nbd = r % 64;
            conv_item(AIN(second ? 29 : 5) + (size_t)l * wff, DM, FF, 32 * nbd, WSP(bf16, second ? WS_WD2 : WS_WD1), 32 * nbd, 64 * kb, scr, F.lane); continue; }
        r -= 2 * I_D;
        if (r < I_IN) { const int kb = r / 160, nbd = r % 160, tile = nbd >> 3, pb = nbd & 7, bj = pb >> 2, wc = pb & 3;
            conv_item(AIN(7) + (size_t)l * DM * INC, INC, DM, 256 * tile + 32 * (2 * wc + bj), WSP(bf16, WS_WIN), 32 * nbd, 64 * kb, scr, F.lane, AIN(6) + l * DM); continue; }
        r -= I_IN;
        if (r < I_GLU) { const int kb = r / 32, nbd = r % 32;
            conv_item(AIN(22) + (size_t)l * S5W * S5W, S5W, S5W, 32 * nbd, WSP(bf16, WS_WGLU), 32 * nbd, 64 * kb, scr, F.lane); continue; }
        r -= I_GLU;
        { const int kb = r / 64, nbd = r % 64;
            const int k0 = 64 * kb;
            conv_item(AIN(25) + (size_t)l * DM * DM, DM, DM, 32 * nbd, WSP(bf16, WS_WOUT), 32 * nbd, k0, scr, F.lane, k0 < 512 ? AIN(11) + l * 512 : (k0 < 1024 ? nullptr : AIN(24) + l * 1024 - 1024)); }
    }
}
__device__ __forceinline__ void lb_table(FA) {
    float* LB = WSP(float, WS_TAB); const float* lg = AIN(12);
    for (int i = blockIdx.x * 512 + F.tid; i < 1024; i += F.G * 512) {
        float v[NL], mx = -1e30f;
#pragma unroll
        for (int l = 0; l < NL; ++l) { v[l] = lg[l * 1024 + i]; mx = fmaxf(mx, v[l]); }
        float s = 0.f;
#pragma unroll
        for (int l = 0; l < NL; ++l) { v[l] = expf(v[l] - mx); s += v[l]; }
        float c = 0.f;
#pragma unroll
        for (int l = 0; l < NL; ++l) { if (l > 0) c += v[l] / s; LB[l * 1024 + i] = c; }
    }
}
__device__ __forceinline__ const float* in_row(FA, int r) { return r < MPROMPT ? AIN(0) + (size_t)r * DM : AIN(1) + (size_t)(r - MPROMPT) * DM; }
__device__ __forceinline__ void prep_phase(FA) {
    bf16* XB = WSP(bf16, WS_XB); u64* SS0 = WSP(u64, WS_SS);
    for (int r = F.gw; r < MTOK; r += F.NGW) {
        const f32x4* xr = (const f32x4*)in_row(F, A, r) + F.lane; f32x4 v[8]; float s = 0.f;
#pragma unroll
        for (int j = 0; j < 8; ++j) { v[j] = __builtin_nontemporal_load(xr + 64 * j); s += (v[j][0] * v[j][0] + v[j][1] * v[j][1]) + (v[j][2] * v[j][2] + v[j][3] * v[j][3]); }
        s = wave_sum(s, F.lane); if (F.lane == 0) SS0[r] = ss_fix(s);
        v2u* o = (v2u*)(XB + (size_t)r * DM) + F.lane;
#pragma unroll
        for (int j = 0; j < 8; ++j) { v2u w; w.x = pk2(v[j][0], v[j][1]); w.y = pk2(v[j][2], v[j][3]); o[64 * j] = w; }
    }
}
__device__ __forceinline__ void out_norm_phase(FA, const u64* ss, const float* g) {
    const bf16* XB = WSP(bf16, WS_XB);
    for (int r = F.gw; r < MTOK; r += F.NGW) {
        f32x4* xr = (f32x4*)(F.X + (size_t)r * DM) + F.lane; const f32x4* gp = (const f32x4*)g + F.lane; const v2u* xb = (const v2u*)(XB + (size_t)r * DM) + F.lane;
        const float rstd = fast_rsq(ss_val(ss[r]) * (1.0f / DM) + EPS);
        v2u w[8];
#pragma unroll
        for (int j = 0; j < 8; ++j) w[j] = xb[64 * j];
#pragma unroll
        for (int j = 0; j < 8; ++j) __builtin_nontemporal_store((f32x4){bflo(w[j].x), bfhi(w[j].x), bflo(w[j].y), bfhi(w[j].y)} * rstd * gp[64 * j], xr + 64 * j);
    }
}
__device__ __forceinline__ void seq_of_row(int r, int& base, int& t, int& rows) {
    if (r < MPROMPT) { base = r & ~(TP - 1); t = r & (TP - 1); rows = TP / 64; } else { const int q = r - MPROMPT; base = MPROMPT + (q & ~(TS - 1)); t = q & (TS - 1); rows = TS / 64; }
}
__device__ __forceinline__ void seq_of_index(int s, int& base, int& T) { if (s < 8) { base = s * TP; T = TP; } else { base = MPROMPT + (s - 8) * TS; T = TS; } }

struct S5Par { float dre, ang, fre, fim; };
__device__ __forceinline__ S5Par s5_par(FA, int l, int dir, int g, int p) {
    const int pi = ((l * 2 + dir) * 64 + g) * 64 + p;
    const float are = AIN(14)[pi], aim = AIN(15)[pi], dt = expf(AIN(16)[(l * 2 + dir) * 64 + g]);
    const float mag = __expf(dt * are), ang = dt * aim; float sn_, cs_; fast_sincos(ang, sn_, cs_); const float abr = mag * cs_, abi = mag * sn_;
    const float den = are * are + aim * aim, nr = abr - 1.0f;
    S5Par r; r.dre = dt * are; r.ang = ang; r.fre = (nr * are + abi * aim) / den; r.fim = (abi * are - nr * aim) / den; return r;
}
__device__ __forceinline__ void s5_pow(const S5Par& q, float e, float& pr, float& pim) { const float m = __expf(e * q.dre); float s, c; fast_sincos(e * q.ang, s, c); pr = m * c; pim = m * s; }
__device__ __forceinline__ void s5_ops(FA, int l) {
    bf16* BE = WSP(bf16, WS_S5E); bf16* BY = WSP(bf16, WS_S5Y); const int lane = F.lane;
    for (int task = F.gw; task < 64 * 16 * 2; task += F.NGW) {
        const int chalf = task & 1, g = task >> 5, tau = (task >> 1) & 15; float kf[4] = {0.f, 0.f, 0.f, 0.f}, kb[4] = {0.f, 0.f, 0.f, 0.f};
#pragma unroll 1
        for (int dir = 0; dir < 2; ++dir) {
            const S5Par q = s5_par(F, A, l, dir, g, lane); float pr, pim; s5_pow(q, (float)tau, pr, pim);
            const size_t pi = (size_t)(((l * 2 + dir) * 64 + g) * 64 + lane);
            float wr_[16], wi_[16];
#pragma unroll
            for (int c = 0; c < 16; ++c) { const float br = AIN(17)[pi * 16 + c], bi = AIN(18)[pi * 16 + c]; const float bbr = q.fre * br - q.fim * bi, bbi = q.fre * bi + q.fim * br;
                wr_[c] = pr * bbr - pim * bbi; wi_[c] = pr * bbi + pim * bbr; }
#pragma unroll 1
            for (int c = 8 * chalf; c < 8 * chalf + 8; ++c) { const size_t ci = ((size_t)((l * 2 + dir) * 64 + g) * 16 + c) * 64 + lane; const float cr = AIN(19)[ci], cim = AIN(20)[ci];
#pragma unroll
                for (int cp = 0; cp < 16; ++cp) { const float v = wave_sum(cr * wr_[cp] - cim * wi_[cp], lane);
                    if (lane == c * 4 + (cp >> 2)) { if (dir == 0) kf[cp & 3] = v; else kb[cp & 3] = v; } } }
        }
        const int c = lane >> 2, cp0 = 4 * (lane & 3);
        if ((c >> 3) != chalf) continue;
        if (tau == 0) {
            float v[4];
#pragma unroll
            for (int j = 0; j < 4; ++j) v[j] = kf[j] + kb[j] + ((cp0 + j == c) ? AIN(21)[l * 1024 + g * 16 + c] : 0.f);
            for (int i = 0; i < 16; ++i) { v2u w; w.x = pk2(v[0], v[1]); w.y = pk2(v[2], v[3]); *(v2u*)(BY + ((size_t)g * 256 + i * 16 + c) * 512 + i * 16 + cp0) = w; }
        } else {
            v2u wf, wb; wf.x = pk2(kf[0], kf[1]); wf.y = pk2(kf[2], kf[3]); wb.x = pk2(kb[0], kb[1]); wb.y = pk2(kb[2], kb[3]);
            for (int s = 0; s + tau < 16; ++s) { const int i = s + tau;
                *(v2u*)(BY + ((size_t)g * 256 + i * 16 + c) * 512 + s * 16 + cp0) = wf;
                *(v2u*)(BY + ((size_t)g * 256 + s * 16 + c) * 512 + i * 16 + cp0) = wb; }
        }
    }
    const int gt = F.bid * 512 + F.tid, ngt = F.G * 512;
    for (int t = gt; t < 64 * 16 * 16 * 2 * 8; t += ngt) {
        const int po = t & 7, dir = (t >> 3) & 1, c = (t >> 4) & 15, i = (t >> 8) & 15, g = t >> 12; const float e = dir ? (float)(16 - i) : (float)(i + 1);
        float re[8], im[8];
#pragma unroll
        for (int j = 0; j < 8; ++j) { const int p = po * 8 + j; const S5Par q = s5_par(F, A, l, dir, g, p); float pr, pim; s5_pow(q, e, pr, pim);
            const size_t ci = ((size_t)((l * 2 + dir) * 64 + g) * 16 + c) * 64 + p; const float cr = AIN(19)[ci], cim = AIN(20)[ci];
            re[j] = cr * pr - cim * pim; im[j] = -(cr * pim + cim * pr); }
        bf16* row = BY + ((size_t)g * 256 + i * 16 + c) * 512 + 256 + dir * 128 + po * 8;
        v4u w; w.x = pk2(re[0], re[1]); w.y = pk2(re[2], re[3]); w.z = pk2(re[4], re[5]); w.w = pk2(re[6], re[7]); *(v4u*)row = w;
        w.x = pk2(im[0], im[1]); w.y = pk2(im[2], im[3]); w.z = pk2(im[4], im[5]); w.w = pk2(im[6], im[7]); *(v4u*)(row + 64) = w;
    }
    for (int t = gt; t < 64 * 2 * 64 * 16; t += ngt) {
        const int s = t & 15, p = (t >> 4) & 63, dir = (t >> 10) & 1, g = t >> 11; const float e = dir ? (float)s : (float)(15 - s);
        const S5Par q = s5_par(F, A, l, dir, g, p); float pr, pim; s5_pow(q, e, pr, pim);
        const size_t pi = (size_t)(((l * 2 + dir) * 64 + g) * 64 + p); float re[16], im[16];
#pragma unroll
        for (int c = 0; c < 16; ++c) { const float br = AIN(17)[pi * 16 + c], bi = AIN(18)[pi * 16 + c]; const float bbr = q.fre * br - q.fim * bi, bbi = q.fre * bi + q.fim * br;
            re[c] = pr * bbr - pim * bbi; im[c] = pr * bbi + pim * bbr; }
        bf16* rr = BE + ((size_t)g * 256 + dir * 128 + p) * 256 + s * 16; bf16* ri = rr + 64 * 256;
        v4u w; w.x = pk2(re[0], re[1]); w.y = pk2(re[2], re[3]); w.z = pk2(re[4], re[5]); w.w = pk2(re[6], re[7]); *(v4u*)rr = w;
        w.x = pk2(re[8], re[9]); w.y = pk2(re[10], re[11]); w.z = pk2(re[12], re[13]); w.w = pk2(re[14], re[15]); *(v4u*)(rr + 8) = w;
        w.x = pk2(im[0], im[1]); w.y = pk2(im[2], im[3]); w.z = pk2(im[4], im[5]); w.w = pk2(im[6], im[7]); *(v4u*)ri = w;
        w.x = pk2(im[8], im[9]); w.y = pk2(im[10], im[11]); w.z = pk2(im[12], im[13]); w.w = pk2(im[14], im[15]); *(v4u*)(ri + 8) = w;
    }
}
__device__ __forceinline__ void s5_carry(FA, int l, int w0, int nw) {
    const bf16* E = WSP(bf16, WS_E); bf16* UX = WSP(bf16, WS_UX); const int lane = F.lane, lg = lane >> 4, lp = lane & 15;
    LAS unsigned char* buf = F.lds + RING_OFF + F.wave * 16384;
    for (int task = w0; task < 12 * 64 * 2; task += nw) {
        const int dir = task & 1, g = (task >> 1) & 63, s = task >> 7; int base, T; seq_of_index(s, base, T);
        const int c0 = base >> 4, nch = T >> 4, nb = nch >> 6;
        const S5Par q = s5_par(F, A, l, dir, g, lane); float ar, ai; s5_pow(q, 16.0f, ar, ai);
        const bf16* Eb = E + ((size_t)g * 2048 + c0) * 256 + dir * 128; bf16* Ub = UX + ((size_t)g * 2048 + c0) * 512 + 256 + dir * 128;
        float xr = 0.f, xi = 0.f;
        v4u ld[16];
#pragma unroll
        for (int i = 0; i < 16; ++i) { const int n = 4 * i + lg, cn = dir ? nch - 1 - n : n; ld[i] = *(const v4u*)(Eb + (unsigned)(cn * 256 + 8 * lp)); }
#pragma unroll 1
        for (int b = 0; b < nb; ++b) {
#pragma unroll
            for (int i = 0; i < 16; ++i) *(LAS v4u*)(buf + (4 * i + lg) * 256 + 16 * lp) = ld[i];
            asm volatile("" ::: "memory");
            { const int bn = b + 1 < nb ? b + 1 : b;
#pragma unroll
                for (int i = 0; i < 16; ++i) { const int n = 64 * bn + 4 * i + lg, cn = dir ? nch - 1 - n : n; ld[i] = *(const v4u*)(Eb + (unsigned)(cn * 256 + 8 * lp)); } }
#pragma unroll 1
            for (int j0 = 0; j0 < 64; j0 += 8) {
                LAS unsigned short* row = (LAS unsigned short*)(buf + j0 * 256) + lane; unsigned short rr[8], ri[8];
#pragma unroll
                for (int j = 0; j < 8; ++j) { rr[j] = row[j * 128]; ri[j] = row[j * 128 + 64]; }
#pragma unroll
                for (int j = 0; j < 8; ++j) { const unsigned xo = pk2(xr, xi); row[j * 128] = (unsigned short)xo; row[j * 128 + 64] = (unsigned short)(xo >> 16);
                    const float er = bf2f(rr[j]), ei = bf2f(ri[j]); const float nr = ar * xr - ai * xi + er, ni = ar * xi + ai * xr + ei; xr = nr; xi = ni; }
            }
            asm volatile("" ::: "memory");
            v4u xo[16];
#pragma unroll
            for (int i = 0; i < 16; ++i) xo[i] = *(const LAS v4u*)(buf + (4 * i + lg) * 256 + 16 * lp);
#pragma unroll
            for (int i = 0; i < 16; ++i) { const int n = 64 * b + 4 * i + lg, cn = dir ? nch - 1 - n : n; *(v4u*)(Ub + (unsigned)(cn * 512 + 8 * lp)) = xo[i]; }
        }
    }
}
typedef short s16x4 __attribute__((ext_vector_type(4)));
__device__ __forceinline__ unsigned hoff(unsigned row, unsigned ch) { return 256u * row + 16u * (ch ^ (((row & 3u) << 2) | ((row >> 2) & 3u))); }
__device__ __forceinline__ s16x4 tr_read(const LAS unsigned char* p) { return __builtin_bit_cast(s16x4, __builtin_amdgcn_ds_read_tr16_b64_v4i16((LAS s16x4*)p)); }
__device__ __forceinline__ bf16x8 tr_frag(const LAS unsigned char* tile, int lane, int c, int rowbase0, int rowbase1) {
    const unsigned g = lane >> 4, q = (lane & 15) >> 2, p = lane & 3;
    const s16x4 a = tr_read(tile + hoff(rowbase0 + 4 * g + q, 2 * c + (p >> 1)) + 8 * (p & 1)), b = tr_read(tile + hoff(rowbase1 + 4 * g + q, 2 * c + (p >> 1)) + 8 * (p & 1));
    bf16x8 r; r[0] = a[0]; r[1] = a[1]; r[2] = a[2]; r[3] = a[3]; r[4] = b[0]; r[5] = b[1]; r[6] = b[2]; r[7] = b[3]; return r;
}
__device__ __forceinline__ void lds8(const LAS float* p, float (&v)[8]) { const f32x4 a = *(const LAS f32x4*)p, b = *(const LAS f32x4*)(p + 4); v[0] = a[0]; v[1] = a[1]; v[2] = a[2]; v[3] = a[3]; v[4] = b[0]; v[5] = b[1]; v[6] = b[2]; v[7] = b[3]; }
constexpr int HG_BST = 136;
constexpr int HG_BF_OFF = 0, HG_BB_OFF = 64 * HG_BST * 4, HG_V_OFF = 2 * 64 * HG_BST * 4, HG_Q_OFF = HG_V_OFF + 16384, HG_K2_OFF = HG_Q_OFF;
constexpr int HG_OST = 132;
static_assert(2 * 64 * HG_OST * 4 <= HG_V_OFF && HG_K2_OFF + 2 * 16384 <= RING_BYTES, "HGRN2 LDS map");
struct HgTiles { v4u lw[4]; v4u tv[2], tq[2]; };
__device__ __forceinline__ void hg_issue(Frame& F, HgTiles& T, const bf16* LFF, const bf16* LFB, const bf16* VH, const bf16* QH, int cu) {
    const int head = cu & 3, cg = cu >> 2;
    const unsigned lt = (unsigned)((F.tid >> 4) * 512 + 8 * (F.tid & 15));
#pragma unroll
    for (int i = 0; i < 2; ++i) { const size_t go = (size_t)(64 * cg + 32 * i) * 512 + head * 128;
        T.lw[i] = *(const v4u*)(LFF + go + lt); T.lw[2 + i] = *(const v4u*)(LFB + go + lt);
        T.tv[i] = *(const v4u*)(VH + go + lt); if (QH) T.tq[i] = *(const v4u*)(QH + go + lt); }
}
__device__ __forceinline__ void hg_commit_scan(Frame& F, const HgTiles& T, bool hasq) {
#pragma unroll
    for (int i = 0; i < 2; ++i) { const int idx = F.tid + 512 * i, p = idx >> 4, ch = idx & 15;
#pragma unroll
        for (int dir = 0; dir < 2; ++dir) { const v4u w = T.lw[2 * dir + i]; LAS float* bp = (LAS float*)(F.lds + (dir ? HG_BB_OFF : HG_BF_OFF)) + p * HG_BST + 8 * ch;
            *(LAS f32x4*)bp = (f32x4){bflo(w.x), bfhi(w.x), bflo(w.y), bfhi(w.y)}; *(LAS f32x4*)(bp + 4) = (f32x4){bflo(w.z), bfhi(w.z), bflo(w.w), bfhi(w.w)}; }
        *(LAS v4u*)(F.lds + HG_V_OFF + hoff(p, ch)) = T.tv[i]; if (hasq) *(LAS v4u*)(F.lds + HG_Q_OFF + hoff(p, ch)) = T.tq[i]; }
    __syncthreads();
    if (F.tid < 128) { LAS float* bt = (LAS float*)(F.lds + HG_BF_OFF) + F.tid; float a = 0.f;
#pragma unroll 1
        for (int j0 = 0; j0 < 64; j0 += 8) { float v[8];
#pragma unroll
            for (int k = 0; k < 8; ++k) v[k] = bt[(j0 + k) * HG_BST];
#pragma unroll
            for (int k = 0; k < 8; ++k) { a += v[k]; bt[(j0 + k) * HG_BST] = a; } } }
    else if (F.tid < 256) { LAS float* bt = (LAS float*)(F.lds + HG_BB_OFF) + (F.tid - 128); float a = 0.f;
#pragma unroll 1
        for (int j0 = 0; j0 < 64; j0 += 8) { float v[8];
#pragma unroll
            for (int k = 0; k < 8; ++k) v[k] = bt[(63 - j0 - k) * HG_BST];
#pragma unroll
            for (int k = 0; k < 8; ++k) { a += v[k]; bt[(63 - j0 - k) * HG_BST] = a; } } }
    __syncthreads();
}
__device__ __forceinline__ void hg_phase_a(FA) {
    const bf16* LFF = WSP(bf16, WS_LFF); const bf16* LFB = WSP(bf16, WS_LFB); const bf16* VH = WSP(bf16, WS_VH); bf16* LT = WSP(bf16, WS_LT); float* HD = WSP(float, WS_HD);
    const int lane = F.lane, w = F.wave, g = lane >> 4, wdir = w >> 2, wq = w & 3;
    HgTiles T; if (F.bid < 2048) hg_issue(F, T, LFF, LFB, VH, nullptr, F.bid);
    for (int cu = F.bid; cu < 2048; cu += F.G) {
        hg_commit_scan(F, T, false);
        if (cu + F.G < 2048) hg_issue(F, T, LFF, LFB, VH, nullptr, cu + F.G);
#pragma unroll
        for (int i = 0; i < 4; ++i) { const int idx = F.tid + 512 * i, dir = idx >> 10, p = (idx >> 4) & 63, ch = idx & 15;
            const LAS float* bt = (const LAS float*)(F.lds + (dir ? HG_BB_OFF : HG_BF_OFF)); const LAS float* bj = bt + p * HG_BST + 8 * ch; const LAS float* bl = bt + (dir ? 0 : 63) * HG_BST + 8 * ch;
            const bool edge = dir ? (p == 63) : (p == 0); const int pst = edge ? 0 : (dir ? HG_BST : -HG_BST);
            float kt[8], vb[8], vp[8], vl[8]; lds8(bj, vb); lds8(bj + pst, vp); lds8(bl, vl);
#pragma unroll
            for (int e = 0; e < 8; ++e) { const float bb = vb[e], bp = edge ? 0.f : vp[e]; kt[e] = (1.0f - __expf(bb - bp)) * __expf(vl[e] - bb); }
            v4u o; o.x = pk2(kt[0], kt[1]); o.y = pk2(kt[2], kt[3]); o.z = pk2(kt[4], kt[5]); o.w = pk2(kt[6], kt[7]);
            *(LAS v4u*)(F.lds + HG_K2_OFF + dir * 16384 + hoff(p, ch)) = o; }
        if (F.tid < 256) { const int dir = F.tid >> 7, d = F.tid & 127; HD[(size_t)((cu * 2) + dir) * 128 + d] = __expf(((const LAS float*)(F.lds + (dir ? HG_BB_OFF : HG_BF_OFF)))[(dir ? 0 : 63) * HG_BST + d]); }
        __syncthreads();
        f32x4 acc[2][8];
#pragma unroll
        for (int mb = 0; mb < 2; ++mb)
#pragma unroll
            for (int c = 0; c < 8; ++c) acc[mb][c] = (f32x4){0.f, 0.f, 0.f, 0.f};
#pragma unroll
        for (int ks = 0; ks < 2; ++ks) {
            bf16x8 a[2];
#pragma unroll
            for (int mb = 0; mb < 2; ++mb) a[mb] = tr_frag(F.lds + HG_K2_OFF + wdir * 16384, lane, 2 * wq + mb, 32 * ks, 32 * ks + 16);
#pragma unroll
            for (int c = 0; c < 8; ++c) { const bf16x8 bv = tr_frag(F.lds + HG_V_OFF, lane, c, 32 * ks, 32 * ks + 16);
#pragma unroll
                for (int mb = 0; mb < 2; ++mb) acc[mb][c] = __builtin_amdgcn_mfma_f32_16x16x32_bf16(a[mb], bv, acc[mb][c], 0, 0, 0); } }
        bf16* lt = LT + (size_t)(cu * 2 + wdir) * 16384;
#pragma unroll
        for (int mb = 0; mb < 2; ++mb)
#pragma unroll
            for (int c = 0; c < 8; ++c) { v2u o; o.x = pk2(acc[mb][c][0], acc[mb][c][1]); o.y = pk2(acc[mb][c][2], acc[mb][c][3]);
                { const int mbg = 2 * wq + mb, ksq = mbg >> 1, gp = 2 * (mbg & 1) + (g >> 1); *(v2u*)(lt + (size_t)((c * 4 + ksq) * 64 + gp * 16 + (lane & 15)) * 8 + 4 * (g & 1)) = o; } }
        __syncthreads();
    }
}
__device__ __forceinline__ void hg_phase_b(FA) {
    const bf16* LT = WSP(bf16, WS_LT); const float* HD = WSP(float, WS_HD); bf16* SIN = WSP(bf16, WS_SIN); const int lane = F.lane;
    for (int tk = F.gw; tk < 3072; tk += F.NGW) {
        int idx, smp; if (tk < 1024) { idx = tk; smp = 0; } else if (tk < 2048) { idx = tk - 1024; smp = 1; } else { idx = tk - 1024; smp = 0; }
        const int eg = idx & 31, dir = (idx >> 5) & 1, head = (idx >> 6) & 3, sq = idx >> 8;
        const int c0 = smp ? (MPROMPT / 64) + sq * (TS / 64) : sq * (TP / 64), nch = smp ? TS / 64 : TP / 64;
        const int e0 = eg * 512 + lane * 8, d0 = 32 * (eg & 3) + 8 * (lane >> 4);
        float S[8];
#pragma unroll
        for (int e = 0; e < 8; ++e) S[e] = 0.f;
        v4u l4[4]; f32x4 da[4], db[4];
#pragma unroll
        for (int i = 0; i < 4; ++i) { const int cg = c0 + (dir ? nch - 1 - i : i); const size_t u = (size_t)((cg * 4 + head) * 2 + dir);
            l4[i] = *(const v4u*)(LT + u * 16384 + e0); da[i] = *(const f32x4*)(HD + u * 128 + d0); db[i] = *(const f32x4*)(HD + u * 128 + d0 + 4); }
        for (int n0 = 0; n0 < nch; n0 += 4) {
            v4u m4[4]; f32x4 ea[4], eb[4]; const int n1 = n0 + 4 < nch ? n0 + 4 : n0;
#pragma unroll
            for (int i = 0; i < 4; ++i) { const int cg = c0 + (dir ? nch - 1 - (n1 + i) : n1 + i); const size_t u = (size_t)((cg * 4 + head) * 2 + dir);
                m4[i] = *(const v4u*)(LT + u * 16384 + e0); ea[i] = *(const f32x4*)(HD + u * 128 + d0); eb[i] = *(const f32x4*)(HD + u * 128 + d0 + 4); }
#pragma unroll
            for (int i = 0; i < 4; ++i) { const int cg = c0 + (dir ? nch - 1 - (n0 + i) : n0 + i); const size_t u = (size_t)((cg * 4 + head) * 2 + dir);
                v4u o; o.x = pk2(S[0], S[1]); o.y = pk2(S[2], S[3]); o.z = pk2(S[4], S[5]); o.w = pk2(S[6], S[7]); *(v4u*)(SIN + u * 16384 + e0) = o;
                S[0] = da[i][0] * S[0] + bflo(l4[i].x); S[1] = da[i][1] * S[1] + bfhi(l4[i].x); S[2] = da[i][2] * S[2] + bflo(l4[i].y); S[3] = da[i][3] * S[3] + bfhi(l4[i].y);
                S[4] = db[i][0] * S[4] + bflo(l4[i].z); S[5] = db[i][1] * S[5] + bfhi(l4[i].z); S[6] = db[i][2] * S[6] + bflo(l4[i].w); S[7] = db[i][3] * S[7] + bfhi(l4[i].w); }
#pragma unroll
            for (int i = 0; i < 4; ++i) { l4[i] = m4[i]; da[i] = ea[i]; db[i] = eb[i]; }
        }
    }
}
__device__ __forceinline__ void hg_phase_c(FA, const float* gnorm) {
    const bf16* LFF = WSP(bf16, WS_LFF); const bf16* LFB = WSP(bf16, WS_LFB); const bf16* VH = WSP(bf16, WS_VH); const bf16* QH = WSP(bf16, WS_QH); const bf16* SIN = WSP(bf16, WS_SIN);
    const bf16* GH = WSP(bf16, WS_GH); bf16* CAT = WSP(bf16, WS_CAT);
    const int lane = F.lane, w = F.wave, g = lane >> 4, tl = lane & 15, dir = w >> 2, PI = w & 3;
    const LAS float* bt = (const LAS float*)(F.lds + (dir ? HG_BB_OFF : HG_BF_OFF));
    const int pst = dir ? HG_BST : -HG_BST;
    const bool hasref = dir ? (PI < 3) : (PI > 0); const int refrow = hasref ? (dir ? 16 * PI + 16 : 16 * PI - 1) : 0;
    HgTiles T; if (F.bid < 2048) hg_issue(F, T, LFF, LFB, VH, QH, F.bid);
    for (int cu = F.bid; cu < 2048; cu += F.G) {
        const int head = cu & 3, cg = cu >> 2;
        const bf16* st = SIN + (size_t)(cu * 2 + dir) * 16384;
        bf16x8 sb[2][4], sc[2][4];
#define HG_SLOAD(dst, cb) _Pragma("unroll") for (int c = 0; c < 2; ++c) _Pragma("unroll") for (int ks = 0; ks < 4; ++ks) dst[c][ks] = *(const bf16x8*)(st + (size_t)(((2 * (cb) + c) * 4 + ks) * 64 + lane) * 8)
#define HG_SMMA(src, cb) _Pragma("unroll") for (int c = 0; c < 2; ++c) _Pragma("unroll") for (int ks = 0; ks < 4; ++ks) acc[2 * (cb) + c] = __builtin_amdgcn_mfma_f32_16x16x32_bf16(qt[ks], src[c][ks], acc[2 * (cb) + c], 0, 0, 0)
        HG_SLOAD(sb, 0); HG_SLOAD(sc, 1);
        hg_commit_scan(F, T, true);
        const int p = 16 * PI + tl;
        bf16x8 qt[4], qh[4]; f32x4 acc[8];
#pragma unroll
        for (int c = 0; c < 8; ++c) acc[c] = (f32x4){0.f, 0.f, 0.f, 0.f};
#pragma unroll
        for (int ks = 0; ks < 4; ++ks) { const int d0 = 32 * ks + 8 * g; const LAS float* bj = bt + p * HG_BST + d0; const LAS float* br = bt + refrow * HG_BST + d0;
            const v4u q4 = *(const LAS v4u*)(F.lds + HG_Q_OFF + hoff(p, 4 * ks + g)); const float qv[8] = {bflo(q4.x), bfhi(q4.x), bflo(q4.y), bfhi(q4.y), bflo(q4.z), bfhi(q4.z), bflo(q4.w), bfhi(q4.w)};
            float a[8], h[8], vb[8], vr[8]; lds8(bj, vb); lds8(br, vr);
#pragma unroll
            for (int e = 0; e < 8; ++e) { const float bb = vb[e], rr = hasref ? vr[e] : 0.f; a[e] = qv[e] * __expf(bb); h[e] = qv[e] * __expf(bb - rr); }
            v4u o; o.x = pk2(a[0], a[1]); o.y = pk2(a[2], a[3]); o.z = pk2(a[4], a[5]); o.w = pk2(a[6], a[7]); qt[ks] = __builtin_bit_cast(bf16x8, o);
            o.x = pk2(h[0], h[1]); o.y = pk2(h[2], h[3]); o.z = pk2(h[4], h[5]); o.w = pk2(h[6], h[7]); qh[ks] = __builtin_bit_cast(bf16x8, o); }
        auto intra = [&](const int jp) __attribute__((always_inline)) {
            int ln_ = lane; asm volatile("" : "+v"(ln_)); const int lane = ln_, g = ln_ >> 4, tl = ln_ & 15;
            f32x4 pt[2];
#pragma unroll
            for (int jj = 0; jj < 2; ++jj) { const int PJ = 2 * jp + jj; pt[jj] = (f32x4){0.f, 0.f, 0.f, 0.f};
                if (dir ? (PJ >= PI) : (PJ <= PI)) { const int s = 16 * PJ + tl; const bool edge = dir ? (s == 63) : (s == 0);
#pragma unroll
                    for (int ks = 0; ks < 4; ++ks) { const int d0 = 32 * ks + 8 * g; const LAS float* bs = bt + s * HG_BST + d0; const LAS float* br = bt + refrow * HG_BST + d0;
                        float kh[8], vb[8], vp[8], vr[8]; lds8(bs, vb); lds8(bs + (edge ? 0 : pst), vp); lds8(br, vr);
#pragma unroll
                        for (int e = 0; e < 8; ++e) { const float bb = vb[e], bp = edge ? 0.f : vp[e], rr = hasref ? vr[e] : 0.f; kh[e] = (1.0f - __expf(bb - bp)) * __expf(rr - bb); }
                        v4u o; o.x = pk2(kh[0], kh[1]); o.y = pk2(kh[2], kh[3]); o.z = pk2(kh[4], kh[5]); o.w = pk2(kh[6], kh[7]);
                        pt[jj] = __builtin_amdgcn_mfma_f32_16x16x32_bf16(__builtin_bit_cast(bf16x8, o), qh[ks], pt[jj], 0, 0, 0); }
                    if (PJ == PI) {
#pragma unroll
                        for (int r = 0; r < 4; ++r) if (dir ? (4 * g + r < tl) : (4 * g + r > tl)) pt[jj][r] = 0.f; }
                } }
            v4u pa; pa.x = pk2(pt[0][0], pt[0][1]); pa.y = pk2(pt[0][2], pt[0][3]); pa.z = pk2(pt[1][0], pt[1][1]); pa.w = pk2(pt[1][2], pt[1][3]);
#pragma unroll
            for (int cq = 0; cq < 2; ++cq) { bf16x8 bv[4];
#pragma unroll
                for (int c = 0; c < 4; ++c) bv[c] = tr_frag(F.lds + HG_V_OFF, lane, 4 * cq + c, 32 * jp, 32 * jp + 16);
#pragma unroll
                for (int c = 0; c < 4; ++c) acc[4 * cq + c] = __builtin_amdgcn_mfma_f32_16x16x32_bf16(__builtin_bit_cast(bf16x8, pa), bv[c], acc[4 * cq + c], 0, 0, 0); }
        };
        HG_SMMA(sb, 0); HG_SLOAD(sb, 2); HG_SMMA(sc, 1);
        intra(dir ? 1 : 0);
        HG_SMMA(sb, 2); HG_SLOAD(sc, 3);
        if (dir ? (PI <= 1) : (PI >= 2)) intra(dir ? 0 : 1);
        if (cu + F.G < 2048) hg_issue(F, T, LFF, LFB, VH, QH, cu + F.G);
        HG_SMMA(sc, 3);
#undef HG_SLOAD
#undef HG_SMMA
        __syncthreads();
        const int fpos = 8 * w + (lane >> 3), fvc = lane & 7; const size_t ftok = (size_t)(64 * cg + fpos);
        v4u ghv[2]; f32x4 gnv[4];
#pragma unroll
        for (int hh = 0; hh < 2; ++hh) { ghv[hh] = *(const v4u*)(GH + ftok * 512 + head * 128 + 16 * fvc + 8 * hh); gnv[2 * hh] = *(const f32x4*)(gnorm + head * 128 + 16 * fvc + 8 * hh); gnv[2 * hh + 1] = *(const f32x4*)(gnorm + head * 128 + 16 * fvc + 8 * hh + 4); }
        { LAS float* ob = (LAS float*)F.lds + dir * 64 * HG_OST;
#pragma unroll
            for (int r = 0; r < 4; ++r)
#pragma unroll
                for (int c = 0; c < 8; ++c) ob[(16 * PI + 4 * g + r) * HG_OST + 16 * c + tl] = acc[c][r]; }
        __syncthreads();
        { const int pos = 8 * w + (lane >> 3), vc = lane & 7; const LAS float* o0 = (const LAS float*)F.lds + pos * HG_OST + 16 * vc; const LAS float* o1 = o0 + 64 * HG_OST;
            float x[16]; float ss = 0.f;
#pragma unroll
            for (int i = 0; i < 4; ++i) { const f32x4 a = *(const LAS f32x4*)(o0 + 4 * i), b2 = *(const LAS f32x4*)(o1 + 4 * i);
#pragma unroll
                for (int e = 0; e < 4; ++e) { const float v = a[e] + b2[e]; x[4 * i + e] = v; ss += v * v; } }
            ss += xshfl<1>(ss, lane); ss += xshfl<2>(ss, lane); ss += xshfl<4>(ss, lane);
            const float rstd = fast_rsq(ss * (1.0f / 128.0f) + EPS);
            bf16* op = CAT + ftok * DM + 512 + head * 128 + 16 * vc;
#pragma unroll
            for (int hh = 0; hh < 2; ++hh) { const v4u gh = ghv[hh]; const f32x4 g0 = gnv[2 * hh], g1 = gnv[2 * hh + 1]; const float* xx = x + 8 * hh;
                v4u o; o.x = pk2(xx[0] * rstd * g0[0] * bflo(gh.x), xx[1] * rstd * g0[1] * bfhi(gh.x)); o.y = pk2(xx[2] * rstd * g0[2] * bflo(gh.y), xx[3] * rstd * g0[3] * bfhi(gh.y));
                o.z = pk2(xx[4] * rstd * g1[0] * bflo(gh.z), xx[5] * rstd * g1[1] * bfhi(gh.z)); o.w = pk2(xx[6] * rstd * g1[2] * bflo(gh.w), xx[7] * rstd * g1[3] * bfhi(gh.w));
                *(v4u*)(op + 8 * hh) = o; } }
        __syncthreads();
    }
}

__device__ __forceinline__ void na_phase(FA, const float* relb, const float* qng, const float* kng, u64* ssA) {
    const bf16* Q = WSP(bf16, WS_Q); const bf16* K = WSP(bf16, WS_K); const bf16* V = WSP(bf16, WS_V); bf16* CAT = WSP(bf16, WS_CAT);
    const int lane = F.lane, w = F.wave, g = lane >> 4, tl = lane & 15, qb = w & 3, hh = w >> 2;
    const int kb_lo = qb >= 2 ? qb - 1 : 0, kb_hi = qb <= 1 ? qb + 1 : 3;
    LAS float* btab = (LAS float*)(F.lds + NA_BIAS_OFF); int hp_loaded = -1;
    float Bnd; { const float qv = qng[lane], kv = kng[lane]; float bvv[8], mb = 0.f;
#pragma unroll
        for (int j = 0; j < 8; ++j) bvv[j] = relb[min(F.tid + 512 * j, 8 * 15 * 31 - 1)];
#pragma unroll
        for (int j = 0; j < 8; ++j) mb = fmaxf(mb, fabsf(bvv[j]));
        const float mq = wave_max(fabsf(qv), lane), mk = wave_max(fabsf(kv), lane); mb = wave_max(mb, lane);
        LAS float* red = (LAS float*)(F.lds + NA_BIAS_OFF + 3840);
        if (lane == 0) red[w] = mb;
        __syncthreads();
        Bnd = 8.0f * mq * mk + wave_max(red[lane & 7], lane); }
    constexpr int NA_V_OFF = RING_OFF, NA_K_OFF = RING_OFF + 65536;
    const unsigned vlt = (unsigned)((F.tid >> 4) * 512 + 8 * (F.tid & 15)), vlds = hoff(F.tid >> 4, F.tid & 15);
    const unsigned klt = (unsigned)(tl * 512 + 8 * g);
    v4u vv[8], kk[8];
#define NA_ISSUE(uu, ss) do { const int hp_ = (uu) & 3, R_ = (uu) >> 2; int Rb_, gr_, rows_; \
        if (R_ < MPROMPT / 64) { Rb_ = R_ & ~31; gr_ = R_ & 31; rows_ = 32; } else { Rb_ = 256 + ((R_ - 256) & ~63); gr_ = (R_ - 256) & 63; rows_ = 64; } \
        const size_t go_ = (size_t)((Rb_ + min(max(gr_ - 4, 0), rows_ - 8)) * 64 + 256 * (ss)) * 512 + hp_ * 128; \
        _Pragma("unroll") for (int i = 0; i < 8; ++i) { vv[i] = *(const v4u*)(V + go_ + (size_t)(32 * i) * 512 + vlt); kk[i] = *(const v4u*)(K + go_ + (size_t)(32 * i) * 512 + vlt); } } while (0)
    if (F.bid < 512 * 4) NA_ISSUE(F.bid, 0);
    for (int u = F.bid; u < 512 * 4; u += F.G) {
        const int hp = u & 3, R = u >> 2; int Rb, gr, rows;
        if (R < MPROMPT / 64) { Rb = R & ~31; gr = R & 31; rows = 32; } else { Rb = 256 + ((R - 256) & ~63); gr = (R - 256) & 63; rows = 64; }
        const int rs = min(max(gr - 4, 0), rows - 8), head = 2 * hp + hh;
        const int gc = 16 * qb + tl, cs = min(max(gc - 8, 0), 48), qrow = R * 64 + gc;
        bf16x8 qf[2];
#pragma unroll
        for (int ks = 0; ks < 2; ++ks) qf[ks] = *(const bf16x8*)(Q + (size_t)(R * 64 + 16 * qb) * 512 + head * 64 + 32 * ks + klt);
        if (hp != hp_loaded) { const float b0 = relb[hp * 2 * 15 * 31 + F.tid], b1 = relb[hp * 2 * 15 * 31 + min(F.tid + 512, 2 * 15 * 31 - 1)];
            btab[F.tid] = b0 - Bnd; if (F.tid + 512 < 2 * 15 * 31) btab[F.tid + 512] = b1 - Bnd; hp_loaded = hp; }
        f32x4 acc[4];
#pragma unroll
        for (int db = 0; db < 4; ++db) acc[db] = (f32x4){0.f, 0.f, 0.f, 0.f};
        float lrun = 0.f;
#pragma unroll 1
        for (int sg = 0; sg < 2; ++sg) {
#pragma unroll
            for (int i = 0; i < 8; ++i) { *(LAS v4u*)(F.lds + NA_V_OFF + vlds + 8192 * i) = vv[i]; *(LAS v4u*)(F.lds + NA_K_OFF + vlds + 8192 * i) = kk[i]; }
            __syncthreads();
            __builtin_amdgcn_s_waitcnt(0x0F70);
            if (sg == 0) NA_ISSUE(u, 1); else if (u + F.G < 512 * 4) NA_ISSUE(u + F.G, 0);
#pragma unroll 1
            for (int al = 0; al < 4; ++al) {
                const int dr = rs + 4 * sg + al - gr; const LAS float* brow = btab + (hh * 15 + dr + 7) * 31 + 15 - gc;
                f32x4 st[4];
#pragma unroll
                for (int kb = 0; kb < 4; ++kb) { st[kb] = (f32x4){0.f, 0.f, 0.f, 0.f};
                    if (kb >= kb_lo && kb <= kb_hi) {
#pragma unroll
                        for (int ks = 0; ks < 2; ++ks) st[kb] = __builtin_amdgcn_mfma_f32_16x16x32_bf16(*(const LAS bf16x8*)(F.lds + NA_K_OFF + hoff(64 * al + 16 * kb + tl, 8 * hh + 4 * ks + g)), qf[ks], st[kb], 0, 0, 0); } }
#pragma unroll
                for (int kb = 0; kb < 4; ++kb) {
                    if (kb < kb_lo || kb > kb_hi) continue;
                    float bv[4], ev[4];
#pragma unroll
                    for (int r = 0; r < 4; ++r) { const int kc = 16 * kb + 4 * g + r; bv[r] = brow[min(max(kc, cs), cs + 15)]; }
#pragma unroll
                    for (int r = 0; r < 4; ++r) ev[r] = __expf(st[kb][r] * 0.125f + bv[r]);
#pragma unroll
                    for (int r = 0; r < 4; ++r) { const int kc = 16 * kb + 4 * g + r; const float p = (kc >= cs && kc < cs + 16) ? ev[r] : 0.f; st[kb][r] = p; lrun += p; } }
#pragma unroll
                for (int kp2 = 0; kp2 < 2; ++kp2) {
                    if (2 * kp2 + 1 < kb_lo || 2 * kp2 > kb_hi) continue;
                    v4u pb; pb.x = pk2(st[2 * kp2][0], st[2 * kp2][1]); pb.y = pk2(st[2 * kp2][2], st[2 * kp2][3]); pb.z = pk2(st[2 * kp2 + 1][0], st[2 * kp2 + 1][1]); pb.w = pk2(st[2 * kp2 + 1][2], st[2 * kp2 + 1][3]);
                    bf16x8 va[4];
#pragma unroll
                    for (int db = 0; db < 4; ++db) va[db] = tr_frag(F.lds + NA_V_OFF, lane, 4 * hh + db, 64 * al + 32 * kp2, 64 * al + 32 * kp2 + 16);
#pragma unroll
                    for (int db = 0; db < 4; ++db) acc[db] = __builtin_amdgcn_mfma_f32_16x16x32_bf16(va[db], __builtin_bit_cast(bf16x8, pb), acc[db], 0, 0, 0);
                }
            }
            __syncthreads();
        }
        lrun += xshfl<16>(lrun, lane); lrun += xshfl<32>(lrun, lane);
        const float inv = 1.0f / lrun;
        bf16* op = CAT + (size_t)qrow * DM + head * 64 + 4 * g; float ssq = 0.f;
#pragma unroll
        for (int db = 0; db < 4; ++db) { const f32x4 ov = acc[db] * inv; ssq += (ov[0] * ov[0] + ov[1] * ov[1]) + (ov[2] * ov[2] + ov[3] * ov[3]);
            v2u o; o.x = pk2(ov[0], ov[1]); o.y = pk2(ov[2], ov[3]); *(v2u*)(op + 16 * db) = o; }
        ssq += xshfl<16>(ssq, lane); ssq += xshfl<32>(ssq, lane);
        if (g == 0) atomicAdd(ssA + qrow, ss_fix(ssq));
    }
#undef NA_ISSUE
}

__device__ __forceinline__ void post_phase(FA, int l) {
    const bf16* O = WSP(bf16, WS_O); const bf16* Y2 = WSP(bf16, WS_Y2); bf16* CAT = WSP(bf16, WS_CAT);
    const float* ga = AIN(11) + l * 512; const float* gc = AIN(24) + l * 1024; const int lane = F.lane;
    for (int r = F.gw; r < MTOK; r += F.NGW) {
        {
            const v4u w = *(const v4u*)(O + (size_t)r * 512 + 8 * lane); float x[8] = {bflo(w.x), bfhi(w.x), bflo(w.y), bfhi(w.y), bflo(w.z), bfhi(w.z), bflo(w.w), bfhi(w.w)}; float s = 0.f;
#pragma unroll
            for (int i = 0; i < 8; ++i) s += x[i] * x[i];
            const float rstd = fast_rsq(wave_sum(s, F.lane) * (1.0f / 512.0f) + EPS); const f32x4 g0 = *(const f32x4*)(ga + 8 * lane), g1 = *(const f32x4*)(ga + 8 * lane + 4);
            v4u o; o.x = pk2(x[0] * rstd * g0[0], x[1] * rstd * g0[1]); o.y = pk2(x[2] * rstd * g0[2], x[3] * rstd * g0[3]); o.z = pk2(x[4] * rstd * g1[0], x[5] * rstd * g1[1]); o.w = pk2(x[6] * rstd * g1[2], x[7] * rstd * g1[3]);
            *(v4u*)(CAT + (size_t)r * DM + 8 * lane) = o; }
        {
            float s = 0.f; v4u w[2];
#pragma unroll
            for (int hh = 0; hh < 2; ++hh) { w[hh] = *(const v4u*)(Y2 + (size_t)r * 1024 + 512 * hh + 8 * lane);
                s += bflo(w[hh].x) * bflo(w[hh].x) + bfhi(w[hh].x) * bfhi(w[hh].x) + bflo(w[hh].y) * bflo(w[hh].y) + bfhi(w[hh].y) * bfhi(w[hh].y) + bflo(w[hh].z) * bflo(w[hh].z) + bfhi(w[hh].z) * bfhi(w[hh].z) + bflo(w[hh].w) * bflo(w[hh].w) + bfhi(w[hh].w) * bfhi(w[hh].w); }
            const float rstd = fast_rsq(wave_sum(s, F.lane) * (1.0f / 1024.0f) + EPS);
#pragma unroll
            for (int hh = 0; hh < 2; ++hh) { const f32x4 g0 = *(const f32x4*)(gc + 512 * hh + 8 * lane), g1 = *(const f32x4*)(gc + 512 * hh + 8 * lane + 4);
                v4u o; o.x = pk2(bflo(w[hh].x) * rstd * g0[0], bfhi(w[hh].x) * rstd * g0[1]); o.y = pk2(bflo(w[hh].y) * rstd * g0[2], bfhi(w[hh].y) * rstd * g0[3]);
                o.z = pk2(bflo(w[hh].z) * rstd * g1[0], bfhi(w[hh].z) * rstd * g1[1]); o.w = pk2(bflo(w[hh].w) * rstd * g1[2], bfhi(w[hh].w) * rstd * g1[3]);
                *(v4u*)(CAT + (size_t)r * DM + 1024 + 512 * hh + 8 * lane) = o; } }
    }
}

__global__ void __launch_bounds__(NWAVES * 64, 2) enc_fwd(const Args A) {
    extern __shared__ __attribute__((aligned(16))) unsigned char lds[];
    Frame F;
    F.lds = (LAS unsigned char*)lds; F.MISC = (volatile LAS unsigned*)(F.lds + MISC_OFF);
    F.tid = threadIdx.x; F.lane = F.tid & 63; F.wave = __builtin_amdgcn_readfirstlane(F.tid >> 6);
    const int wave0 = F.wave;
    F.G = gridDim.x; F.gw = blockIdx.x * NWAVES + F.wave; F.NGW = F.G * NWAVES; F.bid = blockIdx.x; F.ws = (unsigned char*)A.in[32]; F.X = (float*)A.in[31]; F.zi = 0;

    for (int u = F.tid; u < (LDS_BYTES - LDSCTL_OFF) / 4; u += NWAVES * 64) ((LAS unsigned*)(F.lds + LDSCTL_OFF))[u] = 0u;
    __syncthreads();
    if (!MK_PER_PHASE) (void)xcd_barrier_post((unsigned*)((unsigned char*)A.in[32] + WS_CTL) + CW_BAR, (volatile LAS unsigned*)((LAS unsigned char*)lds + MISC_OFF) + 8);
#define GRID_BAR() do { if (MK_PER_PHASE) { if (F.tid == 0) __hip_atomic_store((gu32*)(F.ws + WS_CTL) + CW_TMO, 0xBADBA0u, RLX_AGENT); } \
    else { unsigned zb_ = 0u; asm volatile("" : "+v"(zb_)); zb_ = (unsigned)__builtin_amdgcn_readfirstlane((int)zb_); unsigned char* wsb_ = (unsigned char*)A.in[32 + (int)zb_]; \
           XcdBarrier b_; b_.bar = (unsigned*)(wsb_ + WS_CTL) + CW_BAR; b_.x = xb_xcc_id(); b_.t0 = (wave0 == 0) && (fresh_lane() == 0); b_.st = (volatile LAS unsigned*)((LAS unsigned char*)lds + MISC_OFF) + 8; xcd_barrier(b_); } } while (0)
#ifndef ONLY
#define ONLY -1
#endif
#define IN(k) ((ONLY < 0 || ((k) - p0) == ONLY) && A.ph_lo <= (k) && (k) < A.ph_hi)
#define SEAM(k) do { if (IN(k) && IN((k) + 1)) GRID_BAR(); } while (0)
#define PHASE_BEGIN() do { int t_ = wave0 * 64 + fresh_lane(); asm volatile("" : "+v"(t_)); F.tid = t_; F.lane = t_ & 63; F.wave = __builtin_amdgcn_readfirstlane(t_ >> 6); \
        int b_ = blockIdx.x; asm volatile("" : "+v"(b_)); b_ = __builtin_amdgcn_readfirstlane(b_); F.bid = b_; F.G = gridDim.x; F.NGW = F.G * NWAVES; F.gw = b_ * NWAVES + F.wave; \
        unsigned z_ = 0u; asm volatile("" : "+v"(z_)); z_ = (unsigned)__builtin_amdgcn_readfirstlane((int)z_); F.zi = (int)z_; F.ws = (unsigned char*)AIN(32); F.X = (float*)AIN(31); } while (0)
    for (int l = 0; l < NL; ++l) {
        const int p0 = l * PH_PER_LAYER;
#define SSP(ll, k) (WSP(u64, WS_SS) + (size_t)(1 + 6 * (ll) + (k)) * MTOK)
        if (IN(p0 + 0)) { PHASE_BEGIN();
            if (F.wave & 1) { s5_ops(F, A, l); conv_layer(F, A, l); } else { conv_layer(F, A, l); s5_ops(F, A, l); }
            if (l == 0) { lb_table(F, A); prep_phase(F, A); }
        }
        SEAM(p0 + 0);
#define HOFF(hf) ((size_t)(hf) * MPROMPT)
#define FFN_UP(hf, WOFF, SA, SB, UB) do { PHASE_BEGIN(); pg8::Gemm g{WSP(bf16, WS_XB) + HOFF(hf) * DM, WSP(bf16, WOFF), MPROMPT, 2 * FF, DM, DM, DM}; pg8::StaticOrder S; S.init(MPROMPT, 2 * FF, F.G, F.bid, WGM_UP); \
            EpiSwiGLU E{WSP(bf16, WS_H) + HOFF(hf) * FF, RowScale{(SA) + HOFF(hf), (SB) + HOFF(hf), UB}}; pg8::gemm_phase<EpiSwiGLU, pg8::StaticOrder, true, true>(F.lds + RING_OFF, g, S, E, F.tid); } while (0)
#define FFN_DN(hf, WOFF, PRE, HASPRE, PREG, SSA, SSB, GB) do { PHASE_BEGIN(); pg8::Gemm g{WSP(bf16, WS_H) + HOFF(hf) * FF, WSP(bf16, WOFF), MPROMPT, DM, FF, FF, FF}; pg8::StaticOrder S; S.init(MPROMPT, DM, F.G, F.bid, WGM_DN); \
            u64* ssb_ = (SSB); EpiResid E{WSP(bf16, WS_XB) + HOFF(hf) * DM, 0.5f, (PRE) + HOFF(hf), HASPRE, PREG, (SSA) + HOFF(hf), ssb_ ? ssb_ + HOFF(hf) : nullptr, GB}; \
            pg8::gemm_phase<EpiResid, pg8::StaticOrder, true, true>(F.lds + RING_OFF, g, S, E, F.tid); } while (0)
        if (IN(p0 + 1)) { FFN_UP(0, WS_WGU1, l ? SSP(l - 1, 2) : WSP(u64, WS_SS), l ? SSP(l - 1, 3) : WSP(u64, WS_SS), l != 0); }
        SEAM(p0 + 1);
        if (IN(p0 + 2)) { FFN_DN(0, WS_WD1, l ? SSP(l - 1, 2) : SSP(l, 0), l != 0, l ? AIN(30) + (l - 1) * DM : nullptr, SSP(l, 0), (u64*)nullptr, nullptr); __syncthreads();
                          FFN_UP(1, WS_WGU1, l ? SSP(l - 1, 2) : WSP(u64, WS_SS), l ? SSP(l - 1, 3) : WSP(u64, WS_SS), l != 0); }
        SEAM(p0 + 2);
        if (IN(p0 + 3)) { FFN_DN(1, WS_WD1, l ? SSP(l - 1, 2) : SSP(l, 0), l != 0, l ? AIN(30) + (l - 1) * DM : nullptr, SSP(l, 0), (u64*)nullptr, nullptr); }
        SEAM(p0 + 3);
        if (IN(p0 + 4)) { PHASE_BEGIN(); pg8::Gemm g{WSP(bf16, WS_XB), WSP(bf16, WS_WIN), MTOK, INC, DM, DM, DM}; pg8::StaticOrder S; S.init(MTOK, INC, F.G, F.bid, WGM_IN);
            EpiWin E{WSP(bf16, WS_Q), WSP(bf16, WS_K), WSP(bf16, WS_V), WSP(bf16, WS_QH), WSP(bf16, WS_VH), WSP(bf16, WS_GH), WSP(bf16, WS_LFF), WSP(bf16, WS_LFB), WSP(bf16, WS_UX),
                     AIN(8) + l * 64, AIN(9) + l * 64, WSP(float, WS_TAB) + l * 1024, RowScale{SSP(l, 0), SSP(l, 0), false}};
            pg8::gemm_phase<EpiWin, pg8::StaticOrder, true, true>(F.lds + RING_OFF, g, S, E, F.tid); }
        SEAM(p0 + 4);
        if (IN(p0 + 5)) { PHASE_BEGIN(); pg8::Gemm g{WSP(bf16, WS_UX), WSP(bf16, WS_S5E), 64 * 2048, 64 * 256, 256, 512, 256}; S5Order S{F.G, F.bid};
            EpiS5E E{WSP(bf16, WS_E)}; pg8::gemm_phase<EpiS5E, S5Order, false, true>(F.lds + RING_OFF, g, S, E, F.tid);
            __syncthreads(); hg_phase_a(F, A);
        }
        SEAM(p0 + 5);
        if (IN(p0 + 6)) { PHASE_BEGIN();
            hg_phase_b(F, A);
            if (F.gw < 1536) s5_carry(F, A, l, F.gw, 1536);
            __syncthreads(); na_phase(F, A, AIN(10) + l * (8 * 15 * 31), AIN(8) + l * 64, AIN(9) + l * 64, SSP(l, 4));
        }
        SEAM(p0 + 6);
        if (IN(p0 + 7)) { PHASE_BEGIN(); pg8::Gemm g{WSP(bf16, WS_UX), WSP(bf16, WS_S5Y), 64 * 2048, 64 * 256, 512, 512, 512}; S5Order S{F.G, F.bid};
            EpiS5Y E{WSP(bf16, WS_YPRE)}; pg8::gemm_phase<EpiS5Y, S5Order, true, true>(F.lds + RING_OFF, g, S, E, F.tid);
            __syncthreads(); hg_phase_c(F, A, AIN(13) + l * 512);
        }
        SEAM(p0 + 7);
        if (IN(p0 + 8)) { PHASE_BEGIN(); pg8::Gemm g{WSP(bf16, WS_YPRE), WSP(bf16, WS_WGLU), MTOK, S5W, S5W, S5W, S5W}; pg8::StaticOrder S; S.init(MTOK, S5W, F.G, F.bid, WGM_DN);
            EpiGLU E{WSP(bf16, WS_YPRE), AIN(23) + l * S5W, WSP(bf16, WS_CAT) + 1024, SSP(l, 5)}; pg8::gemm_phase<EpiGLU, pg8::StaticOrder, true, true>(F.lds + RING_OFF, g, S, E, F.tid); }
        SEAM(p0 + 8);
        if (IN(p0 + 9)) { PHASE_BEGIN(); pg8::Gemm g{WSP(bf16, WS_CAT), WSP(bf16, WS_WOUT), MTOK, DM, DM, DM, DM}; pg8::StaticOrder S; S.init(MTOK, DM, F.G, F.bid, WGM_DN);
            EpiResidW E{WSP(bf16, WS_XB), SSP(l, 4), SSP(l, 5), SSP(l, 1)}; pg8::gemm_phase<EpiResidW, pg8::StaticOrder, true, true>(F.lds + RING_OFF, g, S, E, F.tid); }
        SEAM(p0 + 9);
        if (IN(p0 + 10)) { FFN_UP(0, WS_WGU2, SSP(l, 1), SSP(l, 1), false); }
        SEAM(p0 + 10);
        if (IN(p0 + 11)) { FFN_DN(0, WS_WD2, SSP(l, 2), false, nullptr, SSP(l, 2), SSP(l, 3), AIN(30) + l * DM); __syncthreads();
                           FFN_UP(1, WS_WGU2, SSP(l, 1), SSP(l, 1), false); }
        SEAM(p0 + 11);
        if (IN(p0 + 12)) { FFN_DN(1, WS_WD2, SSP(l, 2), false, nullptr, SSP(l, 2), SSP(l, 3), AIN(30) + l * DM); }
        if (l == NL - 1) SEAM(p0 + 12);
        if (IN(p0 + 13) && l == NL - 1) { PHASE_BEGIN(); out_norm_phase(F, A, SSP(l, 2), AIN(30) + l * DM); }
        SEAM(p0 + 13);
    }
#undef IN
#undef SEAM
}

extern "C" void kernel_launch(void* const* d_in, const int* in_sizes, int n_in, void* d_out, int out_size, void* d_ws, size_t ws_size, hipStream_t stream) {
    static int grid = 0;
    if (grid == 0) {
        if (n_in != 31 || out_size != MTOK * DM || ws_size < WS_END) { fprintf(stderr, "kernel_launch: unexpected shapes: n_in %d out %d ws %zu (need %zu); nothing launched\n", n_in, out_size, ws_size, (size_t)WS_END); grid = -1; return; }
        int dev = 0, cus = 0, per_cu = 0;
        if (hipGetDevice(&dev) != hipSuccess || hipDeviceGetAttribute(&cus, hipDeviceAttributeMultiprocessorCount, dev) != hipSuccess) { grid = -1; return; }
        if (hipFuncSetAttribute((const void*)enc_fwd, hipFuncAttributeMaxDynamicSharedMemorySize, LDS_BYTES) != hipSuccess) { fprintf(stderr, "kernel_launch: hipFuncSetAttribute failed\n"); grid = -1; return; }
        if (hipOccupancyMaxActiveBlocksPerMultiprocessor(&per_cu, (const void*)enc_fwd, NWAVES * 64, LDS_BYTES) != hipSuccess || per_cu < 1)
            fprintf(stderr, "kernel_launch: note: occupancy query reports %d workgroups per CU\n", per_cu);
        (void)hipGetLastError();
        grid = cus;
    }
    if (grid < 0) return;
    static_assert(WS_SS + SS_BYTES == WS_CTL && WS_CTL + CTL_ZERO_BYTES == WS_END, "row sums and control words are one contiguous region");
    if (hipMemsetAsync((char*)d_ws + WS_SS, 0, SS_BYTES + CTL_ZERO_BYTES, stream) != hipSuccess) { fprintf(stderr, "kernel_launch: memset failed\n"); return; }
    Args a{};
    for (int i = 0; i < 31; ++i) a.in[i] = (const float*)d_in[i];
    a.in[31] = (const float*)d_out; a.in[32] = (const float*)d_ws; a.li = 0; a.pad = 0;
#if MK_PER_PHASE
    for (int p = 0; p < N_PHASES; ++p) { a.ph_lo = p; a.ph_hi = p + 1; hipLaunchKernelGGL(enc_fwd, dim3(grid), dim3(NWAVES * 64), LDS_BYTES, stream, a); }
#else
    a.ph_lo = 0; a.ph_hi = N_PHASES; hipLaunchKernelGGL(enc_fwd, dim3(grid), dim3(NWAVES * 64), LDS_BYTES, stream, a);
#endif
    const hipError_t le = hipPeekAtLastError();
    if (le != hipSuccess) fprintf(stderr, "kernel_launch: launch failed: %s\n", hipGetErrorName(le));
}
```
